# Optimizing an MI355X kernel written in HIP

```python
import math
import jax, jax.numpy as jnp
from jax import lax
import numpy as np

D_MODEL = 4096
BATCH = 2
SEQ = 4096
DEPTH = 2

HEAD_DIM = 128
A_HEADS = 8
A_Q_LORA = 768
A_KV_LORA = 512
A_NOPE = 128
A_ROPE = 64
A_V = 128
B_PAIRS = ((128, 1), (512, 4), (2048, 16))
B_HEADS_PER_PAIR = 4
B_HEADS = B_HEADS_PER_PAIR * len(B_PAIRS)
C_HEADS = 8
C_KV_HEADS = 2
D_HEADS = 8
D_KV_HEADS = 2
D_WINDOW = 128

GRID_W = 64
ROPE_THETA = 10000.0
N_BUCKETS = 32
REL_MAX_DIST = 1024
BLOCK = 128
EPS = 1e-6
NEG = -1e30

W_A = A_HEADS * A_V
W_B = B_HEADS * HEAD_DIM
W_C = C_HEADS * HEAD_DIM
W_D = D_HEADS * HEAD_DIM
MIX_WIDTH = W_A + W_B + W_C + W_D
IN_SPLITS = (A_Q_LORA, A_KV_LORA, A_ROPE,
             W_B, W_B, W_B,
             W_C, C_KV_HEADS * HEAD_DIM, C_KV_HEADS * HEAD_DIM,
             W_D, D_KV_HEADS * HEAD_DIM, D_KV_HEADS * HEAD_DIM,
             MIX_WIDTH)
IN_WIDTH = sum(IN_SPLITS)

kernel_name = "hymba_style_mla_dilated_axial_sink_encoder"


def rmsnorm(x, g):
    xf = x.astype(jnp.float32)
    y = xf * lax.rsqrt(jnp.mean(xf * xf, axis=-1, keepdims=True) + EPS)
    return (y * g.astype(jnp.float32)).astype(x.dtype)


def rope_angles(pos, dim):
    inv = ROPE_THETA ** (-jnp.arange(0, dim, 2, dtype=jnp.float32) / dim)
    return pos.astype(jnp.float32)[:, None] * inv[None, :]


def apply_rope(x, ang):
    xf = x.astype(jnp.float32)
    half = x.shape[-1] // 2
    x1, x2 = xf[..., :half], xf[..., half:]
    cos = jnp.cos(ang)[:, None, :]
    sin = jnp.sin(ang)[:, None, :]
    return jnp.concatenate([x1 * cos - x2 * sin, x2 * cos + x1 * sin], axis=-1).astype(x.dtype)


def rel_bucket(rel):
    nb = N_BUCKETS // 2
    max_exact = nb // 2
    ret = jnp.where(rel > 0, nb, 0)
    n = jnp.abs(rel)
    nf = jnp.maximum(n, 1).astype(jnp.float32)
    large = max_exact + (jnp.log(nf / max_exact) / math.log(REL_MAX_DIST / max_exact)
                         * (nb - max_exact)).astype(jnp.int32)
    large = jnp.minimum(large, nb - 1)
    return ret + jnp.where(n < max_exact, n, large)


def dense_attention(q, k, v, scale):
    b, s = q.shape[:2]
    nblk = s // BLOCK
    qb = jnp.moveaxis(q.reshape(b, nblk, BLOCK, *q.shape[2:]), 1, 0)

    def one(qblk):
        logits = jnp.einsum('bqhgd,bkhd->bhgqk', qblk, k).astype(jnp.float32) * scale
        p = jax.nn.softmax(logits, axis=-1).astype(v.dtype)
        return jnp.einsum('bhgqk,bkhd->bqhgd', p, v)

    out = lax.map(one, qb)
    return jnp.moveaxis(out, 0, 1).reshape(b, s, *out.shape[3:])


def dilated_group(q, k, v, dil, side, bias_tab):
    b, s, h, d = q.shape
    offs = dil * jnp.arange(-side, side + 1)
    bias = bias_tab[rel_bucket(offs)].T.astype(jnp.float32)
    nblk = s // BLOCK
    qb = jnp.moveaxis(q.reshape(b, nblk, BLOCK, h, d), 1, 0)
    starts = jnp.arange(nblk) * BLOCK
    scale = d ** -0.5

    def one(args):
        qblk, st = args
        idx = (st + jnp.arange(BLOCK))[:, None] + offs[None, :]
        valid = (idx >= 0) & (idx < s)
        idxc = jnp.clip(idx, 0, s - 1)
        kg = k[:, idxc]
        vg = v[:, idxc]
        logits = jnp.einsum('bqhd,bqkhd->bhqk', qblk, kg).astype(jnp.float32) * scale + bias[None, :, None, :]
        logits = jnp.where(valid[None, None], logits, NEG)
        lse = jax.nn.logsumexp(logits, axis=-1)
        p = jnp.exp(logits - lse[..., None]).astype(v.dtype)
        return jnp.einsum('bhqk,bqkhd->bqhd', p, vg), lse

    o, lse = lax.map(one, (qb, starts))
    o = jnp.moveaxis(o, 0, 1).reshape(b, s, h, d)
    lse = jnp.transpose(lse, (1, 0, 3, 2)).reshape(b, s, h)
    return o, lse


def window_attention(q, k, v, sinks, bias_tab):
    b, s, hk, g, d = q.shape
    nblk = s // BLOCK
    pad = ((0, 0), (BLOCK, BLOCK), (0, 0), (0, 0))
    kp = jnp.pad(k, pad).reshape(b, nblk + 2, BLOCK, hk, d)
    vp = jnp.pad(v, pad).reshape(b, nblk + 2, BLOCK, hk, d)
    kband = jnp.concatenate([kp[:, :-2], kp[:, 1:-1], kp[:, 2:]], axis=2)
    vband = jnp.concatenate([vp[:, :-2], vp[:, 1:-1], vp[:, 2:]], axis=2)
    qb = q.reshape(b, nblk, BLOCK, hk, g, d)
    kj = jnp.arange(3 * BLOCK)[None, :] - BLOCK
    rel = kj - jnp.arange(BLOCK)[:, None]
    kpos = jnp.arange(nblk)[:, None] * BLOCK + kj
    valid = (jnp.abs(rel) <= D_WINDOW)[None] & ((kpos >= 0) & (kpos < s))[:, None, :]
    bias = jnp.moveaxis(bias_tab[rel_bucket(rel)], -1, 0).reshape(hk, g, BLOCK, 3 * BLOCK).astype(jnp.float32)
    logits = jnp.einsum('bnqhgd,bnkhd->bnhgqk', qb, kband).astype(jnp.float32) * (d ** -0.5) + bias
    logits = jnp.where(valid[None, :, None, None], logits, NEG)
    sink = jnp.broadcast_to(sinks.astype(jnp.float32).reshape(hk, g)[None, None, :, :, None, None],
                            logits.shape[:-1] + (1,))
    p = jax.nn.softmax(jnp.concatenate([logits, sink], axis=-1), axis=-1)[..., :-1].astype(v.dtype)
    o = jnp.einsum('bnhgqk,bnkhd->bnqhgd', p, vband)
    return o.reshape(b, s, hk, g, d)


def hybrid_layer(x, g_attn, w_in, g_qa, g_kva, w_uq, w_ukv, g_qn, g_kn, sinks, w_out,
                 rel_bias, ang_t, ang_row, ang_col):
    b, s, _ = x.shape
    h = rmsnorm(x, g_attn)
    proj = h @ w_in
    pts = [int(p) for p in np.cumsum(IN_SPLITS)[:-1]]
    (a_cq, a_ckv, a_kpe, b_q, b_k, b_v, c_q, c_k, c_v, d_q, d_k, d_v, gate) = jnp.split(proj, pts, axis=-1)

    qa = (rmsnorm(a_cq, g_qa) @ w_uq).reshape(b, s, A_HEADS, A_NOPE + A_ROPE)
    q_pe = apply_rope(qa[..., A_NOPE:], ang_t)
    kva = (rmsnorm(a_ckv, g_kva) @ w_ukv).reshape(b, s, A_HEADS, A_NOPE + A_V)
    k_pe = apply_rope(a_kpe[:, :, None, :], ang_t)
    q_a = jnp.concatenate([qa[..., :A_NOPE], q_pe], axis=-1)[:, :, :, None, :]
    k_a = jnp.concatenate([kva[..., :A_NOPE], jnp.broadcast_to(k_pe, (b, s, A_HEADS, A_ROPE))], axis=-1)
    o_a = dense_attention(q_a, k_a, kva[..., A_NOPE:], (A_NOPE + A_ROPE) ** -0.5).reshape(b, s, W_A)

    npair = len(B_PAIRS)
    b_q = b_q.reshape(b, s, npair, B_HEADS_PER_PAIR, HEAD_DIM)
    b_k = b_k.reshape(b, s, npair, B_HEADS_PER_PAIR, HEAD_DIM)
    b_v = b_v.reshape(b, s, npair, B_HEADS_PER_PAIR, HEAD_DIM)
    outs, lses = [], []
    for j, (win, dil) in enumerate(B_PAIRS):
        o, lse = dilated_group(b_q[:, :, j], b_k[:, :, j], b_v[:, :, j], dil, win // (2 * dil),
                               rel_bias[:, j * B_HEADS_PER_PAIR:(j + 1) * B_HEADS_PER_PAIR])
        outs.append(o)
        lses.append(lse)
    alpha = jax.nn.softmax(jnp.stack(lses, axis=2), axis=2)
    o_b = (jnp.stack(outs, axis=2) * alpha[..., None].astype(x.dtype)).reshape(b, s, W_B)

    half = HEAD_DIM // 2
    qc = rmsnorm(c_q.reshape(b, s, C_HEADS, HEAD_DIM), g_qn)
    kc = rmsnorm(c_k.reshape(b, s, C_KV_HEADS, HEAD_DIM), g_kn)
    qc = jnp.concatenate([apply_rope(qc[..., :half], ang_row), apply_rope(qc[..., half:], ang_col)], axis=-1)
    kc = jnp.concatenate([apply_rope(kc[..., :half], ang_row), apply_rope(kc[..., half:], ang_col)], axis=-1)
    o_c = dense_attention(qc.reshape(b, s, C_KV_HEADS, C_HEADS // C_KV_HEADS, HEAD_DIM), kc,
                          c_v.reshape(b, s, C_KV_HEADS, HEAD_DIM), HEAD_DIM ** -0.5).reshape(b, s, W_C)

    o_d = window_attention(d_q.reshape(b, s, D_KV_HEADS, D_HEADS // D_KV_HEADS, HEAD_DIM),
                           d_k.reshape(b, s, D_KV_HEADS, HEAD_DIM),
                           d_v.reshape(b, s, D_KV_HEADS, HEAD_DIM),
                           sinks, rel_bias[:, B_HEADS:]).reshape(b, s, W_D)

    mixed = jnp.concatenate([o_a, o_b, o_c, o_d], axis=-1) * jax.nn.silu(gate)
    return x + mixed @ w_out


def setup_inputs(seed: int = 0) -> dict:
    key = jax.random.key(seed)
    ks = jax.random.split(key, 16)
    f32 = jnp.float32
    nrm = lambda k, shape, scale: jax.random.normal(k, shape, f32) * scale
    return {
        "x": nrm(ks[0], (BATCH, SEQ, D_MODEL), 1.0),
        "g_attn": 1.0 + nrm(ks[1], (DEPTH, D_MODEL), 0.02),
        "w_in": nrm(ks[2], (DEPTH, D_MODEL, IN_WIDTH), D_MODEL ** -0.5),
        "g_qa": 1.0 + nrm(ks[3], (DEPTH, A_Q_LORA), 0.02),
        "g_kva": 1.0 + nrm(ks[4], (DEPTH, A_KV_LORA), 0.02),
        "w_uq": nrm(ks[5], (DEPTH, A_Q_LORA, A_HEADS * (A_NOPE + A_ROPE)), A_Q_LORA ** -0.5),
        "w_ukv": nrm(ks[6], (DEPTH, A_KV_LORA, A_HEADS * (A_NOPE + A_V)), A_KV_LORA ** -0.5),
        "g_qn": 1.0 + nrm(ks[7], (DEPTH, HEAD_DIM), 0.02),
        "g_kn": 1.0 + nrm(ks[8], (DEPTH, HEAD_DIM), 0.02),
        "sinks": nrm(ks[9], (DEPTH, D_HEADS), 0.5),
        "w_out": nrm(ks[10], (DEPTH, MIX_WIDTH, D_MODEL), MIX_WIDTH ** -0.5),
        "rel_bias": nrm(ks[11], (N_BUCKETS, B_HEADS + D_HEADS), 0.1),
        "g_final": 1.0 + nrm(ks[12], (D_MODEL,), 0.02),
    }


def reference(x, g_attn, w_in, g_qa, g_kva, w_uq, w_ukv, g_qn, g_kn, sinks, w_out, rel_bias, g_final):
    s = x.shape[1]
    rows = s // GRID_W
    ang_t = rope_angles(jnp.arange(s), A_ROPE)
    ang_row = rope_angles(jnp.repeat(jnp.arange(rows), GRID_W), HEAD_DIM // 2)
    ang_col = rope_angles(jnp.tile(jnp.arange(GRID_W), rows), HEAD_DIM // 2)
    for l in range(DEPTH):
        x = hybrid_layer(x, g_attn[l], w_in[l], g_qa[l], g_kva[l], w_uq[l], w_ukv[l], g_qn[l], g_kn[l],
                         sinks[l], w_out[l], rel_bias, ang_t, ang_row, ang_col)
    return rmsnorm(x, g_final)
```

```cpp
#include <hip/hip_runtime.h>
#include <hip/hip_cooperative_groups.h>
#include <cstdio>
namespace cg = cooperative_groups;
namespace pg8 {
#define PG8_LAS __attribute__((address_space(3)))
typedef unsigned short bf16_t;
__device__ __forceinline__ int opaque_tid() { int t = threadIdx.x; asm volatile("" : "+v"(t)); return t; }
typedef short bf16x8 __attribute__((ext_vector_type(8)));
typedef float f32x4 __attribute__((ext_vector_type(4)));
typedef unsigned u32x4 __attribute__((ext_vector_type(4)));
constexpr int BM = 256, BK = 64, HALF = 128, HTB = HALF * BK * 2  , STAGE_BYTES = 8 * HTB, NXCD = 8, WGM = 8;

__host__ __device__ __forceinline__ int lds_byte(int r, int c) { const int st = (r >> 4) * 2 + (c >> 5), rr = r & 15, cc = c & 31, ob = rr * 64 + cc * 2; return st * 1024 + (ob ^ (((ob >> 9) & 1) << 5)); }
__host__ __device__ __forceinline__ void stage_rc(int b, int& R, int& C) { const int st = b / 1024, sb = b % 1024, swz = sb ^ (((sb >> 9) & 1) << 5); R = (st >> 1) * 16 + swz / 64; C = (st & 1) * 32 + (swz % 64) / 2; }
__host__ __device__ __forceinline__ int perm32(int rho) { const int n = rho >> 4, i = rho & 15; return 8 * (i >> 2) + 4 * n + (i & 3); }

struct Unit { int pm, pn; };
struct Gemm { const bf16_t* A; const bf16_t* Bt; int M, N, K; };
struct StaticOrder {
    int nM, nN, nwg, G, c;
    __host__ __device__ void init(int M, int N, int G_, int c_) { nM = M / BM; nN = N / BM; nwg = nM * nN; G = G_; c = c_; }
    __host__ __device__ bool next(int i, Unit& u) const {
        const long L = (long)i * G + c; if (L >= nwg) return false;
        int wgid = (int)L; { const int q = nwg / NXCD, r = nwg % NXCD, xcd = wgid % NXCD, off = wgid / NXCD; wgid = (xcd < r ? xcd * (q + 1) : r * (q + 1) + (xcd - r) * q) + off; }
        const int nig = WGM * nN, gid = wgid / nig, fm = gid * WGM, gsz = (nM - fm) < WGM ? (nM - fm) : WGM;
        u.pm = fm + ((wgid % nig) % gsz); u.pn = (wgid % nig) / gsz; return true;
    }
    __device__ __forceinline__ void a_ready(const Unit&) const {}
    __device__ __forceinline__ void done(const Unit&) const {}
};
__device__ __forceinline__ unsigned cvt_pk_bf16(float lo, float hi) { unsigned r; asm volatile("v_cvt_pk_bf16_f32 %0, %1, %2" : "=v"(r) : "v"(lo), "v"(hi)); return r; }
typedef float f32x2 __attribute__((ext_vector_type(2)));
struct EpiBf16P {
    static constexpr bool PERM = true, AFTER_DRAIN = false;
    bf16_t* O; int ldc;
    __device__ __forceinline__ void operator()(const f32x4 (&acc)[2][2][4][2], const Unit& u, int wr, int wc, int fr, int fq) const {
        const int row0 = u.pm * BM + wr * 64 + fr; const int col0 = u.pn * BM + wc * 32 + 8 * fq;
#pragma unroll
        for (int ai = 0; ai < 2; ++ai)
#pragma unroll
            for (int m = 0; m < 4; ++m) { bf16_t* rowp = O + (size_t)(row0 + ai * HALF + m * 16) * ldc + col0;
#pragma unroll
                for (int bj = 0; bj < 2; ++bj) { const f32x4 v0 = acc[ai][bj][m][0], v1 = acc[ai][bj][m][1];
                    u32x4 w; w.x = cvt_pk_bf16(v0[0], v0[1]); w.y = cvt_pk_bf16(v0[2], v0[3]); w.z = cvt_pk_bf16(v1[0], v1[1]); w.w = cvt_pk_bf16(v1[2], v1[3]);
                    *(u32x4*)(rowp + bj * HALF) = w; } }
    }
};
struct EpiResF32 {
    static constexpr bool PERM = false, AFTER_DRAIN = false;
    const float* base; float* out; int ldc;
    __device__ __forceinline__ void operator()(const f32x4 (&acc)[2][2][4][2], const Unit& u, int wr, int wc, int fr, int fq) const {
        const int row0 = u.pm * BM + wr * 64 + fr, col0 = u.pn * BM + wc * 32 + 4 * fq;
#pragma unroll
        for (int ai = 0; ai < 2; ++ai)
#pragma unroll
            for (int m = 0; m < 4; ++m) { const size_t off = (size_t)(row0 + ai * HALF + m * 16) * ldc + col0;
#pragma unroll
                for (int bj = 0; bj < 2; ++bj)
#pragma unroll
                    for (int n = 0; n < 2; ++n) { const f32x4 b = *(const f32x4*)(base + off + bj * HALF + n * 16); *(f32x4*)(out + off + bj * HALF + n * 16) = acc[ai][bj][m][n] + b; } }
    }
};
template <class Epi, class Sched, bool STAMP = false>
__device__ __forceinline__ void gemm_phase(PG8_LAS unsigned char* lds, const Gemm g, const Sched& S, const Epi& E, unsigned long long* stamps) {
    const int tid = opaque_tid(), wid = __builtin_amdgcn_readfirstlane(tid >> 6), lane = tid & 63, wr = wid >> 2, wc = wid & 3, fr = lane & 15, fq = lane >> 4;
    const int K = g.K, nt = K / BK;
    int ts_lo = 0, ts_hi = 0, nts = 0; const unsigned long long rt_entry = STAMP ? (unsigned long long)wall_clock64() : 0ull;
#define PG8_STAMP() do { if (STAMP && wid == 0 && nts < 64) { const unsigned long long _c = (unsigned long long)clock64(); \
        ts_lo = (lane == nts) ? (int)(unsigned)_c : ts_lo; ts_hi = (lane == nts) ? (int)(unsigned)(_c >> 32) : ts_hi; ++nts; } } while (0)
    PG8_STAMP();
    unsigned voffA[2], voffB[2];
#pragma unroll
    for (int i = 0; i < 2; ++i) { int R, C; stage_rc(tid * 16 + i * 8192, R, C); const int Rb = Epi::PERM ? ((R & ~31) + perm32(R & 31)) : R;
        voffA[i] = (unsigned)(R * K + C) * 2u; voffB[i] = (unsigned)(Rb * K + C) * 2u; }
    const size_t kstep = (size_t)(BK * 2);
    const size_t hstep = (size_t)HALF * K * 2;
    const size_t tstep = 2 * hstep;
    const unsigned ldsw = (unsigned)wid * 1024u;
    const int aoff = lds_byte(wr * 64 + fr, fq * 8), boff = lds_byte(wc * 32 + fr, fq * 8);
#define PG8_SA(b, h) (((b) * 2 + (h)) * HTB)
#define PG8_SB(b, h) ((4 + (b) * 2 + (h)) * HTB)
#define PG8_STAGE(bufoff, gbase, voff) do { _Pragma("unroll") for (int _i = 0; _i < 2; ++_i) \
        __builtin_amdgcn_global_load_lds((const unsigned*)((const char*)(gbase) + (voff)[_i]), (PG8_LAS unsigned*)(lds + (bufoff) + ldsw + _i * 8192), 16, 0, 0); } while (0)
#define PG8_LDA(dst, b, h) do { _Pragma("unroll") for (int m = 0; m < 4; ++m) _Pragma("unroll") for (int k = 0; k < 2; ++k) dst[m][k] = *(const PG8_LAS bf16x8*)(lds + PG8_SA(b, h) + aoff + m * 2048 + k * 1024); } while (0)
#define PG8_LDB(dst, b, h) do { _Pragma("unroll") for (int n = 0; n < 2; ++n) _Pragma("unroll") for (int k = 0; k < 2; ++k) dst[n][k] = *(const PG8_LAS bf16x8*)(lds + PG8_SB(b, h) + boff + n * 2048 + k * 1024); } while (0)
#define PG8_MMA(ai, bj, At, Bt) do { __builtin_amdgcn_s_setprio(1); _Pragma("unroll") for (int m = 0; m < 4; ++m) _Pragma("unroll") for (int n = 0; n < 2; ++n) _Pragma("unroll") for (int k = 0; k < 2; ++k) \
        acc[ai][bj][m][n] = __builtin_amdgcn_mfma_f32_16x16x32_bf16(Bt[n][k], At[m][k], acc[ai][bj][m][n], 0, 0, 0); __builtin_amdgcn_s_setprio(0); } while (0)
#define PG8_WAIT_V(n) asm volatile("s_waitcnt vmcnt(" #n ")" ::: "memory")
#define PG8_WAIT_L(n) asm volatile("s_waitcnt lgkmcnt(" #n ")" ::: "memory")
#define PG8_BAR __builtin_amdgcn_s_barrier()
#define PG8_SCHED __builtin_amdgcn_sched_barrier(0)
    Unit cur, nxt; int ui = 0;
    if (!S.next(0, cur)) return;
    f32x4 acc[2][2][4][2];
#pragma unroll
    for (int a = 0; a < 2; ++a)
#pragma unroll
        for (int b = 0; b < 2; ++b)
#pragma unroll
            for (int m = 0; m < 4; ++m)
#pragma unroll
                for (int n = 0; n < 2; ++n) acc[a][b][m][n] = (f32x4){0.f, 0.f, 0.f, 0.f};
    bf16x8 At[4][2], B0[2][2], B1[2][2];
    const char* cA = (const char*)g.A + (size_t)cur.pm * tstep; const char* cB = (const char*)g.Bt + (size_t)cur.pn * tstep;
    S.a_ready(cur);
    PG8_STAGE(PG8_SB(0, 0), cB, voffB); PG8_STAGE(PG8_SA(0, 0), cA, voffA); PG8_STAGE(PG8_SB(0, 1), cB + hstep, voffB); PG8_STAGE(PG8_SA(0, 1), cA + hstep, voffA);
    if (wr == 1) PG8_BAR;
    PG8_WAIT_V(4); PG8_BAR;
    PG8_STAGE(PG8_SB(1, 0), cB + kstep, voffB); PG8_STAGE(PG8_SA(1, 0), cA + kstep, voffA); PG8_STAGE(PG8_SB(1, 1), cB + hstep + kstep, voffB);
    PG8_WAIT_V(6); PG8_BAR;
    PG8_STAMP();
    for (;;) {
        const bool has_next = S.next(ui + 1, nxt);
        const char* nA = has_next ? (const char*)g.A + (size_t)nxt.pm * tstep : cA; const char* nB = has_next ? (const char*)g.Bt + (size_t)nxt.pn * tstep : cB;
        for (int t = 0; t < nt; t += 2) {
            const bool last = (t == nt - 2);
            const char* a1 = cA + (size_t)(t + 1) * kstep;
            const char* a2 = last ? nA : cA + (size_t)(t + 2) * kstep; const char* b2 = last ? nB : cB + (size_t)(t + 2) * kstep;
            const char* a3 = a2 + kstep; const char* b3 = b2 + kstep;
            if (last && has_next) S.a_ready(nxt);
            PG8_LDB(B0, 0, 0); PG8_SCHED; PG8_LDA(At, 0, 0); PG8_STAGE(PG8_SA(1, 1), a1 + hstep, voffA);
            PG8_WAIT_L(8); PG8_BAR; PG8_WAIT_L(0); PG8_MMA(0, 0, At, B0); PG8_BAR; PG8_SCHED;
            PG8_LDB(B1, 0, 1); PG8_STAGE(PG8_SB(0, 0), b2, voffB);
            PG8_BAR; PG8_WAIT_L(0); PG8_MMA(0, 1, At, B1); PG8_BAR;
            PG8_LDA(At, 0, 1); PG8_STAGE(PG8_SA(0, 0), a2, voffA);
            PG8_BAR; PG8_WAIT_L(0); PG8_MMA(1, 0, At, B0); PG8_BAR; PG8_SCHED;
            PG8_STAGE(PG8_SB(0, 1), b2 + hstep, voffB);
            PG8_WAIT_V(6); PG8_BAR; PG8_MMA(1, 1, At, B1); PG8_BAR;
            PG8_LDB(B0, 1, 0); PG8_SCHED; PG8_LDA(At, 1, 0); PG8_STAGE(PG8_SA(0, 1), a2 + hstep, voffA);
            PG8_WAIT_L(8); PG8_BAR; PG8_WAIT_L(0); PG8_MMA(0, 0, At, B0); PG8_BAR; PG8_SCHED;
            PG8_LDB(B1, 1, 1); PG8_STAGE(PG8_SB(1, 0), b3, voffB);
            PG8_BAR; PG8_WAIT_L(0); PG8_MMA(0, 1, At, B1); PG8_BAR;
            PG8_LDA(At, 1, 1); PG8_STAGE(PG8_SA(1, 0), a3, voffA);
            PG8_BAR; PG8_WAIT_L(0); PG8_MMA(1, 0, At, B0); PG8_BAR; PG8_SCHED;
            PG8_STAGE(PG8_SB(1, 1), b3 + hstep, voffB);
            PG8_WAIT_V(6); PG8_BAR; PG8_MMA(1, 1, At, B1); PG8_BAR;
        }
        PG8_STAMP();
        if constexpr (!Epi::AFTER_DRAIN) { E(acc, cur, wr, wc, fr, fq); S.done(cur); }
        PG8_STAMP();
        if (!has_next) break;
#pragma unroll
        for (int a = 0; a < 2; ++a)
#pragma unroll
            for (int b = 0; b < 2; ++b)
#pragma unroll
                for (int m = 0; m < 4; ++m)
#pragma unroll
                    for (int n = 0; n < 2; ++n) acc[a][b][m][n] = (f32x4){0.f, 0.f, 0.f, 0.f};
        cur = nxt; cA = nA; cB = nB; ++ui;
    }
    PG8_WAIT_V(0);
    if (wr == 0) PG8_BAR;
    PG8_BAR;
    if constexpr (Epi::AFTER_DRAIN) { E.fused(acc, cur, wr, wc, fr, fq, lds, wid, lane); S.done(cur); }
    PG8_STAMP();
    if (STAMP && wid == 0) { stamps[lane] = lane < nts ? (((unsigned long long)(unsigned)ts_hi << 32) | (unsigned)ts_lo) : 0ull;
        if (lane == 62) stamps[62] = rt_entry; if (lane == 63) stamps[63] = (unsigned long long)wall_clock64(); }
#undef PG8_STAMP
#undef PG8_SA
#undef PG8_SB
#undef PG8_STAGE
#undef PG8_LDA
#undef PG8_LDB
#undef PG8_MMA
#undef PG8_WAIT_V
#undef PG8_WAIT_L
#undef PG8_BAR
#undef PG8_SCHED
}
}

typedef pg8::bf16_t bf16_t;
typedef pg8::bf16x8 bf16x8;
typedef pg8::f32x4 f32x4;
typedef pg8::u32x4 u32x4;
typedef short s16x4 __attribute__((ext_vector_type(4)));
typedef float f32x16 __attribute__((ext_vector_type(16)));
typedef unsigned u32x2 __attribute__((ext_vector_type(2)));
#define LAS __attribute__((address_space(3)))
typedef LAS unsigned char lds_u8;

constexpr int SEQ = 4096, NBATCH = 2, MTOK = 8192, DM = 4096, NIN = 13632, NINP = 13824, MIXW = 4608;
constexpr int C_ACQ = 0, C_ACKV = 768, C_KPE = 1280, C_BQ = 1344, C_BK = 2880, C_BV = 4416, C_CQ = 5952, C_CK = 6976, C_CV = 7232,
              C_DQ = 7488, C_DK = 8512, C_DV = 8768, C_GATE = 9024;
constexpr int MX_A = 0, MX_B = 1024, MX_C = 2560, MX_D = 3584;
constexpr float EPS = 1e-6f;
constexpr float LOG2E = 1.4426950408889634f, LN2 = 0.6931471805599453f;

constexpr size_t AL(size_t x) { return (x + 255) / 256 * 256; }
constexpr size_t WS_WIN   = 0;
constexpr size_t WS_WOUT  = WS_WIN   + AL((size_t)2 * NINP * DM * 2);
constexpr size_t WS_WUQ   = WS_WOUT  + AL((size_t)2 * DM * MIXW * 2);
constexpr size_t WS_WUKV  = WS_WUQ   + AL((size_t)2 * 1536 * 768 * 2);
constexpr size_t WS_H     = WS_WUKV  + AL((size_t)2 * 2048 * 512 * 2);
constexpr size_t WS_PROJ  = WS_H     + AL((size_t)MTOK * DM * 2);
constexpr size_t WS_X1    = WS_PROJ  + AL((size_t)MTOK * NINP * 2);
constexpr size_t WS_QAN   = WS_X1    + AL((size_t)MTOK * DM * 4);
constexpr size_t WS_KVAN  = WS_QAN   + AL((size_t)MTOK * 768 * 2);
constexpr size_t WS_KPE   = WS_KVAN  + AL((size_t)MTOK * 512 * 2);
constexpr size_t WS_QRAW  = WS_KPE   + AL((size_t)MTOK * 64 * 2);
constexpr size_t WS_KVRAW = WS_QRAW  + AL((size_t)MTOK * 1536 * 2);
constexpr size_t WS_QC    = WS_KVRAW + AL((size_t)MTOK * 2048 * 2);
constexpr size_t WS_KC    = WS_QC    + AL((size_t)MTOK * 1024 * 2);
constexpr size_t WS_MIXED = WS_KC    + AL((size_t)MTOK * 256 * 2);
constexpr size_t WS_LSE   = WS_MIXED + AL((size_t)MTOK * MIXW * 2);
constexpr size_t WS_CS    = WS_LSE   + AL((size_t)3 * MTOK * 4 * 4);
constexpr size_t WS_END   = WS_CS    + AL((size_t)SEQ * 32 * 8);

constexpr int LDS_BYTES = 131072;

struct Params {
    const float *x, *g_attn, *w_in, *g_qa, *g_kva, *w_uq, *w_ukv, *g_qn, *g_kn, *sinks, *w_out, *rel_bias, *g_final;
    float* out; unsigned char* ws; int ph_lo, ph_hi;
};

__device__ __forceinline__ bf16_t f2bf(float f) { unsigned u = __float_as_uint(f); u += 0x7FFFu + ((u >> 16) & 1u); return (bf16_t)(u >> 16); }
__device__ __forceinline__ float bf2f(bf16_t b) { return __uint_as_float(((unsigned)b) << 16); }
__device__ __forceinline__ float bflo(unsigned w) { return __uint_as_float(w << 16); }
__device__ __forceinline__ float bfhi(unsigned w) { return __uint_as_float(w & 0xffff0000u); }
__device__ __forceinline__ unsigned cvtpk(float lo, float hi) { unsigned r; asm volatile("v_cvt_pk_bf16_f32 %0, %1, %2" : "=v"(r) : "v"(lo), "v"(hi)); return r; }
__device__ __forceinline__ float wave_sum(float v) {
#pragma unroll
    for (int o = 32; o >= 1; o >>= 1) v += __shfl_xor(v, o);
    return v;
}
__device__ __forceinline__ int rel_bucket(int rel) {
    const int n = rel < 0 ? -rel : rel; int b;
    if (n < 8) b = n;
    else b = 8 + (n >= 15) + (n >= 27) + (n >= 50) + (n >= 91) + (n >= 166) + (n >= 305) + (n >= 559);
    return b + (rel > 0 ? 16 : 0);
}

__device__ __forceinline__ void cvt_transpose(const float* __restrict__ src, bf16_t* __restrict__ dst, int K, int N, int Npad, lds_u8* lds, int wg, int nwg) {
    LAS float* tile = (LAS float*)lds;
    const int tid = pg8::opaque_tid(), tn = Npad / 64, tk = K / 64;
    for (int t = wg; t < tn * tk; t += nwg) {
        const int nt = t % tn, kt = t / tn;
#pragma unroll
        for (int i = 0; i < 2; ++i) {
            const int row = (tid >> 4) + 32 * i, c4 = (tid & 15) * 4, n = nt * 64 + c4;
            f32x4 v = (f32x4){0.f, 0.f, 0.f, 0.f};
            if (n < N) v = *(const f32x4*)(src + (size_t)(kt * 64 + row) * N + n);
            tile[row * 65 + c4 + 0] = v[0]; tile[row * 65 + c4 + 1] = v[1]; tile[row * 65 + c4 + 2] = v[2]; tile[row * 65 + c4 + 3] = v[3];
        }
        __syncthreads();
        {
            const int nl = tid >> 3, kc = (tid & 7) * 8;
            float f[8];
#pragma unroll
            for (int j = 0; j < 8; ++j) f[j] = tile[(kc + j) * 65 + nl];
            u32x4 w; w.x = cvtpk(f[0], f[1]); w.y = cvtpk(f[2], f[3]); w.z = cvtpk(f[4], f[5]); w.w = cvtpk(f[6], f[7]);
            *(u32x4*)(dst + (size_t)(nt * 64 + nl) * K + kt * 64 + kc) = w;
        }
        __syncthreads();
    }
}

__device__ __forceinline__ void build_cs(float2* cs, int wg, int nwg) {
    for (int idx = wg * 512 + pg8::opaque_tid(); idx < SEQ * 32; idx += nwg * 512) {
        const int pos = idx >> 5, i = idx & 31;
        const float inv = exp2f(-(float)i * (13.287712379549449f / 32.0f));
        const float ang = (float)pos * inv;
        const float k = rintf(ang * 0.15915494309189535f);
        float r = fmaf(-k, 6.2831854820251465f, ang); r = fmaf(-k, -1.7484555e-7f, r);
        cs[idx] = make_float2(__cosf(r), __sinf(r));
    }
}

template <bool TO_BF16>
__device__ __forceinline__ void rmsnorm_rows(const float* x, const float* __restrict__ g, bf16_t* hout, float* fout, lds_u8* lds, int wg, int nwg) {
    LAS float* red = (LAS float*)lds;
    const int tid = pg8::opaque_tid(), wid = tid >> 6, lane = tid & 63;
    const f32x4 g0 = *(const f32x4*)(g + tid * 8), g1 = *(const f32x4*)(g + tid * 8 + 4);
    for (int row = wg; row < MTOK; row += nwg) {
        const float* xr = x + (size_t)row * DM + tid * 8;
        const f32x4 a = *(const f32x4*)xr, b = *(const f32x4*)(xr + 4);
        float ss = a[0] * a[0] + a[1] * a[1] + a[2] * a[2] + a[3] * a[3] + b[0] * b[0] + b[1] * b[1] + b[2] * b[2] + b[3] * b[3];
        ss = wave_sum(ss);
        if (lane == 0) red[wid] = ss;
        __syncthreads();
        float tot = 0.f;
#pragma unroll
        for (int w = 0; w < 8; ++w) tot += red[w];
        const float rstd = rsqrtf(tot * (1.0f / DM) + EPS);
        const f32x4 ya = a * rstd * g0, yb = b * rstd * g1;
        if (TO_BF16) {
            u32x4 w; w.x = cvtpk(ya[0], ya[1]); w.y = cvtpk(ya[2], ya[3]); w.z = cvtpk(yb[0], yb[1]); w.w = cvtpk(yb[2], yb[3]);
            *(u32x4*)(hout + (size_t)row * DM + tid * 8) = w;
        } else {
            float* o = fout + (size_t)row * DM + tid * 8;
            *(f32x4*)o = ya; *(f32x4*)(o + 4) = yb;
        }
        __syncthreads();
    }
}

__device__ __forceinline__ void prep_tokens(const bf16_t* __restrict__ proj, const float* __restrict__ g_qa, const float* __restrict__ g_kva,
                                            const float* __restrict__ g_qn, const float* __restrict__ g_kn, const float2* __restrict__ cs,
                                            bf16_t* qan, bf16_t* kvan, bf16_t* kpe, bf16_t* qc, bf16_t* kc, int wg, int nwg) {
    const int tid = pg8::opaque_tid(), wid = tid >> 6, lane = tid & 63;
    for (int t = wg * 8 + wid; t < MTOK; t += nwg * 8) {
        const bf16_t* pr = proj + (size_t)t * NINP;
        const int pos = t & (SEQ - 1);
        {
            float v[12]; float ss = 0.f;
#pragma unroll
            for (int k = 0; k < 3; ++k) { const u32x2 w = *(const u32x2*)(pr + C_ACQ + k * 256 + lane * 4);
                v[4 * k] = bflo(w.x); v[4 * k + 1] = bfhi(w.x); v[4 * k + 2] = bflo(w.y); v[4 * k + 3] = bfhi(w.y); }
#pragma unroll
            for (int j = 0; j < 12; ++j) ss += v[j] * v[j];
            ss = wave_sum(ss);
            const float rstd = rsqrtf(ss * (1.0f / 768.0f) + EPS);
#pragma unroll
            for (int k = 0; k < 3; ++k) { const f32x4 gg = *(const f32x4*)(g_qa + k * 256 + lane * 4);
                u32x2 w; w.x = cvtpk(v[4 * k] * rstd * gg[0], v[4 * k + 1] * rstd * gg[1]); w.y = cvtpk(v[4 * k + 2] * rstd * gg[2], v[4 * k + 3] * rstd * gg[3]);
                *(u32x2*)(qan + (size_t)t * 768 + k * 256 + lane * 4) = w; }
        }
        {
            float v[8]; float ss = 0.f;
#pragma unroll
            for (int k = 0; k < 2; ++k) { const u32x2 w = *(const u32x2*)(pr + C_ACKV + k * 256 + lane * 4);
                v[4 * k] = bflo(w.x); v[4 * k + 1] = bfhi(w.x); v[4 * k + 2] = bflo(w.y); v[4 * k + 3] = bfhi(w.y); }
#pragma unroll
            for (int j = 0; j < 8; ++j) ss += v[j] * v[j];
            ss = wave_sum(ss);
            const float rstd = rsqrtf(ss * (1.0f / 512.0f) + EPS);
#pragma unroll
            for (int k = 0; k < 2; ++k) { const f32x4 gg = *(const f32x4*)(g_kva + k * 256 + lane * 4);
                u32x2 w; w.x = cvtpk(v[4 * k] * rstd * gg[0], v[4 * k + 1] * rstd * gg[1]); w.y = cvtpk(v[4 * k + 2] * rstd * gg[2], v[4 * k + 3] * rstd * gg[3]);
                *(u32x2*)(kvan + (size_t)t * 512 + k * 256 + lane * 4) = w; }
        }
        if (lane < 32) {
            const float x1 = bf2f(pr[C_KPE + lane]), x2 = bf2f(pr[C_KPE + 32 + lane]);
            const float2 c = cs[pos * 32 + lane];
            kpe[(size_t)t * 64 + lane] = f2bf(x1 * c.x - x2 * c.y);
            kpe[(size_t)t * 64 + 32 + lane] = f2bf(x2 * c.x + x1 * c.y);
        }
        {
            const int half = lane >> 5, i = lane & 31;
            const int p = half ? (pos & 63) : (pos >> 6);
            const float2 c = cs[p * 32 + i];
#pragma unroll 1
            for (int hd = 0; hd < 10; ++hd) {
                const int col = (hd < 8) ? (C_CQ + hd * 128) : (C_CK + (hd - 8) * 128);
                const float* gg = (hd < 8) ? g_qn : g_kn;
                float a = bf2f(pr[col + half * 64 + i]), b = bf2f(pr[col + half * 64 + 32 + i]);
                float ss = wave_sum(a * a + b * b);
                const float rstd = rsqrtf(ss * (1.0f / 128.0f) + EPS);
                a *= rstd * gg[half * 64 + i]; b *= rstd * gg[half * 64 + 32 + i];
                const float oa = a * c.x - b * c.y, ob = b * c.x + a * c.y;
                bf16_t* dst = (hd < 8) ? (qc + (size_t)t * 1024 + hd * 128) : (kc + (size_t)t * 256 + (hd - 8) * 128);
                dst[half * 64 + i] = f2bf(oa); dst[half * 64 + 32 + i] = f2bf(ob);
            }
        }
    }
}

__device__ __forceinline__ void fixup_b(bf16_t* mixed, const float* __restrict__ lse, int wg, int nwg) {
    const int tid = pg8::opaque_tid(), wid = tid >> 6, lane = tid & 63, hh = lane >> 4;
    for (int t = wg * 8 + wid; t < MTOK; t += nwg * 8) {
        const float l0 = lse[((size_t)0 * MTOK + t) * 4 + hh], l1 = lse[((size_t)1 * MTOK + t) * 4 + hh], l2 = lse[((size_t)2 * MTOK + t) * 4 + hh];
        const float mx = fmaxf(l0, fmaxf(l1, l2));
        const float e0 = __expf(l0 - mx), e1 = __expf(l1 - mx), e2 = __expf(l2 - mx), inv = 1.0f / (e0 + e1 + e2);
        const float al[3] = {e0 * inv, e1 * inv, e2 * inv};
#pragma unroll
        for (int k = 0; k < 3; ++k) {
            bf16_t* p = mixed + (size_t)t * MIXW + MX_B + k * 512 + lane * 8;
            u32x4 w = *(u32x4*)p;
            const float a = al[k];
            w.x = cvtpk(bflo(w.x) * a, bfhi(w.x) * a); w.y = cvtpk(bflo(w.y) * a, bfhi(w.y) * a);
            w.z = cvtpk(bflo(w.z) * a, bfhi(w.z) * a); w.w = cvtpk(bflo(w.w) * a, bfhi(w.w) * a);
            *(u32x4*)p = w;
        }
    }
}

__device__ __forceinline__ int crow(int r, int hi) { return (r & 3) + 8 * (r >> 2) + 4 * hi; }
#define KSWZ(row, colB) ((row) * 256 + ((colB) ^ (((row) & 7) << 4)))
#define PSWZ(row, colB) ((row) * 128 + ((colB) ^ (((row) & 7) << 4)))
__device__ __forceinline__ int v_st(int k, int c) { const int kk = (k & ~0xC) | ((k & 4) << 1) | ((k & 8) >> 1); return ((kk >> 3) * 4 + (c >> 5)) * 512 + ((kk & 7) * 32 + (c & 31)) * 2; }
__device__ __forceinline__ int v_rd_base(int lane) { return ((lane & 3) << 3) | (((lane >> 2) & 3) << 6) | (((lane >> 4) & 1) << 5) | (((lane >> 5) & 1) << 8); }
constexpr int v_rd_off(int d0, int ks, int half) { return d0 * 512 + ks * 4096 + half * 2048; }
template <int OFF> __device__ __forceinline__ s16x4 tr_read(int vb) {
    s16x4 r; asm volatile("ds_read_b64_tr_b16 %0, %1 offset:%2" : "=&v"(r) : "v"(vb), "i"(OFF) : "memory"); return r;
}
template <int D0> __device__ __forceinline__ void pv_one(f32x16& od, int vb, bf16x8 pa0, bf16x8 pa1, bf16x8 pa2, bf16x8 pa3) {
    const s16x4 l0 = tr_read<v_rd_off(D0, 0, 0)>(vb), h0 = tr_read<v_rd_off(D0, 0, 1)>(vb), l1 = tr_read<v_rd_off(D0, 1, 0)>(vb), h1 = tr_read<v_rd_off(D0, 1, 1)>(vb);
    const s16x4 l2 = tr_read<v_rd_off(D0, 2, 0)>(vb), h2 = tr_read<v_rd_off(D0, 2, 1)>(vb), l3 = tr_read<v_rd_off(D0, 3, 0)>(vb), h3 = tr_read<v_rd_off(D0, 3, 1)>(vb);
    asm volatile("s_waitcnt lgkmcnt(0)" ::: "memory"); __builtin_amdgcn_sched_barrier(0);
#define PK(L, H) (bf16x8){L[0], L[1], L[2], L[3], H[0], H[1], H[2], H[3]}
    od = __builtin_amdgcn_mfma_f32_32x32x16_bf16(pa0, PK(l0, h0), od, 0, 0, 0);
    od = __builtin_amdgcn_mfma_f32_32x32x16_bf16(pa1, PK(l1, h1), od, 0, 0, 0);
    od = __builtin_amdgcn_mfma_f32_32x32x16_bf16(pa2, PK(l2, h2), od, 0, 0, 0);
    od = __builtin_amdgcn_mfma_f32_32x32x16_bf16(pa3, PK(l3, h3), od, 0, 0, 0);
#undef PK
}

constexpr int AL_V = 0, AL_K = 16384, AL_KP = 32768, AL_WS = 40960, AL_LUT = 43008;

struct AttnArgs {
    const bf16_t* Q; long ldq;
    const bf16_t* K; long ldk;
    const bf16_t* K2; long ldk2;
    const bf16_t* V; long ldv;
    const bf16_t* G; long ldg;
    bf16_t* O; long ldo;
    float* lse; long ldl;
    const float2* cs;
    int i0, L, side, dil;
    const float* bias; int bcol;
    float C;
    float sink2;
};

template <int DQK, bool BAND, bool SINK, bool WLSE, bool ROPEQ>
__device__ __forceinline__ void attn_unit(lds_u8* lds, const AttnArgs& a) {
    constexpr int ND0 = DQK / 16;
    const int tid = pg8::opaque_tid(), wid = tid >> 6, lane = tid & 63, r32 = lane & 31, hi = lane >> 5;
    lds_u8* Vl = lds + AL_V; lds_u8* Kl = lds + AL_K; lds_u8* Kp = lds + AL_KP;
    LAS float* wsf = (LAS float*)(lds + AL_WS) + wid * 64; LAS float* li_l = wsf; LAS float* al_l = wsf + 32;
    LAS float* lut = (LAS float*)(lds + AL_LUT);
    __syncthreads();
    if (BAND) {
        if (tid <= 2 * a.side) { const int rel = tid - a.side; lut[tid] = a.bias[rel_bucket(rel * a.dil) * 20 + a.bcol] * LOG2E; }
    }
    const int qi = a.i0 + wid * 32 + r32;
    bf16x8 qr[ND0];
    {
        const bf16_t* Qw = a.Q + (long)qi * a.ldq + hi * 8;
#pragma unroll
        for (int d0 = 0; d0 < ND0; ++d0) qr[d0] = *(const bf16x8*)(Qw + d0 * 16);
    }
    if constexpr (ROPEQ) {
#pragma unroll
        for (int dd = 0; dd < 2; ++dd) {
            bf16x8 x1 = qr[8 + dd], x2 = qr[10 + dd];
#pragma unroll
            for (int j = 0; j < 8; ++j) {
                const float2 c = a.cs[qi * 32 + dd * 16 + hi * 8 + j];
                const float f1 = bf2f((bf16_t)x1[j]), f2 = bf2f((bf16_t)x2[j]);
                x1[j] = (short)f2bf(f1 * c.x - f2 * c.y); x2[j] = (short)f2bf(f2 * c.x + f1 * c.y);
            }
            qr[8 + dd] = x1; qr[10 + dd] = x2;
        }
    }
    int t_lo = 0, t_hi = a.L / 64, lo_w = 0, hi_w = 1 << 30;
    if (BAND) {
        t_lo = (a.i0 - a.side) / 64; if (t_lo < 0) t_lo = 0;
        int th = (a.i0 + 256 + a.side) / 64; if (th < t_hi) t_hi = th;
        const int w0 = a.i0 + wid * 32;
        lo_w = (w0 - a.side) >> 6; hi_w = (w0 + 31 + a.side) >> 6;
    }
    const int sr = tid >> 4, sc = (tid & 15) * 8;
    const int vst0 = v_st(sr, sc), vst1 = v_st(32 + sr, sc), kst0 = KSWZ(sr, sc * 2), kst1 = KSWZ(32 + sr, sc * 2);
    const int pr_ = tid >> 3, pc = (tid & 7) * 8, pst = PSWZ(pr_, pc * 2);
    const int vb0 = (int)(unsigned)(size_t)Vl + v_rd_base(lane);
    bf16x8 kA, kB, vA, vB, kP;
#define ALOAD(T) do { const long j0 = (long)(T) * 64; \
        kA = *(const bf16x8*)(a.K + (j0 + sr) * a.ldk + sc); kB = *(const bf16x8*)(a.K + (j0 + 32 + sr) * a.ldk + sc); \
        vA = *(const bf16x8*)(a.V + (j0 + sr) * a.ldv + sc); vB = *(const bf16x8*)(a.V + (j0 + 32 + sr) * a.ldv + sc); \
        if constexpr (DQK == 192) kP = *(const bf16x8*)(a.K2 + (j0 + pr_) * a.ldk2 + pc); } while (0)
    float m_reg = -1e29f, l_reg = 0.f;
    f32x16 o[4];
#pragma unroll
    for (int d = 0; d < 4; ++d)
#pragma unroll
        for (int r = 0; r < 16; ++r) o[d][r] = 0.f;
    ALOAD(t_lo);
    for (int T = t_lo; T < t_hi; ++T) {
        __syncthreads();
        *(LAS bf16x8*)(Kl + kst0) = kA; *(LAS bf16x8*)(Kl + kst1) = kB;
        *(LAS bf16x8*)(Vl + vst0) = vA; *(LAS bf16x8*)(Vl + vst1) = vB;
        if constexpr (DQK == 192) *(LAS bf16x8*)(Kp + pst) = kP;
        if (T + 1 < t_hi) ALOAD(T + 1);
        __syncthreads();
        if (T >= lo_w && T <= hi_w) {
            f32x16 p0, p1;
#pragma unroll
            for (int r = 0; r < 16; ++r) { p0[r] = 0.f; p1[r] = 0.f; }
#pragma unroll
            for (int d0 = 0; d0 < 8; ++d0) { const int cb = (d0 * 16 + hi * 8) * 2;
                const bf16x8 b0 = *(const LAS bf16x8*)(Kl + KSWZ(r32, cb)), b1 = *(const LAS bf16x8*)(Kl + KSWZ(32 + r32, cb));
                p0 = __builtin_amdgcn_mfma_f32_32x32x16_bf16(b0, qr[d0], p0, 0, 0, 0);
                p1 = __builtin_amdgcn_mfma_f32_32x32x16_bf16(b1, qr[d0], p1, 0, 0, 0); }
            if constexpr (DQK == 192) {
#pragma unroll
                for (int d0 = 0; d0 < 4; ++d0) { const int cb = (d0 * 16 + hi * 8) * 2;
                    const bf16x8 b0 = *(const LAS bf16x8*)(Kp + PSWZ(r32, cb)), b1 = *(const LAS bf16x8*)(Kp + PSWZ(32 + r32, cb));
                    p0 = __builtin_amdgcn_mfma_f32_32x32x16_bf16(b0, qr[8 + d0], p0, 0, 0, 0);
                    p1 = __builtin_amdgcn_mfma_f32_32x32x16_bf16(b1, qr[8 + d0], p1, 0, 0, 0); }
            }
            if (BAND) {
                const int base = T * 64 - qi + a.side;
#pragma unroll
                for (int r = 0; r < 16; ++r) {
                    const int i0_ = base + crow(r, hi), i1_ = i0_ + 32;
                    const bool ok0 = (unsigned)i0_ <= (unsigned)(2 * a.side), ok1 = (unsigned)i1_ <= (unsigned)(2 * a.side);
                    const float b0 = lut[ok0 ? i0_ : 0], b1 = lut[ok1 ? i1_ : 0];
                    p0[r] = ok0 ? fmaf(p0[r], a.C, b0) : -1e30f; p1[r] = ok1 ? fmaf(p1[r], a.C, b1) : -1e30f;
                }
            } else {
#pragma unroll
                for (int r = 0; r < 16; ++r) { p0[r] *= a.C; p1[r] *= a.C; }
            }
            float pmax = p0[0];
#pragma unroll
            for (int r = 1; r < 16; ++r) pmax = fmaxf(pmax, p0[r]);
#pragma unroll
            for (int r = 0; r < 16; ++r) pmax = fmaxf(pmax, p1[r]);
            { auto rr = __builtin_amdgcn_permlane32_swap(__float_as_uint(pmax), __float_as_uint(pmax), false, false);
              pmax = fmaxf(__uint_as_float(rr[0]), __uint_as_float(rr[1])); }
            const float mn = fmaxf(m_reg, pmax);
            const float alpha = __builtin_amdgcn_exp2f(m_reg - mn);
            m_reg = mn;
            float ps = 0.f;
#pragma unroll
            for (int r = 0; r < 16; ++r) { p0[r] = __builtin_amdgcn_exp2f(p0[r] - mn); p1[r] = __builtin_amdgcn_exp2f(p1[r] - mn); ps += p0[r] + p1[r]; }
            { auto rr = __builtin_amdgcn_permlane32_swap(__float_as_uint(ps), __float_as_uint(ps), false, false);
              ps = __uint_as_float(rr[0]) + __uint_as_float(rr[1]); }
            l_reg = l_reg * alpha + ps;
            if (__any(alpha < 1.f)) {
                if (hi == 0) al_l[r32] = alpha;
                asm volatile("s_waitcnt lgkmcnt(0)" ::: "memory");
#pragma unroll
                for (int r = 0; r < 16; ++r) { const float al = al_l[crow(r, hi)];
#pragma unroll
                    for (int d = 0; d < 4; ++d) o[d][r] *= al; }
            }
            bf16x8 pa0, pa1, pa2, pa3;
#define PK4(P, BASE, OUT) do { unsigned a0 = cvtpk(P[BASE + 0], P[BASE + 1]), a1 = cvtpk(P[BASE + 2], P[BASE + 3]);   \
    unsigned b0 = cvtpk(P[BASE + 4], P[BASE + 5]), b1 = cvtpk(P[BASE + 6], P[BASE + 7]);                              \
    auto r0 = __builtin_amdgcn_permlane32_swap(a0, b0, false, false); auto r1 = __builtin_amdgcn_permlane32_swap(a1, b1, false, false); \
    u32x4 w = {r0[0], r1[0], r0[1], r1[1]}; OUT = *reinterpret_cast<bf16x8*>(&w); } while (0)
            PK4(p0, 0, pa0); PK4(p0, 8, pa1); PK4(p1, 0, pa2); PK4(p1, 8, pa3);
#undef PK4
            pv_one<0>(o[0], vb0, pa0, pa1, pa2, pa3); pv_one<1>(o[1], vb0, pa0, pa1, pa2, pa3);
            pv_one<2>(o[2], vb0, pa0, pa1, pa2, pa3); pv_one<3>(o[3], vb0, pa0, pa1, pa2, pa3);
        }
    }
#undef ALOAD
    if (SINK) l_reg += __builtin_amdgcn_exp2f(a.sink2 - m_reg);
    if (hi == 0) li_l[r32] = l_reg;
    if (WLSE) { if (hi == 0) a.lse[(long)qi * a.ldl] = (m_reg + __builtin_amdgcn_logf(l_reg)) * LN2; }
    asm volatile("s_waitcnt lgkmcnt(0)" ::: "memory");
#pragma unroll
    for (int r = 0; r < 16; ++r) {
        const int row = crow(r, hi);
        const float rl = __builtin_amdgcn_rcpf(li_l[row]);
        const long i = a.i0 + wid * 32 + row;
        const bf16_t* gp = a.G + i * a.ldg + r32; bf16_t* op = a.O + i * a.ldo + r32;
#pragma unroll
        for (int d0 = 0; d0 < 4; ++d0) {
            const float g = bf2f(gp[d0 * 32]);
            const float sg = g / (1.0f + __expf(-g));
            op[d0 * 32] = f2bf(o[d0][r] * rl * sg);
        }
    }
}

__device__ __forceinline__ void attn_phase(lds_u8* lds, const Params& p, int layer, int wg, int nwg) {
    unsigned char* ws = p.ws;
    const bf16_t* proj = (const bf16_t*)(ws + WS_PROJ);
    bf16_t* mixed = (bf16_t*)(ws + WS_MIXED);
    const float2* cs = (const float2*)(ws + WS_CS);
    constexpr int NA = 256, NC = 256, ND = 256, NBU = 384;
    for (int it = wg; it < NA + NC + ND + NBU; it += nwg) {
        AttnArgs a; a.lse = nullptr; a.ldl = 0; a.cs = cs; a.side = 0; a.dil = 1; a.bias = p.rel_bias; a.bcol = 0; a.sink2 = 0.f; a.K2 = nullptr; a.ldk2 = 0; a.L = SEQ;
        if (it < NA) {
            const int c = it, xcd = c & 7, slot = c >> 3, bh = xcd * 2 + (slot >> 4), qb = slot & 15, b = bh >> 3, h = bh & 7;
            const size_t t0 = (size_t)b * SEQ;
            const bf16_t* qraw = (const bf16_t*)(ws + WS_QRAW); const bf16_t* kvraw = (const bf16_t*)(ws + WS_KVRAW); const bf16_t* kpe = (const bf16_t*)(ws + WS_KPE);
            a.Q = qraw + t0 * 1536 + h * 192; a.ldq = 1536;
            a.K = kvraw + t0 * 2048 + h * 256; a.ldk = 2048; a.K2 = kpe + t0 * 64; a.ldk2 = 64;
            a.V = kvraw + t0 * 2048 + h * 256 + 128; a.ldv = 2048;
            a.G = proj + t0 * NINP + C_GATE + MX_A + h * 128; a.ldg = NINP;
            a.O = mixed + t0 * MIXW + MX_A + h * 128; a.ldo = MIXW;
            a.i0 = qb * 256; a.C = 0.07216878364870322f * LOG2E;
            attn_unit<192, false, false, false, true>(lds, a);
        } else if (it < NA + NC) {
            const int c = it - NA, xcd = c & 7, slot = c >> 3, pair = xcd * 2 + (slot >> 4), qb = slot & 15, b = pair >> 3, hq = pair & 7, hk = hq >> 2;
            const size_t t0 = (size_t)b * SEQ;
            const bf16_t* qc = (const bf16_t*)(ws + WS_QC); const bf16_t* kc = (const bf16_t*)(ws + WS_KC);
            a.Q = qc + t0 * 1024 + hq * 128; a.ldq = 1024;
            a.K = kc + t0 * 256 + hk * 128; a.ldk = 256;
            a.V = proj + t0 * NINP + C_CV + hk * 128; a.ldv = NINP;
            a.G = proj + t0 * NINP + C_GATE + MX_C + hq * 128; a.ldg = NINP;
            a.O = mixed + t0 * MIXW + MX_C + hq * 128; a.ldo = MIXW;
            a.i0 = qb * 256; a.C = 0.08838834764831845f * LOG2E;
            attn_unit<128, false, false, false, false>(lds, a);
        } else if (it < NA + NC + ND) {
            const int c = it - NA - NC, qb = c & 15, hq = (c >> 4) & 7, b = c >> 7, hk = hq >> 2;
            const size_t t0 = (size_t)b * SEQ;
            a.Q = proj + t0 * NINP + C_DQ + hq * 128; a.ldq = NINP;
            a.K = proj + t0 * NINP + C_DK + hk * 128; a.ldk = NINP;
            a.V = proj + t0 * NINP + C_DV + hk * 128; a.ldv = NINP;
            a.G = proj + t0 * NINP + C_GATE + MX_D + hq * 128; a.ldg = NINP;
            a.O = mixed + t0 * MIXW + MX_D + hq * 128; a.ldo = MIXW;
            a.i0 = qb * 256; a.side = 128; a.dil = 1; a.bcol = 12 + hq; a.C = 0.08838834764831845f * LOG2E;
            a.sink2 = p.sinks[layer * 8 + hq] * LOG2E;
            attn_unit<128, true, true, false, false>(lds, a);
        } else {
            const int c = it - NA - NC - ND, u = c & 15, hh = (c >> 4) & 3, j = (c >> 6) % 3, b = c / 192;
            const int dil = (j == 0) ? 1 : (j == 1 ? 4 : 16), L = SEQ / dil, nblk = L / 256, r = u / nblk, qb = u % nblk;
            const size_t t0 = (size_t)b * SEQ + r; const int head = j * 4 + hh;
            a.Q = proj + t0 * NINP + C_BQ + head * 128; a.ldq = (long)dil * NINP;
            a.K = proj + t0 * NINP + C_BK + head * 128; a.ldk = (long)dil * NINP;
            a.V = proj + t0 * NINP + C_BV + head * 128; a.ldv = (long)dil * NINP;
            a.G = proj + t0 * NINP + C_GATE + MX_B + head * 128; a.ldg = (long)dil * NINP;
            a.O = mixed + t0 * MIXW + MX_B + head * 128; a.ldo = (long)dil * MIXW;
            a.lse = (float*)(ws + WS_LSE) + ((size_t)j * MTOK + t0) * 4 + hh; a.ldl = (long)dil * 4;
            a.i0 = qb * 256; a.L = L; a.side = 64; a.dil = dil; a.bcol = head; a.C = 0.08838834764831845f * LOG2E;
            attn_unit<128, true, false, true, false>(lds, a);
        }
    }
}

__global__ void __launch_bounds__(512) hymba_fwd(Params p0) {
    extern __shared__ __attribute__((aligned(16))) unsigned char shm[];
    lds_u8* lds = (lds_u8*)shm;
    cg::grid_group grid = cg::this_grid();
    const int wg0 = blockIdx.x, nwg0 = gridDim.x;
    const int lo = p0.ph_lo, hi = p0.ph_hi;
    int ph = 0;
#define PH_BEGIN if (lo <= ph && ph < hi) { auto kp4 = (__attribute__((address_space(4))) const char*)__builtin_amdgcn_kernarg_segment_ptr(); asm volatile("" : "+s"(kp4)); \
    const Params& p = *(const Params*)kp4; unsigned char* ws = p.ws; int wg = wg0, nwg = nwg0; asm volatile("" : "+s"(wg), "+s"(nwg)); \
    bf16_t* WinT = (bf16_t*)(ws + WS_WIN); bf16_t* WoutT = (bf16_t*)(ws + WS_WOUT); bf16_t* WuqT = (bf16_t*)(ws + WS_WUQ); bf16_t* WukvT = (bf16_t*)(ws + WS_WUKV); \
    bf16_t* H = (bf16_t*)(ws + WS_H); bf16_t* PROJ = (bf16_t*)(ws + WS_PROJ); float* X1 = (float*)(ws + WS_X1); \
    bf16_t* QAN = (bf16_t*)(ws + WS_QAN); bf16_t* KVAN = (bf16_t*)(ws + WS_KVAN); bf16_t* KPE = (bf16_t*)(ws + WS_KPE); \
    bf16_t* QRAW = (bf16_t*)(ws + WS_QRAW); bf16_t* KVRAW = (bf16_t*)(ws + WS_KVRAW); bf16_t* QC = (bf16_t*)(ws + WS_QC); bf16_t* KC = (bf16_t*)(ws + WS_KC); \
    bf16_t* MIXED = (bf16_t*)(ws + WS_MIXED); float* LSE = (float*)(ws + WS_LSE); float2* CS = (float2*)(ws + WS_CS); \
    (void)WinT; (void)WoutT; (void)WuqT; (void)WukvT; (void)H; (void)PROJ; (void)X1; (void)QAN; (void)KVAN; (void)KPE; (void)QRAW; (void)KVRAW; (void)QC; (void)KC; (void)MIXED; (void)LSE; (void)CS;
#define PH_END } if (lo <= ph && ph + 1 < hi) grid.sync(); ++ph;

    PH_BEGIN
        for (int l = 0; l < 2; ++l) {
            cvt_transpose(p.w_in + (size_t)l * DM * NIN, WinT + (size_t)l * NINP * DM, DM, NIN, NINP, lds, wg, nwg);
            cvt_transpose(p.w_out + (size_t)l * MIXW * DM, WoutT + (size_t)l * DM * MIXW, MIXW, DM, DM, lds, wg, nwg);
            cvt_transpose(p.w_uq + (size_t)l * 768 * 1536, WuqT + (size_t)l * 1536 * 768, 768, 1536, 1536, lds, wg, nwg);
            cvt_transpose(p.w_ukv + (size_t)l * 512 * 2048, WukvT + (size_t)l * 2048 * 512, 512, 2048, 2048, lds, wg, nwg);
        }
        build_cs(CS, wg, nwg);
        rmsnorm_rows<true>(p.x, p.g_attn, H, nullptr, lds, wg, nwg);
    PH_END

#pragma unroll 1
    for (int l = 0; l < 2; ++l) {
        if (l > 0) {
            PH_BEGIN
                rmsnorm_rows<true>(X1, p.g_attn + (size_t)l * DM, H, nullptr, lds, wg, nwg);
            PH_END
        }
        PH_BEGIN
#ifndef NO_GEMM
            pg8::Gemm g{H, WinT + (size_t)l * NINP * DM, MTOK, NINP, DM}; pg8::StaticOrder S; S.init(MTOK, NINP, nwg, wg);
            pg8::EpiBf16P E{PROJ, NINP};
            pg8::gemm_phase<pg8::EpiBf16P, pg8::StaticOrder, false>(lds, g, S, E, nullptr);
#endif
        PH_END
        PH_BEGIN
            prep_tokens(PROJ, p.g_qa + l * 768, p.g_kva + l * 512, p.g_qn + l * 128, p.g_kn + l * 128, CS, QAN, KVAN, KPE, QC, KC, wg, nwg);
        PH_END
        PH_BEGIN
#ifndef NO_GEMM
            { pg8::Gemm g{QAN, WuqT + (size_t)l * 1536 * 768, MTOK, 1536, 768}; pg8::StaticOrder S; S.init(MTOK, 1536, nwg, wg);
              pg8::EpiBf16P E{QRAW, 1536};
              pg8::gemm_phase<pg8::EpiBf16P, pg8::StaticOrder, false>(lds, g, S, E, nullptr); }
            { pg8::Gemm g{KVAN, WukvT + (size_t)l * 2048 * 512, MTOK, 2048, 512}; pg8::StaticOrder S; S.init(MTOK, 2048, nwg, nwg - 1 - wg);
              pg8::EpiBf16P E{KVRAW, 2048};
              pg8::gemm_phase<pg8::EpiBf16P, pg8::StaticOrder, false>(lds, g, S, E, nullptr); }
#endif
        PH_END
        PH_BEGIN
#ifndef NO_ATTN
            attn_phase(lds, p, l, wg, nwg);
#endif
        PH_END
        PH_BEGIN
            fixup_b(MIXED, LSE, wg, nwg);
        PH_END
        PH_BEGIN
#ifndef NO_GEMM
            pg8::Gemm g{MIXED, WoutT + (size_t)l * DM * MIXW, MTOK, DM, MIXW}; pg8::StaticOrder S; S.init(MTOK, DM, nwg, wg);
            const float* xin = (l == 0) ? p.x : X1; float* xout = (l == 0) ? X1 : p.out;
            pg8::EpiResF32 E{xin, xout, DM};
            pg8::gemm_phase<pg8::EpiResF32, pg8::StaticOrder, false>(lds, g, S, E, nullptr);
#endif
        PH_END
    }
    PH_BEGIN
        rmsnorm_rows<false>(p.out, p.g_final, nullptr, p.out, lds, wg, nwg);
    PH_END
#undef PH_BEGIN
#undef PH_END
}

constexpr int N_PHASES = 15;

extern "C" void kernel_launch(void* const* d_in, const int* in_sizes, int n_in, void* d_out, int out_size, void* d_ws, size_t ws_size, hipStream_t stream) {
    static int grid_blocks = 0;
    if (grid_blocks == 0) {
        if (n_in != 13 || ws_size < WS_END || out_size != MTOK * DM) { fprintf(stderr, "kernel_launch: unexpected shapes (n_in %d, out %d, ws %zu, need %zu)\n", n_in, out_size, ws_size, (size_t)WS_END); grid_blocks = -1; return; }
        int dev = 0, cus = 0, per_cu = 0;
        hipGetDevice(&dev);
        hipDeviceGetAttribute(&cus, hipDeviceAttributeMultiprocessorCount, dev);
        if (hipFuncSetAttribute((const void*)hymba_fwd, hipFuncAttributeMaxDynamicSharedMemorySize, LDS_BYTES) != hipSuccess) { fprintf(stderr, "kernel_launch: hipFuncSetAttribute failed\n"); grid_blocks = -1; return; }
        if (hipOccupancyMaxActiveBlocksPerMultiprocessor(&per_cu, (const void*)hymba_fwd, 512, LDS_BYTES) != hipSuccess || per_cu < 1) { fprintf(stderr, "kernel_launch: occupancy query gave %d\n", per_cu); per_cu = 1; }
        (void)hipGetLastError();
        grid_blocks = cus * 1;
        fprintf(stderr, "kernel_launch: cus %d per_cu %d grid %d\n", cus, per_cu, grid_blocks);
    }
    if (grid_blocks < 0) return;
    Params p{};
    p.x = (const float*)d_in[0]; p.g_attn = (const float*)d_in[1]; p.w_in = (const float*)d_in[2]; p.g_qa = (const float*)d_in[3]; p.g_kva = (const float*)d_in[4];
    p.w_uq = (const float*)d_in[5]; p.w_ukv = (const float*)d_in[6]; p.g_qn = (const float*)d_in[7]; p.g_kn = (const float*)d_in[8]; p.sinks = (const float*)d_in[9];
    p.w_out = (const float*)d_in[10]; p.rel_bias = (const float*)d_in[11]; p.g_final = (const float*)d_in[12];
    p.out = (float*)d_out; p.ws = (unsigned char*)d_ws;
#if defined(MULTI_LAUNCH)
    for (int k = 0; k < N_PHASES; ++k) { p.ph_lo = k; p.ph_hi = k + 1; hipLaunchKernelGGL(hymba_fwd, dim3(grid_blocks), dim3(512), LDS_BYTES, stream, p); }
#else
    p.ph_lo = 0; p.ph_hi = N_PHASES;
    void* args[] = {&p};
    hipError_t e = hipLaunchCooperativeKernel((const void*)hymba_fwd, dim3(grid_blocks), dim3(512), args, LDS_BYTES, stream);
    if (e != hipSuccess) fprintf(stderr, "cooperative launch failed: %s (grid %d)\n", hipGetErrorString(e), grid_blocks);
#endif
}
```

```cpp
#include <hip/hip_runtime.h>
#include <hip/hip_cooperative_groups.h>
#include <cstdio>
namespace cg = cooperative_groups;
namespace pg8 {
#define PG8_LAS __attribute__((address_space(3)))
typedef unsigned short bf16_t;
__device__ __forceinline__ int opaque_tid() { int t = threadIdx.x; asm volatile("" : "+v"(t)); return t; }
typedef short bf16x8 __attribute__((ext_vector_type(8)));
typedef float f32x4 __attribute__((ext_vector_type(4)));
typedef unsigned u32x4 __attribute__((ext_vector_type(4)));
constexpr int BM = 256, BK = 64, HALF = 128, HTB = HALF * BK * 2  , STAGE_BYTES = 8 * HTB, NXCD = 8, WGM = 8;

__host__ __device__ __forceinline__ int lds_byte(int r, int c) { const int st = (r >> 4) * 2 + (c >> 5), rr = r & 15, cc = c & 31, ob = rr * 64 + cc * 2; return st * 1024 + (ob ^ (((ob >> 9) & 1) << 5)); }
__host__ __device__ __forceinline__ void stage_rc(int b, int& R, int& C) { const int st = b / 1024, sb = b % 1024, swz = sb ^ (((sb >> 9) & 1) << 5); R = (st >> 1) * 16 + swz / 64; C = (st & 1) * 32 + (swz % 64) / 2; }
__host__ __device__ __forceinline__ int perm32(int rho) { const int n = rho >> 4, i = rho & 15; return 8 * (i >> 2) + 4 * n + (i & 3); }

struct Unit { int pm, pn; };
struct Gemm { const bf16_t* A; const bf16_t* Bt; int M, N, K; };
struct StaticOrder {
    int nM, nN, nwg, G, c;
    __host__ __device__ void init(int M, int N, int G_, int c_) { nM = M / BM; nN = N / BM; nwg = nM * nN; G = G_; c = c_; }
    __host__ __device__ bool next(int i, Unit& u) const {
        const long L = (long)i * G + c; if (L >= nwg) return false;
        int wgid = (int)L; { const int q = nwg / NXCD, r = nwg % NXCD, xcd = wgid % NXCD, off = wgid / NXCD; wgid = (xcd < r ? xcd * (q + 1) : r * (q + 1) + (xcd - r) * q) + off; }
        const int nig = WGM * nN, gid = wgid / nig, fm = gid * WGM, gsz = (nM - fm) < WGM ? (nM - fm) : WGM;
        u.pm = fm + ((wgid % nig) % gsz); u.pn = (wgid % nig) / gsz; return true;
    }
    __device__ __forceinline__ void a_ready(const Unit&) const {}
    __device__ __forceinline__ void done(const Unit&) const {}
};
__device__ __forceinline__ unsigned cvt_pk_bf16(float lo, float hi) { unsigned r; asm volatile("v_cvt_pk_bf16_f32 %0, %1, %2" : "=v"(r) : "v"(lo), "v"(hi)); return r; }
typedef float f32x2 __attribute__((ext_vector_type(2)));
struct EpiBf16P {
    static constexpr bool PERM = true, AFTER_DRAIN = false;
    bf16_t* O; int ldc;
    __device__ __forceinline__ void operator()(const f32x4 (&acc)[2][2][4][2], const Unit& u, int wr, int wc, int fr, int fq) const {
        const int row0 = u.pm * BM + wr * 64 + fr; const int col0 = u.pn * BM + wc * 32 + 8 * fq;
#pragma unroll
        for (int ai = 0; ai < 2; ++ai)
#pragma unroll
            for (int m = 0; m < 4; ++m) { bf16_t* rowp = O + (size_t)(row0 + ai * HALF + m * 16) * ldc + col0;
#pragma unroll
                for (int bj = 0; bj < 2; ++bj) { const f32x4 v0 = acc[ai][bj][m][0], v1 = acc[ai][bj][m][1];
                    u32x4 w; w.x = cvt_pk_bf16(v0[0], v0[1]); w.y = cvt_pk_bf16(v0[2], v0[3]); w.z = cvt_pk_bf16(v1[0], v1[1]); w.w = cvt_pk_bf16(v1[2], v1[3]);
                    *(u32x4*)(rowp + bj * HALF) = w; } }
    }
};
struct EpiResF32 {
    static constexpr bool PERM = false, AFTER_DRAIN = false;
    const float* base; float* out; int ldc;
    __device__ __forceinline__ void operator()(const f32x4 (&acc)[2][2][4][2], const Unit& u, int wr, int wc, int fr, int fq) const {
        const int row0 = u.pm * BM + wr * 64 + fr, col0 = u.pn * BM + wc * 32 + 4 * fq;
#pragma unroll
        for (int ai = 0; ai < 2; ++ai)
#pragma unroll
            for (int m = 0; m < 4; ++m) { const size_t off = (size_t)(row0 + ai * HALF + m * 16) * ldc + col0;
#pragma unroll
                for (int bj = 0; bj < 2; ++bj)
#pragma unroll
                    for (int n = 0; n < 2; ++n) { const f32x4 b = *(const f32x4*)(base + off + bj * HALF + n * 16); *(f32x4*)(out + off + bj * HALF + n * 16) = acc[ai][bj][m][n] + b; } }
    }
};
template <class Epi, class Sched, bool ALIGN_EPI = false, bool SP2 = false>
__device__ __forceinline__ void gemm_phase(PG8_LAS unsigned char* lds, const Gemm g, const Sched& S, const Epi& E) {
    const int tid = opaque_tid(), wid = __builtin_amdgcn_readfirstlane(tid >> 6), lane = tid & 63, wr = wid >> 2, wc = wid & 3, fr = lane & 15, fq = lane >> 4;
    const int K = g.K, nt = K / BK;
    unsigned voffA[2], voffB[2];
#pragma unroll
    for (int i = 0; i < 2; ++i) { int R, C; stage_rc(tid * 16 + i * 8192, R, C); const int Rb = Epi::PERM ? ((R & ~31) + perm32(R & 31)) : R;
        voffA[i] = (unsigned)(R * K + C) * 2u; voffB[i] = (unsigned)(Rb * K + C) * 2u; }
    const size_t kstep = (size_t)(BK * 2);
    const size_t hstep = (size_t)HALF * K * 2;
    const size_t tstep = 2 * hstep;
    const unsigned ldsw = (unsigned)wid * 1024u;
    const int aoff = lds_byte(wr * 64 + fr, fq * 8), boff = lds_byte(wc * 32 + fr, fq * 8);
#define PG8_SA(b, h) (((b) * 2 + (h)) * HTB)
#define PG8_SB(b, h) ((4 + (b) * 2 + (h)) * HTB)
#define PG8_STAGE(bufoff, gbase, voff) do { _Pragma("unroll") for (int _i = 0; _i < 2; ++_i) \
        __builtin_amdgcn_global_load_lds((const unsigned*)((const char*)(gbase) + (voff)[_i]), (PG8_LAS unsigned*)(lds + (bufoff) + ldsw + _i * 8192), 16, 0, 0); } while (0)
#define PG8_LDA(dst, b, h) do { _Pragma("unroll") for (int m = 0; m < 4; ++m) _Pragma("unroll") for (int k = 0; k < 2; ++k) dst[m][k] = *(const PG8_LAS bf16x8*)(lds + PG8_SA(b, h) + aoff + m * 2048 + k * 1024); } while (0)
#define PG8_LDB(dst, b, h) do { _Pragma("unroll") for (int n = 0; n < 2; ++n) _Pragma("unroll") for (int k = 0; k < 2; ++k) dst[n][k] = *(const PG8_LAS bf16x8*)(lds + PG8_SB(b, h) + boff + n * 2048 + k * 1024); } while (0)
#define PG8_MMA(ai, bj, At, Bt) do { __builtin_amdgcn_s_setprio(1); _Pragma("unroll") for (int m = 0; m < 4; ++m) _Pragma("unroll") for (int n = 0; n < 2; ++n) _Pragma("unroll") for (int k = 0; k < 2; ++k) \
        acc[ai][bj][m][n] = __builtin_amdgcn_mfma_f32_16x16x32_bf16(Bt[n][k], At[m][k], acc[ai][bj][m][n], 0, 0, 0); __builtin_amdgcn_s_setprio(0); } while (0)
#define PG8_WAIT_V(n) asm volatile("s_waitcnt vmcnt(" #n ")" ::: "memory")
#define PG8_WAIT_L(n) asm volatile("s_waitcnt lgkmcnt(" #n ")" ::: "memory")
#define PG8_BAR __builtin_amdgcn_s_barrier()
#define PG8_SCHED __builtin_amdgcn_sched_barrier(0)
    Unit cur, nxt; int ui = 0;
    if (!S.next(0, cur)) return;
    f32x4 acc[2][2][4][2];
#pragma unroll
    for (int a = 0; a < 2; ++a)
#pragma unroll
        for (int b = 0; b < 2; ++b)
#pragma unroll
            for (int m = 0; m < 4; ++m)
#pragma unroll
                for (int n = 0; n < 2; ++n) acc[a][b][m][n] = (f32x4){0.f, 0.f, 0.f, 0.f};
    bf16x8 At[4][2], B0[2][2], B1[2][2];
    const char* cA = (const char*)g.A + (size_t)cur.pm * tstep; const char* cB = (const char*)g.Bt + (size_t)cur.pn * tstep;
    S.a_ready(cur);
    if constexpr (SP2) {
        PG8_STAGE(PG8_SB(0, 0), cB, voffB); PG8_STAGE(PG8_SB(0, 1), cB + hstep, voffB); PG8_STAGE(PG8_SA(0, 0), cA, voffA); PG8_STAGE(PG8_SA(0, 1), cA + hstep, voffA);
        if (wr == 1) PG8_BAR;
        PG8_WAIT_V(2); PG8_BAR;
        PG8_STAGE(PG8_SB(1, 0), cB + kstep, voffB); PG8_STAGE(PG8_SA(1, 0), cA + kstep, voffA); PG8_STAGE(PG8_SB(1, 1), cB + hstep + kstep, voffB);
        PG8_WAIT_V(6); PG8_BAR;
    } else {
        PG8_STAGE(PG8_SB(0, 0), cB, voffB); PG8_STAGE(PG8_SA(0, 0), cA, voffA); PG8_STAGE(PG8_SB(0, 1), cB + hstep, voffB); PG8_STAGE(PG8_SA(0, 1), cA + hstep, voffA);
        if (wr == 1) PG8_BAR;
        PG8_WAIT_V(4); PG8_BAR;
        PG8_STAGE(PG8_SB(1, 0), cB + kstep, voffB); PG8_STAGE(PG8_SA(1, 0), cA + kstep, voffA); PG8_STAGE(PG8_SB(1, 1), cB + hstep + kstep, voffB);
        PG8_WAIT_V(6); PG8_BAR;
    }
    for (;;) {
        const bool has_next = S.next(ui + 1, nxt);
        const char* nA = has_next ? (const char*)g.A + (size_t)nxt.pm * tstep : cA; const char* nB = has_next ? (const char*)g.Bt + (size_t)nxt.pn * tstep : cB;
        for (int t = 0; t < nt; t += 2) {
            const bool last = (t == nt - 2);
            const char* a1 = cA + (size_t)(t + 1) * kstep;
            const char* a2 = last ? nA : cA + (size_t)(t + 2) * kstep; const char* b2 = last ? nB : cB + (size_t)(t + 2) * kstep;
            const char* a3 = a2 + kstep; const char* b3 = b2 + kstep;
            if (last && has_next) S.a_ready(nxt);
            if constexpr (SP2) {
            PG8_LDB(B0, 0, 0); PG8_LDB(B1, 0, 1); PG8_SCHED; PG8_LDA(At, 0, 0); PG8_STAGE(PG8_SA(1, 1), a1 + hstep, voffA);
            PG8_WAIT_V(8); PG8_WAIT_L(0); PG8_BAR; PG8_MMA(0, 0, At, B0); PG8_MMA(0, 1, At, B1); PG8_BAR; PG8_SCHED;
            PG8_LDA(At, 0, 1); PG8_STAGE(PG8_SB(0, 0), b2, voffB); PG8_STAGE(PG8_SB(0, 1), b2 + hstep, voffB); PG8_STAGE(PG8_SA(0, 0), a2, voffA);
            PG8_WAIT_V(8); PG8_WAIT_L(0); PG8_BAR; PG8_MMA(1, 0, At, B0); PG8_MMA(1, 1, At, B1); PG8_BAR; PG8_SCHED;
            PG8_LDB(B0, 1, 0); PG8_LDB(B1, 1, 1); PG8_SCHED; PG8_LDA(At, 1, 0); PG8_STAGE(PG8_SA(0, 1), a2 + hstep, voffA);
            PG8_WAIT_V(8); PG8_WAIT_L(0); PG8_BAR; PG8_MMA(0, 0, At, B0); PG8_MMA(0, 1, At, B1); PG8_BAR; PG8_SCHED;
            PG8_LDA(At, 1, 1); PG8_STAGE(PG8_SB(1, 0), b3, voffB); PG8_STAGE(PG8_SB(1, 1), b3 + hstep, voffB); PG8_STAGE(PG8_SA(1, 0), a3, voffA);
            PG8_WAIT_V(8); PG8_WAIT_L(0); PG8_BAR; PG8_MMA(1, 0, At, B0); PG8_MMA(1, 1, At, B1); PG8_BAR; PG8_SCHED;
            } else {
            PG8_LDB(B0, 0, 0); PG8_SCHED; PG8_LDA(At, 0, 0); PG8_STAGE(PG8_SA(1, 1), a1 + hstep, voffA);
            PG8_WAIT_L(8); PG8_BAR; PG8_WAIT_L(0); PG8_MMA(0, 0, At, B0); PG8_BAR; PG8_SCHED;
            PG8_LDB(B1, 0, 1); PG8_STAGE(PG8_SB(0, 0), b2, voffB);
            PG8_BAR; PG8_WAIT_L(0); PG8_MMA(0, 1, At, B1); PG8_BAR;
            PG8_LDA(At, 0, 1); PG8_STAGE(PG8_SA(0, 0), a2, voffA);
            PG8_BAR; PG8_WAIT_L(0); PG8_MMA(1, 0, At, B0); PG8_BAR; PG8_SCHED;
            PG8_STAGE(PG8_SB(0, 1), b2 + hstep, voffB);
            PG8_WAIT_V(6); PG8_BAR; PG8_MMA(1, 1, At, B1); PG8_BAR;
            PG8_LDB(B0, 1, 0); PG8_SCHED; PG8_LDA(At, 1, 0); PG8_STAGE(PG8_SA(0, 1), a2 + hstep, voffA);
            PG8_WAIT_L(8); PG8_BAR; PG8_WAIT_L(0); PG8_MMA(0, 0, At, B0); PG8_BAR; PG8_SCHED;
            PG8_LDB(B1, 1, 1); PG8_STAGE(PG8_SB(1, 0), b3, voffB);
            PG8_BAR; PG8_WAIT_L(0); PG8_MMA(0, 1, At, B1); PG8_BAR;
            PG8_LDA(At, 1, 1); PG8_STAGE(PG8_SA(1, 0), a3, voffA);
            PG8_BAR; PG8_WAIT_L(0); PG8_MMA(1, 0, At, B0); PG8_BAR; PG8_SCHED;
            PG8_STAGE(PG8_SB(1, 1), b3 + hstep, voffB);
            PG8_WAIT_V(6); PG8_BAR; PG8_MMA(1, 1, At, B1); PG8_BAR;
            }
        }
        if constexpr (ALIGN_EPI) { if (wr == 0) PG8_BAR; }
        if constexpr (!Epi::AFTER_DRAIN) { E(acc, cur, wr, wc, fr, fq); S.done(cur); }
        if (!has_next) break;
#pragma unroll
        for (int a = 0; a < 2; ++a)
#pragma unroll
            for (int b = 0; b < 2; ++b)
#pragma unroll
                for (int m = 0; m < 4; ++m)
#pragma unroll
                    for (int n = 0; n < 2; ++n) acc[a][b][m][n] = (f32x4){0.f, 0.f, 0.f, 0.f};
        cur = nxt; cA = nA; cB = nB; ++ui;
        if constexpr (ALIGN_EPI) { if (wr == 1) PG8_BAR; }
    }
    PG8_WAIT_V(0);
    if constexpr (!ALIGN_EPI) { if (wr == 0) PG8_BAR; }
    PG8_BAR;
    if constexpr (Epi::AFTER_DRAIN) { E.fused(acc, cur, wr, wc, fr, fq, lds, wid, lane); S.done(cur); }
#undef PG8_SA
#undef PG8_SB
#undef PG8_STAGE
#undef PG8_LDA
#undef PG8_LDB
#undef PG8_MMA
#undef PG8_WAIT_V
#undef PG8_WAIT_L
#undef PG8_BAR
#undef PG8_SCHED
}
}

typedef pg8::bf16_t bf16_t;
typedef pg8::bf16x8 bf16x8;
typedef pg8::f32x4 f32x4;
typedef pg8::u32x4 u32x4;
typedef short s16x4 __attribute__((ext_vector_type(4)));
typedef float f32x16 __attribute__((ext_vector_type(16)));
typedef unsigned u32x2 __attribute__((ext_vector_type(2)));
#define LAS __attribute__((address_space(3)))
typedef LAS unsigned char lds_u8;

constexpr int SEQ = 4096, NBATCH = 2, MTOK = 8192, DM = 4096, NIN = 13632, NINP = 13824, MIXW = 4608;
constexpr int C_ACQ = 0, C_ACKV = 768, C_KPE = 1280, C_BQ = 1344, C_BK = 2880, C_BV = 4416, C_CQ = 5952, C_CK = 6976, C_CV = 7232,
              C_DQ = 7488, C_DK = 8512, C_DV = 8768, C_GATE = 9024;
constexpr int MX_A = 0, MX_B = 1024, MX_C = 2560, MX_D = 3584;
constexpr float EPS = 1e-6f;
constexpr float LOG2E = 1.4426950408889634f, LN2 = 0.6931471805599453f;

constexpr size_t AL(size_t x) { return (x + 255) / 256 * 256; }
constexpr size_t WS_WIN   = 0;
constexpr size_t WS_WOUT  = WS_WIN   + AL((size_t)2 * NINP * DM * 2);
constexpr size_t WS_WUQ   = WS_WOUT  + AL((size_t)2 * DM * MIXW * 2);
constexpr size_t WS_WUKV  = WS_WUQ   + AL((size_t)2 * 1536 * 768 * 2);
constexpr size_t WS_H     = WS_WUKV  + AL((size_t)2 * 2048 * 512 * 2);
constexpr size_t WS_PROJ  = WS_H     + AL((size_t)MTOK * DM * 2);
constexpr size_t WS_X1    = WS_PROJ  + AL((size_t)MTOK * NINP * 2);
constexpr size_t WS_QAN   = WS_X1    + AL((size_t)MTOK * DM * 4);
constexpr size_t WS_KVAN  = WS_QAN   + AL((size_t)MTOK * 768 * 2);
constexpr size_t WS_KPE   = WS_KVAN  + AL((size_t)MTOK * 512 * 2);
constexpr size_t WS_QRAW  = WS_KPE   + AL((size_t)MTOK * 64 * 2);
constexpr size_t WS_KVRAW = WS_QRAW  + AL((size_t)MTOK * 1536 * 2);
constexpr size_t WS_QC    = WS_KVRAW + AL((size_t)MTOK * 2048 * 2);
constexpr size_t WS_KC    = WS_QC    + AL((size_t)MTOK * 1024 * 2);
constexpr size_t WS_MIXED = WS_KC    + AL((size_t)MTOK * 256 * 2);
constexpr size_t WS_LSE   = WS_MIXED + AL((size_t)MTOK * MIXW * 2);
constexpr size_t WS_CS    = WS_LSE   + AL((size_t)3 * MTOK * 4 * 4);
constexpr size_t WS_DELTA = WS_CS    + AL((size_t)SEQ * 32 * 8);
constexpr size_t WS_DKV   = WS_DELTA + AL((size_t)2 * MTOK * DM * 2);
constexpr size_t WS_BAR   = WS_DKV   + AL((size_t)MTOK * 512 * 2);
constexpr size_t WS_END   = WS_BAR   + AL((size_t)3456 * 4);

constexpr int LDS_BYTES = 141312;

#ifndef REP_GEMM
#define REP_GEMM 1
#endif
#ifndef REP_OUT
#define REP_OUT 1
#endif
#ifndef REP_UP
#define REP_UP 1
#endif
#ifndef REP_SYNC
#define REP_SYNC 0
#endif
#ifndef REP_BAND
#define REP_BAND 1
#endif
#ifndef REP_A
#define REP_A 1
#endif
#ifndef REP_C
#define REP_C 1
#endif
#ifndef HIDE_TAIL
#define HIDE_TAIL 0
#endif
#ifndef CVT_P0_LAYERS
#define CVT_P0_LAYERS 2
#endif
#ifndef GEMM_ALIGN
#define GEMM_ALIGN true
#endif
#ifndef GEMM_SP2
#define GEMM_SP2 true
#endif
#ifndef REP_D
#define REP_D 1
#endif
#ifndef REP_B
#define REP_B 1
#endif
#ifndef REP_ATTN
#define REP_ATTN 1
#endif
#ifndef REP_CVT
#define REP_CVT 1
#endif
#ifndef REP_MISC
#define REP_MISC 1
#endif
struct Params {
    const float *x, *g_attn, *w_in, *g_qa, *g_kva, *w_uq, *w_ukv, *g_qn, *g_kn, *sinks, *w_out, *rel_bias, *g_final;
    float* out; unsigned char* ws; int ph_lo, ph_hi;
};

__device__ __forceinline__ bf16_t f2bf(float f) { unsigned u = __float_as_uint(f); u += 0x7FFFu + ((u >> 16) & 1u); return (bf16_t)(u >> 16); }
__device__ __forceinline__ float bf2f(bf16_t b) { return __uint_as_float(((unsigned)b) << 16); }
__device__ __forceinline__ float bflo(unsigned w) { return __uint_as_float(w << 16); }
__device__ __forceinline__ float bfhi(unsigned w) { return __uint_as_float(w & 0xffff0000u); }
__device__ __forceinline__ unsigned cvtpk(float lo, float hi) { unsigned r; asm volatile("v_cvt_pk_bf16_f32 %0, %1, %2" : "=v"(r) : "v"(lo), "v"(hi)); return r; }
__device__ __forceinline__ float wave_sum(float v) {
#pragma unroll
    for (int o = 32; o >= 1; o >>= 1) v += __shfl_xor(v, o);
    return v;
}
__device__ __forceinline__ int rel_bucket(int rel) {
    const int n = rel < 0 ? -rel : rel; int b;
    if (n < 8) b = n;
    else b = 8 + (n >= 15) + (n >= 27) + (n >= 50) + (n >= 91) + (n >= 166) + (n >= 305) + (n >= 559);
    return b + (rel > 0 ? 16 : 0);
}

constexpr int CVT_NQ = 4;
__device__ __forceinline__ void cvt_transpose(const float* __restrict__ src, bf16_t* __restrict__ dst, int K, int N, int Npad, lds_u8* lds, int wg, int nwg) {
    LAS float* tile = (LAS float*)lds;
    const int tid = pg8::opaque_tid(), tn4 = Npad / (64 * CVT_NQ), tk = K / 64;
    __syncthreads();
    for (int t = wg; t < tn4 * tk; t += nwg) {
        const int nt4 = t % tn4, kt = t / tn4;
        f32x4 v[CVT_NQ][2];
#pragma unroll
        for (int q = 0; q < CVT_NQ; ++q)
#pragma unroll
            for (int i = 0; i < 2; ++i) {
                const int row = (tid >> 4) + 32 * i, c4 = (tid & 15) * 4, n = (nt4 * CVT_NQ + q) * 64 + c4;
                v[q][i] = (f32x4){0.f, 0.f, 0.f, 0.f};
                if (n < N) v[q][i] = __builtin_nontemporal_load((const f32x4*)(src + (size_t)(kt * 64 + row) * N + n));
            }
#pragma unroll
        for (int q = 0; q < CVT_NQ; ++q)
#pragma unroll
            for (int i = 0; i < 2; ++i) {
                const int row = (tid >> 4) + 32 * i, c4 = (tid & 15) * 4;
                LAS float* tp = tile + q * (64 * 65) + row * 65 + c4;
                tp[0] = v[q][i][0]; tp[1] = v[q][i][1]; tp[2] = v[q][i][2]; tp[3] = v[q][i][3];
            }
        __syncthreads();
#pragma unroll
        for (int q = 0; q < CVT_NQ; ++q) {
            const int nl = tid >> 3, kc = (tid & 7) * 8;
            float f[8];
#pragma unroll
            for (int j = 0; j < 8; ++j) f[j] = tile[q * (64 * 65) + (kc + j) * 65 + nl];
            u32x4 w; w.x = cvtpk(f[0], f[1]); w.y = cvtpk(f[2], f[3]); w.z = cvtpk(f[4], f[5]); w.w = cvtpk(f[6], f[7]);
            *(u32x4*)(dst + (size_t)((nt4 * CVT_NQ + q) * 64 + nl) * K + kt * 64 + kc) = w;
        }
        __syncthreads();
    }
}

__device__ __forceinline__ void build_cs(float2* cs, int wg, int nwg) {
    for (int idx = wg * 512 + pg8::opaque_tid(); idx < SEQ * 32; idx += nwg * 512) {
        const int pos = idx >> 5, i = idx & 31;
        const float inv = exp2f(-(float)i * (13.287712379549449f / 32.0f));
        const float ang = (float)pos * inv;
        const float k = rintf(ang * 0.15915494309189535f);
        float r = fmaf(-k, 6.2831854820251465f, ang); r = fmaf(-k, -1.7484555e-7f, r);
        cs[idx] = make_float2(__cosf(r), __sinf(r));
    }
}

template <int NDELTA, bool TO_BF16>
__device__ __forceinline__ void rmsnorm_rows(const float* __restrict__ x, const bf16_t* __restrict__ delta0, const bf16_t* __restrict__ delta1, const float* __restrict__ g,
                                             bf16_t* __restrict__ hout, float* __restrict__ fout, int wg, int nwg) {
    const int tid = pg8::opaque_tid(), wid = tid >> 6, lane = tid & 63;
    f32x4 gk[16];
#pragma unroll
    for (int k = 0; k < 16; ++k) gk[k] = *(const f32x4*)(g + k * 256 + lane * 4);
    for (int row = wg * 8 + wid; row < MTOK; row += nwg * 8) {
        const float* xr = x + (size_t)row * DM + lane * 4;
        f32x4 v[16];
#pragma unroll
        for (int k = 0; k < 16; ++k) v[k] = __builtin_nontemporal_load((const f32x4*)(xr + k * 256));
        if (NDELTA >= 1) {
            u32x2 d[16];
#pragma unroll
            for (int k = 0; k < 16; ++k) d[k] = __builtin_nontemporal_load((const u32x2*)(delta0 + (size_t)row * DM + k * 256 + lane * 4));
#pragma unroll
            for (int k = 0; k < 16; ++k) { v[k][0] += bflo(d[k].x); v[k][1] += bfhi(d[k].x); v[k][2] += bflo(d[k].y); v[k][3] += bfhi(d[k].y); }
        }
        if (NDELTA >= 2) {
            u32x2 d[16];
#pragma unroll
            for (int k = 0; k < 16; ++k) d[k] = __builtin_nontemporal_load((const u32x2*)(delta1 + (size_t)row * DM + k * 256 + lane * 4));
#pragma unroll
            for (int k = 0; k < 16; ++k) { v[k][0] += bflo(d[k].x); v[k][1] += bfhi(d[k].x); v[k][2] += bflo(d[k].y); v[k][3] += bfhi(d[k].y); }
        }
        float ss = 0.f;
#pragma unroll
        for (int k = 0; k < 16; ++k) ss += v[k][0] * v[k][0] + v[k][1] * v[k][1] + v[k][2] * v[k][2] + v[k][3] * v[k][3];
        ss = wave_sum(ss);
        const float rstd = rsqrtf(ss * (1.0f / DM) + EPS);
#pragma unroll
        for (int k = 0; k < 16; ++k) {
            const f32x4 y = v[k] * rstd * gk[k];
            if (TO_BF16) { u32x2 w; w.x = cvtpk(y[0], y[1]); w.y = cvtpk(y[2], y[3]); *(u32x2*)(hout + (size_t)row * DM + k * 256 + lane * 4) = w; }
            else __builtin_nontemporal_store(y, (f32x4*)(fout + (size_t)row * DM + k * 256 + lane * 4));
        }
    }
}

__device__ __forceinline__ void prep_tokens(const bf16_t* __restrict__ proj, const float* __restrict__ g_qa, const float* __restrict__ g_kva,
                                            const float* __restrict__ g_qn, const float* __restrict__ g_kn, const float2* __restrict__ cs,
                                            bf16_t* __restrict__ qan, bf16_t* __restrict__ kvan, bf16_t* __restrict__ kpe, bf16_t* __restrict__ qc, bf16_t* __restrict__ kc, bf16_t* __restrict__ dkv, int wg, int nwg) {
    const int tid = pg8::opaque_tid(), wid = tid >> 6, lane = tid & 63, hf = lane >> 5, i = lane & 31;
    for (int t = wg * 8 + wid; t < MTOK; t += nwg * 8) {
        const bf16_t* pr = proj + (size_t)t * NINP;
        const int pos = t & (SEQ - 1);
        u32x2 wq[3], wk[2];
#pragma unroll
        for (int k = 0; k < 3; ++k) wq[k] = *(const u32x2*)(pr + C_ACQ + k * 256 + lane * 4);
#pragma unroll
        for (int k = 0; k < 2; ++k) wk[k] = *(const u32x2*)(pr + C_ACKV + k * 256 + lane * 4);
        bf16_t hv[5][4];
#pragma unroll
        for (int s = 0; s < 5; ++s)
#pragma unroll
            for (int q = 0; q < 4; ++q) hv[s][q] = pr[C_CQ + (2 * s + hf) * 128 + q * 32 + i];
        const bf16_t kp1 = pr[C_KPE + i], kp2 = pr[C_KPE + 32 + i];
        const float2 ct = cs[pos * 32 + i], crow_ = cs[(pos >> 6) * 32 + i], ccol = cs[(pos & 63) * 32 + i];
        {
            float v[12]; float ss = 0.f;
#pragma unroll
            for (int k = 0; k < 3; ++k) { v[4 * k] = bflo(wq[k].x); v[4 * k + 1] = bfhi(wq[k].x); v[4 * k + 2] = bflo(wq[k].y); v[4 * k + 3] = bfhi(wq[k].y); }
#pragma unroll
            for (int j = 0; j < 12; ++j) ss += v[j] * v[j];
            ss = wave_sum(ss);
            const float rstd = rsqrtf(ss * (1.0f / 768.0f) + EPS);
#pragma unroll
            for (int k = 0; k < 3; ++k) { const f32x4 gg = *(const f32x4*)(g_qa + k * 256 + lane * 4);
                u32x2 w; w.x = cvtpk(v[4 * k] * rstd * gg[0], v[4 * k + 1] * rstd * gg[1]); w.y = cvtpk(v[4 * k + 2] * rstd * gg[2], v[4 * k + 3] * rstd * gg[3]);
                *(u32x2*)(qan + (size_t)t * 768 + k * 256 + lane * 4) = w; }
        }
        {
            float v[8]; float ss = 0.f;
#pragma unroll
            for (int k = 0; k < 2; ++k) { v[4 * k] = bflo(wk[k].x); v[4 * k + 1] = bfhi(wk[k].x); v[4 * k + 2] = bflo(wk[k].y); v[4 * k + 3] = bfhi(wk[k].y); }
#pragma unroll
            for (int j = 0; j < 8; ++j) ss += v[j] * v[j];
            ss = wave_sum(ss);
            const float rstd = rsqrtf(ss * (1.0f / 512.0f) + EPS);
#pragma unroll
            for (int k = 0; k < 2; ++k) { const f32x4 gg = *(const f32x4*)(g_kva + k * 256 + lane * 4);
                u32x2 w; w.x = cvtpk(v[4 * k] * rstd * gg[0], v[4 * k + 1] * rstd * gg[1]); w.y = cvtpk(v[4 * k + 2] * rstd * gg[2], v[4 * k + 3] * rstd * gg[3]);
                *(u32x2*)(kvan + (size_t)t * 512 + k * 256 + lane * 4) = w; }
        }
        if (hf == 0) {
            const float x1 = bf2f(kp1), x2 = bf2f(kp2);
            kpe[(size_t)t * 64 + i] = f2bf(x1 * ct.x - x2 * ct.y);
            kpe[(size_t)t * 64 + 32 + i] = f2bf(x2 * ct.x + x1 * ct.y);
        }
#pragma unroll
        for (int s = 0; s < 5; ++s) {
            const int head = 2 * s + hf;
            const float* gg = (head < 8) ? g_qn : g_kn;
            float a0 = bf2f(hv[s][0]), a1 = bf2f(hv[s][1]), a2 = bf2f(hv[s][2]), a3 = bf2f(hv[s][3]);
            float ss = a0 * a0 + a1 * a1 + a2 * a2 + a3 * a3;
#pragma unroll
            for (int o = 16; o >= 1; o >>= 1) ss += __shfl_xor(ss, o);
            const float rstd = rsqrtf(ss * (1.0f / 128.0f) + EPS);
            a0 *= rstd * gg[i]; a1 *= rstd * gg[32 + i]; a2 *= rstd * gg[64 + i]; a3 *= rstd * gg[96 + i];
            bf16_t* dst = (head < 8) ? (qc + (size_t)t * 1024 + head * 128) : (kc + (size_t)t * 256 + (head - 8) * 128);
            dst[i] = f2bf(a0 * crow_.x - a1 * crow_.y); dst[32 + i] = f2bf(a1 * crow_.x + a0 * crow_.y);
            dst[64 + i] = f2bf(a2 * ccol.x - a3 * ccol.y); dst[96 + i] = f2bf(a3 * ccol.x + a2 * ccol.y);
        }
    }
}

__device__ __forceinline__ void fixup_b(bf16_t* mixed, const float* __restrict__ lse, int wg, int nwg) {
    const int tid = pg8::opaque_tid(), wid = tid >> 6, lane = tid & 63, hh = lane >> 4;
    for (int t = wg * 8 + wid; t < MTOK; t += nwg * 8) {
        const float l0 = lse[((size_t)0 * MTOK + t) * 4 + hh], l1 = lse[((size_t)1 * MTOK + t) * 4 + hh], l2 = lse[((size_t)2 * MTOK + t) * 4 + hh];
        const float mx = fmaxf(l0, fmaxf(l1, l2));
        const float e0 = __expf(l0 - mx), e1 = __expf(l1 - mx), e2 = __expf(l2 - mx), inv = 1.0f / (e0 + e1 + e2);
        const float al[3] = {e0 * inv, e1 * inv, e2 * inv};
        u32x4 wv[3];
#pragma unroll
        for (int k = 0; k < 3; ++k) wv[k] = *(const u32x4*)(mixed + (size_t)t * MIXW + MX_B + k * 512 + lane * 8);
#pragma unroll
        for (int k = 0; k < 3; ++k) {
            u32x4 w = wv[k];
            const float a = al[k];
            w.x = cvtpk(bflo(w.x) * a, bfhi(w.x) * a); w.y = cvtpk(bflo(w.y) * a, bfhi(w.y) * a);
            w.z = cvtpk(bflo(w.z) * a, bfhi(w.z) * a); w.w = cvtpk(bflo(w.w) * a, bfhi(w.w) * a);
            *(u32x4*)(mixed + (size_t)t * MIXW + MX_B + k * 512 + lane * 8) = w;
        }
    }
}

__device__ __forceinline__ int crow(int r, int hi) { return (r & 3) + 8 * (r >> 2) + 4 * hi; }
#define KSWZ(row, colB) ((row) * 256 + ((colB) ^ (((row) & 7) << 4)))
#define PSWZ(row, colB) ((row) * 128 + ((colB) ^ (((row) & 7) << 4)))
__device__ __forceinline__ int v_st(int k, int c) { const int kk = (k & ~0xC) | ((k & 4) << 1) | ((k & 8) >> 1); return ((kk >> 3) * 4 + (c >> 5)) * 512 + ((kk & 7) * 32 + (c & 31)) * 2; }
__device__ __forceinline__ int v_rd_base(int lane) { return ((lane & 3) << 3) | (((lane >> 2) & 3) << 6) | (((lane >> 4) & 1) << 5) | (((lane >> 5) & 1) << 8); }
constexpr int v_rd_off(int d0, int ks, int half) { return d0 * 512 + ks * 4096 + half * 2048; }
template <int OFF> __device__ __forceinline__ s16x4 tr_read(int vb) {
    s16x4 r; asm volatile("ds_read_b64_tr_b16 %0, %1 offset:%2" : "=&v"(r) : "v"(vb), "i"(OFF) : "memory"); return r;
}
template <int D0> __device__ __forceinline__ void pv_one(f32x16& od, int vb, bf16x8 pa0, bf16x8 pa1, bf16x8 pa2, bf16x8 pa3) {
    const s16x4 l0 = tr_read<v_rd_off(D0, 0, 0)>(vb), h0 = tr_read<v_rd_off(D0, 0, 1)>(vb), l1 = tr_read<v_rd_off(D0, 1, 0)>(vb), h1 = tr_read<v_rd_off(D0, 1, 1)>(vb);
    const s16x4 l2 = tr_read<v_rd_off(D0, 2, 0)>(vb), h2 = tr_read<v_rd_off(D0, 2, 1)>(vb), l3 = tr_read<v_rd_off(D0, 3, 0)>(vb), h3 = tr_read<v_rd_off(D0, 3, 1)>(vb);
    asm volatile("s_waitcnt lgkmcnt(0)" ::: "memory"); __builtin_amdgcn_sched_barrier(0);
#define PK(L, H) (bf16x8){L[0], L[1], L[2], L[3], H[0], H[1], H[2], H[3]}
    od = __builtin_amdgcn_mfma_f32_32x32x16_bf16(pa0, PK(l0, h0), od, 0, 0, 0);
    od = __builtin_amdgcn_mfma_f32_32x32x16_bf16(pa1, PK(l1, h1), od, 0, 0, 0);
    od = __builtin_amdgcn_mfma_f32_32x32x16_bf16(pa2, PK(l2, h2), od, 0, 0, 0);
    od = __builtin_amdgcn_mfma_f32_32x32x16_bf16(pa3, PK(l3, h3), od, 0, 0, 0);
#undef PK
}

constexpr int AL_V = 0, AL_K = 16384, AL_KP = 32768, AL_WS = 40960, AL_LUT = 43008;

struct AttnArgs {
    const bf16_t* Q; long ldq;
    const bf16_t* K; long ldk;
    const bf16_t* K2; long ldk2;
    const bf16_t* V; long ldv;
    const bf16_t* G; long ldg;
    bf16_t* O; long ldo;
    float* lse; long ldl;
    const float2* cs;
    int i0, L, side, dil;
    const float* bias; int bcol;
    float C;
    float sink2;
};

template <int DQK, bool BAND, bool SINK, bool WLSE, bool ROPEQ>
__device__ __forceinline__ void attn_unit(lds_u8* lds, const AttnArgs& a) {
    constexpr int ND0 = DQK / 16;
    const int tid = pg8::opaque_tid(), wid = tid >> 6, lane = tid & 63, r32 = lane & 31, hi = lane >> 5;
    lds_u8* Vl = lds + AL_V; lds_u8* Kl = lds + AL_K; lds_u8* Kp = lds + AL_KP;
    LAS float* wsf = (LAS float*)(lds + AL_WS) + wid * 64; LAS float* li_l = wsf; LAS float* al_l = wsf + 32;
    LAS float* lut = (LAS float*)(lds + AL_LUT);
    __syncthreads();
    if (BAND) {
        if (tid <= 2 * a.side) { const int rel = tid - a.side; lut[tid] = a.bias[rel_bucket(rel * a.dil) * 20 + a.bcol] * LOG2E; }
    }
    const int qi = a.i0 + wid * 32 + r32;
    bf16x8 qr[ND0];
    {
        const bf16_t* Qw = a.Q + (long)qi * a.ldq + hi * 8;
#pragma unroll
        for (int d0 = 0; d0 < ND0; ++d0) qr[d0] = *(const bf16x8*)(Qw + d0 * 16);
    }
    if constexpr (ROPEQ) {
#pragma unroll
        for (int dd = 0; dd < 2; ++dd) {
            bf16x8 x1 = qr[8 + dd], x2 = qr[10 + dd];
#pragma unroll
            for (int j = 0; j < 8; ++j) {
                const float2 c = a.cs[qi * 32 + dd * 16 + hi * 8 + j];
                const float f1 = bf2f((bf16_t)x1[j]), f2 = bf2f((bf16_t)x2[j]);
                x1[j] = (short)f2bf(f1 * c.x - f2 * c.y); x2[j] = (short)f2bf(f2 * c.x + f1 * c.y);
            }
            qr[8 + dd] = x1; qr[10 + dd] = x2;
        }
    }
    int t_lo = 0, t_hi = a.L / 64, lo_w = 0, hi_w = 1 << 30;
    if (BAND) {
        t_lo = (a.i0 - a.side) / 64; if (t_lo < 0) t_lo = 0;
        int th = (a.i0 + 256 + a.side) / 64; if (th < t_hi) t_hi = th;
        const int w0 = a.i0 + wid * 32;
        lo_w = (w0 - a.side) >> 6; hi_w = (w0 + 31 + a.side) >> 6;
    }
    const int sr = tid >> 4, sc = (tid & 15) * 8;
    const int vst0 = v_st(sr, sc), vst1 = v_st(32 + sr, sc), kst0 = KSWZ(sr, sc * 2), kst1 = KSWZ(32 + sr, sc * 2);
    const int pr_ = tid >> 3, pc = (tid & 7) * 8, pst = PSWZ(pr_, pc * 2);
    const int vb0 = (int)(unsigned)(size_t)Vl + v_rd_base(lane);
    bf16x8 kA, kB, vA, vB, kP;
#define ALOAD(T) do { const long j0 = (long)(T) * 64; \
        kA = *(const bf16x8*)(a.K + (j0 + sr) * a.ldk + sc); kB = *(const bf16x8*)(a.K + (j0 + 32 + sr) * a.ldk + sc); \
        vA = *(const bf16x8*)(a.V + (j0 + sr) * a.ldv + sc); vB = *(const bf16x8*)(a.V + (j0 + 32 + sr) * a.ldv + sc); \
        if constexpr (DQK == 192) kP = *(const bf16x8*)(a.K2 + (j0 + pr_) * a.ldk2 + pc); } while (0)
    float m_reg = -1e29f, l_reg = 0.f;
    f32x16 o[4];
#pragma unroll
    for (int d = 0; d < 4; ++d)
#pragma unroll
        for (int r = 0; r < 16; ++r) o[d][r] = 0.f;
    ALOAD(t_lo);
    for (int T = t_lo; T < t_hi; ++T) {
        __syncthreads();
        *(LAS bf16x8*)(Kl + kst0) = kA; *(LAS bf16x8*)(Kl + kst1) = kB;
        *(LAS bf16x8*)(Vl + vst0) = vA; *(LAS bf16x8*)(Vl + vst1) = vB;
        if constexpr (DQK == 192) *(LAS bf16x8*)(Kp + pst) = kP;
        if (T + 1 < t_hi) ALOAD(T + 1);
        __syncthreads();
        if (T >= lo_w && T <= hi_w) {
            f32x16 p0, p1;
#pragma unroll
            for (int r = 0; r < 16; ++r) { p0[r] = 0.f; p1[r] = 0.f; }
#pragma unroll
            for (int d0 = 0; d0 < 8; ++d0) { const int cb = (d0 * 16 + hi * 8) * 2;
                const bf16x8 b0 = *(const LAS bf16x8*)(Kl + KSWZ(r32, cb)), b1 = *(const LAS bf16x8*)(Kl + KSWZ(32 + r32, cb));
                p0 = __builtin_amdgcn_mfma_f32_32x32x16_bf16(b0, qr[d0], p0, 0, 0, 0);
                p1 = __builtin_amdgcn_mfma_f32_32x32x16_bf16(b1, qr[d0], p1, 0, 0, 0); }
            if constexpr (DQK == 192) {
#pragma unroll
                for (int d0 = 0; d0 < 4; ++d0) { const int cb = (d0 * 16 + hi * 8) * 2;
                    const bf16x8 b0 = *(const LAS bf16x8*)(Kp + PSWZ(r32, cb)), b1 = *(const LAS bf16x8*)(Kp + PSWZ(32 + r32, cb));
                    p0 = __builtin_amdgcn_mfma_f32_32x32x16_bf16(b0, qr[8 + d0], p0, 0, 0, 0);
                    p1 = __builtin_amdgcn_mfma_f32_32x32x16_bf16(b1, qr[8 + d0], p1, 0, 0, 0); }
            }
            if (BAND) {
                const int base = T * 64 - qi + a.side;
#pragma unroll
                for (int r = 0; r < 16; ++r) {
                    const int i0_ = base + crow(r, hi), i1_ = i0_ + 32;
                    const bool ok0 = (unsigned)i0_ <= (unsigned)(2 * a.side), ok1 = (unsigned)i1_ <= (unsigned)(2 * a.side);
                    const float b0 = lut[ok0 ? i0_ : 0], b1 = lut[ok1 ? i1_ : 0];
                    p0[r] = ok0 ? fmaf(p0[r], a.C, b0) : -1e30f; p1[r] = ok1 ? fmaf(p1[r], a.C, b1) : -1e30f;
                }
            } else {
#pragma unroll
                for (int r = 0; r < 16; ++r) { p0[r] *= a.C; p1[r] *= a.C; }
            }
            float pmax = p0[0];
#pragma unroll
            for (int r = 1; r < 16; ++r) pmax = fmaxf(pmax, p0[r]);
#pragma unroll
            for (int r = 0; r < 16; ++r) pmax = fmaxf(pmax, p1[r]);
            { auto rr = __builtin_amdgcn_permlane32_swap(__float_as_uint(pmax), __float_as_uint(pmax), false, false);
              pmax = fmaxf(__uint_as_float(rr[0]), __uint_as_float(rr[1])); }
            const float mn = fmaxf(m_reg, pmax);
            const float alpha = __builtin_amdgcn_exp2f(m_reg - mn);
            m_reg = mn;
            float ps = 0.f;
#pragma unroll
            for (int r = 0; r < 16; ++r) { p0[r] = __builtin_amdgcn_exp2f(p0[r] - mn); p1[r] = __builtin_amdgcn_exp2f(p1[r] - mn); ps += p0[r] + p1[r]; }
            { auto rr = __builtin_amdgcn_permlane32_swap(__float_as_uint(ps), __float_as_uint(ps), false, false);
              ps = __uint_as_float(rr[0]) + __uint_as_float(rr[1]); }
            l_reg = l_reg * alpha + ps;
            if (__any(alpha < 1.f)) {
                if (hi == 0) al_l[r32] = alpha;
                asm volatile("s_waitcnt lgkmcnt(0)" ::: "memory");
#pragma unroll
                for (int r = 0; r < 16; ++r) { const float al = al_l[crow(r, hi)];
#pragma unroll
                    for (int d = 0; d < 4; ++d) o[d][r] *= al; }
            }
            bf16x8 pa0, pa1, pa2, pa3;
#define PK4(P, BASE, OUT) do { unsigned a0 = cvtpk(P[BASE + 0], P[BASE + 1]), a1 = cvtpk(P[BASE + 2], P[BASE + 3]);   \
    unsigned b0 = cvtpk(P[BASE + 4], P[BASE + 5]), b1 = cvtpk(P[BASE + 6], P[BASE + 7]);                              \
    auto r0 = __builtin_amdgcn_permlane32_swap(a0, b0, false, false); auto r1 = __builtin_amdgcn_permlane32_swap(a1, b1, false, false); \
    u32x4 w = {r0[0], r1[0], r0[1], r1[1]}; OUT = *reinterpret_cast<bf16x8*>(&w); } while (0)
            PK4(p0, 0, pa0); PK4(p0, 8, pa1); PK4(p1, 0, pa2); PK4(p1, 8, pa3);
#undef PK4
            pv_one<0>(o[0], vb0, pa0, pa1, pa2, pa3); pv_one<1>(o[1], vb0, pa0, pa1, pa2, pa3);
            pv_one<2>(o[2], vb0, pa0, pa1, pa2, pa3); pv_one<3>(o[3], vb0, pa0, pa1, pa2, pa3);
        }
    }
#undef ALOAD
    if (SINK) l_reg += __builtin_amdgcn_exp2f(a.sink2 - m_reg);
    if (hi == 0) li_l[r32] = l_reg;
    if (WLSE) { if (hi == 0) a.lse[(long)qi * a.ldl] = (m_reg + __builtin_amdgcn_logf(l_reg)) * LN2; }
    asm volatile("s_waitcnt lgkmcnt(0)" ::: "memory");
    bf16_t gv[16][4];
#pragma unroll
    for (int r = 0; r < 16; ++r) {
        const bf16_t* gp = a.G + (long)(a.i0 + wid * 32 + crow(r, hi)) * a.ldg + r32;
#pragma unroll
        for (int d0 = 0; d0 < 4; ++d0) gv[r][d0] = gp[d0 * 32];
    }
#pragma unroll
    for (int r = 0; r < 16; ++r) {
        const int row = crow(r, hi);
        const float rl = __builtin_amdgcn_rcpf(li_l[row]);
        const long i = a.i0 + wid * 32 + row;
        bf16_t* op = a.O + i * a.ldo + r32;
#pragma unroll
        for (int d0 = 0; d0 < 4; ++d0) {
            const float g = bf2f(gv[r][d0]);
            const float sg = g * __builtin_amdgcn_rcpf(1.0f + __builtin_amdgcn_exp2f(-LOG2E * g));
            op[d0 * 32] = (bf16_t)cvtpk(o[d0][r] * rl * sg, 0.f);
        }
    }
}


constexpr int DL_V = 0, DL_K = 32768, DL_P = 65536, DL_WS = 81920;
template <int DQK>
__device__ __forceinline__ void d_qkt(f32x16& p0, f32x16& p1, const lds_u8* Ks, const lds_u8* Ps, const bf16x8* qr, int r32, int hi) {
#pragma unroll
    for (int r = 0; r < 16; ++r) { p0[r] = 0.f; p1[r] = 0.f; }
#pragma unroll
    for (int d0 = 0; d0 < 8; ++d0) { const int cb = (d0 * 16 + hi * 8) * 2;
        const bf16x8 b0 = *(const LAS bf16x8*)(Ks + KSWZ(r32, cb)), b1 = *(const LAS bf16x8*)(Ks + KSWZ(32 + r32, cb));
        p0 = __builtin_amdgcn_mfma_f32_32x32x16_bf16(b0, qr[d0], p0, 0, 0, 0);
        p1 = __builtin_amdgcn_mfma_f32_32x32x16_bf16(b1, qr[d0], p1, 0, 0, 0); }
    if constexpr (DQK == 192) {
#pragma unroll
        for (int d0 = 0; d0 < 4; ++d0) { const int cb = (d0 * 16 + hi * 8) * 2;
            const bf16x8 b0 = *(const LAS bf16x8*)(Ps + PSWZ(r32, cb)), b1 = *(const LAS bf16x8*)(Ps + PSWZ(32 + r32, cb));
            p0 = __builtin_amdgcn_mfma_f32_32x32x16_bf16(b0, qr[8 + d0], p0, 0, 0, 0);
            p1 = __builtin_amdgcn_mfma_f32_32x32x16_bf16(b1, qr[8 + d0], p1, 0, 0, 0); }
    }
}
__device__ __forceinline__ void d_partialSM(f32x16& p0, f32x16& p1, float& m_reg, float& mn, float& alpha, const float C) {
    float pmax = p0[0];
#pragma unroll
    for (int r = 1; r < 16; ++r) pmax = fmaxf(pmax, p0[r]);
#pragma unroll
    for (int r = 0; r < 16; ++r) pmax = fmaxf(pmax, p1[r]);
    { auto rr = __builtin_amdgcn_permlane32_swap(__float_as_uint(pmax), __float_as_uint(pmax), false, false);
      pmax = fmaxf(__uint_as_float(rr[0]), __uint_as_float(rr[1])); }
    if (__builtin_expect(__all((pmax - m_reg) * C <= 8.0f * LOG2E), 1)) { mn = m_reg; alpha = 1.f; }
    else { mn = fmaxf(m_reg, pmax); alpha = __builtin_amdgcn_exp2f((m_reg - mn) * C); m_reg = mn; }
    const float mnC = -mn * C;
#pragma unroll
    for (int r = 0; r < 16; ++r) p0[r] = fmaf(p0[r], C, mnC);
#pragma unroll
    for (int r = 0; r < 16; ++r) p1[r] = fmaf(p1[r], C, mnC);
#pragma unroll
    for (int r = 0; r < 16; ++r) p0[r] = __builtin_amdgcn_exp2f(p0[r]);
}
__device__ __forceinline__ void d_finishSM(f32x16& p0, f32x16& p1, float alpha, float& l_reg, bf16x8& pa0, bf16x8& pa1, bf16x8& pa2, bf16x8& pa3) {
#pragma unroll
    for (int r = 0; r < 16; ++r) p1[r] = __builtin_amdgcn_exp2f(p1[r]);
    float ps = 0;
#pragma unroll
    for (int r = 0; r < 16; ++r) ps += p0[r];
#pragma unroll
    for (int r = 0; r < 16; ++r) ps += p1[r];
    { auto rr = __builtin_amdgcn_permlane32_swap(__float_as_uint(ps), __float_as_uint(ps), false, false);
      ps = __uint_as_float(rr[0]) + __uint_as_float(rr[1]); }
    l_reg = l_reg * alpha + ps;
#define PK4(P, BASE, OUT) do { unsigned a0 = cvtpk(P[BASE + 0], P[BASE + 1]), a1 = cvtpk(P[BASE + 2], P[BASE + 3]);   \
    unsigned b0 = cvtpk(P[BASE + 4], P[BASE + 5]), b1 = cvtpk(P[BASE + 6], P[BASE + 7]);                              \
    auto r0 = __builtin_amdgcn_permlane32_swap(a0, b0, false, false); auto r1 = __builtin_amdgcn_permlane32_swap(a1, b1, false, false); \
    u32x4 w = {r0[0], r1[0], r0[1], r1[1]}; OUT = *reinterpret_cast<bf16x8*>(&w); } while (0)
    PK4(p0, 0, pa0); PK4(p0, 8, pa1); PK4(p1, 0, pa2); PK4(p1, 8, pa3);
#undef PK4
}
__device__ __forceinline__ void d_pv(f32x16* o, int vb, bf16x8 pa0, bf16x8 pa1, bf16x8 pa2, bf16x8 pa3) {
    pv_one<0>(o[0], vb, pa0, pa1, pa2, pa3); pv_one<1>(o[1], vb, pa0, pa1, pa2, pa3); pv_one<2>(o[2], vb, pa0, pa1, pa2, pa3); pv_one<3>(o[3], vb, pa0, pa1, pa2, pa3);
}
#define SBAR() __builtin_amdgcn_sched_barrier(0)

template <int DQK, bool ROPEQ, int SDEPTH>
__device__ __forceinline__ void attn_dense_unit(lds_u8* lds, const AttnArgs& a) {
    constexpr int ND0 = DQK / 16;
    const int tid = pg8::opaque_tid(), wid = tid >> 6, lane = tid & 63, r32 = lane & 31, hi = lane >> 5;
    lds_u8* V_lds = lds + DL_V; lds_u8* K_lds = lds + DL_K; lds_u8* P_lds = lds + DL_P;
    LAS float* wsf = (LAS float*)(lds + DL_WS) + wid * 64; LAS float* li_l = wsf; LAS float* al_l = wsf + 32;
    const float C = a.C;
    __syncthreads();
    const int qi = a.i0 + wid * 32 + r32;
    float m_reg = -1e30f, l_reg = 0.f;
    f32x16 o[4];
#pragma unroll
    for (int d = 0; d < 4; ++d)
#pragma unroll
        for (int r = 0; r < 16; ++r) o[d][r] = 0.f;
    bf16x8 qr[ND0];
    {
        const bf16_t* Qw = a.Q + (long)qi * a.ldq + hi * 8;
#pragma unroll
        for (int d0 = 0; d0 < ND0; ++d0) qr[d0] = *(const bf16x8*)(Qw + d0 * 16);
    }
    if constexpr (ROPEQ) {
#pragma unroll
        for (int dd = 0; dd < 2; ++dd) {
            bf16x8 x1 = qr[8 + dd], x2 = qr[10 + dd];
#pragma unroll
            for (int j = 0; j < 8; ++j) {
                const float2 c = a.cs[qi * 32 + dd * 16 + hi * 8 + j];
                const float f1 = bf2f((bf16_t)x1[j]), f2 = bf2f((bf16_t)x2[j]);
                x1[j] = (short)f2bf(f1 * c.x - f2 * c.y); x2[j] = (short)f2bf(f2 * c.x + f1 * c.y);
            }
            qr[8 + dd] = x1; qr[10 + dd] = x2;
        }
    }
    const int sr = tid >> 4, sc = (tid & 15) * 8, vst0 = v_st(sr, sc), vst1 = v_st(32 + sr, sc), kst0 = KSWZ(sr, sc * 2), kst1 = KSWZ(32 + sr, sc * 2);
    const int pr_ = tid >> 3, pc = (tid & 7) * 8, pst = PSWZ(pr_, pc * 2);
    const int vb0 = (int)(unsigned)(size_t)V_lds + v_rd_base(lane);
    struct { bf16x8 vs0, vs1, ks0, ks1, kp; } sr_[SDEPTH];
#define SLOAD(i, k0) do { sr_[i].vs0 = *(const bf16x8*)(a.V + (long)((k0) + sr) * a.ldv + sc); sr_[i].vs1 = *(const bf16x8*)(a.V + (long)((k0) + 32 + sr) * a.ldv + sc); \
    sr_[i].ks0 = *(const bf16x8*)(a.K + (long)((k0) + sr) * a.ldk + sc); sr_[i].ks1 = *(const bf16x8*)(a.K + (long)((k0) + 32 + sr) * a.ldk + sc); \
    if constexpr (DQK == 192) sr_[i].kp = *(const bf16x8*)(a.K2 + (long)((k0) + pr_) * a.ldk2 + pc); } while (0)
#define SWRITE(b, i) do { *(LAS bf16x8*)(V_lds + (b) * 16384 + vst0) = sr_[i].vs0; *(LAS bf16x8*)(V_lds + (b) * 16384 + vst1) = sr_[i].vs1; \
    *(LAS bf16x8*)(K_lds + (b) * 16384 + kst0) = sr_[i].ks0; *(LAS bf16x8*)(K_lds + (b) * 16384 + kst1) = sr_[i].ks1; \
    if constexpr (DQK == 192) *(LAS bf16x8*)(P_lds + (b) * 8192 + pst) = sr_[i].kp; } while (0)
#define SWAIT() do { if constexpr (SDEPTH == 2) { if constexpr (DQK == 192) asm volatile("s_waitcnt vmcnt(5)" ::: "memory"); else asm volatile("s_waitcnt vmcnt(4)" ::: "memory"); } \
    else asm volatile("s_waitcnt vmcnt(0)" ::: "memory"); } while (0)
#define RESC(al) do { if (__any((al) < 1.f)) { if (hi == 0) al_l[r32] = (al); asm volatile("s_waitcnt lgkmcnt(0)" ::: "memory"); \
    _Pragma("unroll") for (int r = 0; r < 16; ++r) { const float s_ = al_l[crow(r, hi)]; _Pragma("unroll") for (int d = 0; d < 4; ++d) o[d][r] *= s_; } } } while (0)
    f32x16 pA0, pA1, pB0, pB1; float mnA, mnB, alA, alB; bf16x8 pa0, pa1, pa2, pa3; const int NT = a.L / 64;
    constexpr int SE = 0, SO = SDEPTH - 1;
    SLOAD(SE, 0); asm volatile("s_waitcnt vmcnt(0)" ::: "memory"); SWRITE(0, SE); __syncthreads();
    d_qkt<DQK>(pA0, pA1, K_lds, P_lds, qr, r32, hi); d_partialSM(pA0, pA1, m_reg, mnA, alA, C);
    SLOAD(SO, 64); if constexpr (SDEPTH == 2) { if (2 < NT) SLOAD(SE, 128); }
    SWAIT(); SWRITE(1, SO); __syncthreads();
    for (int j = 1; j + 1 < NT; j += 2) {
        SBAR(); d_qkt<DQK>(pB0, pB1, K_lds + 16384, P_lds + 8192, qr, r32, hi);
        d_finishSM(pA0, pA1, alA, l_reg, pa0, pa1, pa2, pa3); SBAR();
        SLOAD(SO, (j + SDEPTH) * 64); SBAR();
        d_pv(o, vb0, pa0, pa1, pa2, pa3); d_partialSM(pB0, pB1, m_reg, mnB, alB, C);
        __syncthreads(); SWAIT(); SWRITE(0, SE);
        RESC(alB); __syncthreads();
        SBAR(); d_qkt<DQK>(pA0, pA1, K_lds, P_lds, qr, r32, hi);
        d_finishSM(pB0, pB1, alB, l_reg, pa0, pa1, pa2, pa3); SBAR();
        if (SDEPTH == 1 || j + 3 < NT) SLOAD(SE, (j + 1 + SDEPTH) * 64); SBAR();
        d_pv(o, vb0 + 16384, pa0, pa1, pa2, pa3); d_partialSM(pA0, pA1, m_reg, mnA, alA, C);
        __syncthreads(); SWAIT(); SWRITE(1, SO);
        RESC(alA); __syncthreads();
    }
    SBAR(); d_qkt<DQK>(pB0, pB1, K_lds + 16384, P_lds + 8192, qr, r32, hi);
    d_finishSM(pA0, pA1, alA, l_reg, pa0, pa1, pa2, pa3); SBAR();
    d_pv(o, vb0, pa0, pa1, pa2, pa3); d_partialSM(pB0, pB1, m_reg, mnB, alB, C);
    __syncthreads(); RESC(alB);
    d_finishSM(pB0, pB1, alB, l_reg, pa0, pa1, pa2, pa3); SBAR();
    d_pv(o, vb0 + 16384, pa0, pa1, pa2, pa3);
#undef SLOAD
#undef SWRITE
#undef SWAIT
#undef RESC
    if (hi == 0) li_l[r32] = l_reg;
    asm volatile("s_waitcnt lgkmcnt(0)" ::: "memory");
    bf16_t gv[16][4];
#pragma unroll
    for (int r = 0; r < 16; ++r) {
        const bf16_t* gp = a.G + (long)(a.i0 + wid * 32 + crow(r, hi)) * a.ldg + r32;
#pragma unroll
        for (int d0 = 0; d0 < 4; ++d0) gv[r][d0] = gp[d0 * 32];
    }
#pragma unroll
    for (int r = 0; r < 16; ++r) {
        const int row = crow(r, hi);
        const float rl = __builtin_amdgcn_rcpf(li_l[row]);
        const long i = a.i0 + wid * 32 + row;
        bf16_t* op = a.O + i * a.ldo + r32;
#pragma unroll
        for (int d0 = 0; d0 < 4; ++d0) {
            const float g = bf2f(gv[r][d0]);
            const float sg = g * __builtin_amdgcn_rcpf(1.0f + __builtin_amdgcn_exp2f(-LOG2E * g));
            op[d0 * 32] = (bf16_t)cvtpk(o[d0][r] * rl * sg, 0.f);
        }
    }
}


constexpr int D3_V = 0, D3_K = 49152, D3_P = 98304, D3_WS = 122880;
template <int DQK, bool ROPEQ>
__device__ __forceinline__ void attn_dense_unit3(lds_u8* lds, const AttnArgs& a) {
    constexpr int ND0 = DQK / 16;
    const int tid = pg8::opaque_tid(), wid = tid >> 6, lane = tid & 63, r32 = lane & 31, hi = lane >> 5;
    lds_u8* V_lds = lds + D3_V; lds_u8* K_lds = lds + D3_K; lds_u8* P_lds = lds + D3_P;
    LAS float* wsf = (LAS float*)(lds + D3_WS) + wid * 64; LAS float* li_l = wsf; LAS float* al_l = wsf + 32;
    const float C = a.C;
    __syncthreads();
    const int qi = a.i0 + wid * 32 + r32;
    float m_reg = -1e30f, l_reg = 0.f;
    f32x16 o[4];
#pragma unroll
    for (int d = 0; d < 4; ++d)
#pragma unroll
        for (int r = 0; r < 16; ++r) o[d][r] = 0.f;
    bf16x8 qr[ND0];
    {
        const bf16_t* Qw = a.Q + (long)qi * a.ldq + hi * 8;
#pragma unroll
        for (int d0 = 0; d0 < ND0; ++d0) qr[d0] = *(const bf16x8*)(Qw + d0 * 16);
    }
    if constexpr (ROPEQ) {
#pragma unroll
        for (int dd = 0; dd < 2; ++dd) {
            bf16x8 x1 = qr[8 + dd], x2 = qr[10 + dd];
#pragma unroll
            for (int j = 0; j < 8; ++j) {
                const float2 c = a.cs[qi * 32 + dd * 16 + hi * 8 + j];
                const float f1 = bf2f((bf16_t)x1[j]), f2 = bf2f((bf16_t)x2[j]);
                x1[j] = (short)f2bf(f1 * c.x - f2 * c.y); x2[j] = (short)f2bf(f2 * c.x + f1 * c.y);
            }
            qr[8 + dd] = x1; qr[10 + dd] = x2;
        }
    }
    const int sr = tid >> 4, sc = (tid & 15) * 8, vst0 = v_st(sr, sc), vst1 = v_st(32 + sr, sc), kst0 = KSWZ(sr, sc * 2), kst1 = KSWZ(32 + sr, sc * 2);
    const int pr_ = tid >> 3, pc = (tid & 7) * 8, pst = PSWZ(pr_, pc * 2);
    const int vb0 = (int)(unsigned)(size_t)V_lds + v_rd_base(lane);
    bf16x8 s_vs0, s_vs1, s_ks0, s_ks1, s_kp;
#define SLOAD(k0) do { s_vs0 = *(const bf16x8*)(a.V + (long)((k0) + sr) * a.ldv + sc); s_vs1 = *(const bf16x8*)(a.V + (long)((k0) + 32 + sr) * a.ldv + sc); \
    s_ks0 = *(const bf16x8*)(a.K + (long)((k0) + sr) * a.ldk + sc); s_ks1 = *(const bf16x8*)(a.K + (long)((k0) + 32 + sr) * a.ldk + sc); \
    if constexpr (DQK == 192) s_kp = *(const bf16x8*)(a.K2 + (long)((k0) + pr_) * a.ldk2 + pc); } while (0)
#define SWRITE(b) do { *(LAS bf16x8*)(V_lds + (b) * 16384 + vst0) = s_vs0; *(LAS bf16x8*)(V_lds + (b) * 16384 + vst1) = s_vs1; \
    *(LAS bf16x8*)(K_lds + (b) * 16384 + kst0) = s_ks0; *(LAS bf16x8*)(K_lds + (b) * 16384 + kst1) = s_ks1; \
    if constexpr (DQK == 192) *(LAS bf16x8*)(P_lds + (b) * 8192 + pst) = s_kp; } while (0)
#define RESC(al) do { if (__any((al) < 1.f)) { if (hi == 0) al_l[r32] = (al); asm volatile("s_waitcnt lgkmcnt(0)" ::: "memory"); \
    _Pragma("unroll") for (int r = 0; r < 16; ++r) { const float s_ = al_l[crow(r, hi)]; _Pragma("unroll") for (int d = 0; d < 4; ++d) o[d][r] *= s_; } } } while (0)
#define ROT() do { bv = bq; bq = bw; bw = (bw == 2) ? 0 : bw + 1; } while (0)
    f32x16 pA0, pA1, pB0, pB1; float mnA, mnB, alA, alB; bf16x8 pa0, pa1, pa2, pa3; const int NT = a.L / 64;
    SLOAD(0); SWRITE(0); SLOAD(64); SWRITE(1); SLOAD(128); __syncthreads();
    d_qkt<DQK>(pA0, pA1, K_lds, P_lds, qr, r32, hi); d_partialSM(pA0, pA1, m_reg, mnA, alA, C);
    int bq = 1, bv = 0, bw = 2;
    for (int j = 1; j + 1 < NT; j += 2) {
        SBAR(); d_qkt<DQK>(pB0, pB1, K_lds + bq * 16384, P_lds + bq * 8192, qr, r32, hi);
        d_finishSM(pA0, pA1, alA, l_reg, pa0, pa1, pa2, pa3); SBAR();
        d_pv(o, vb0 + bv * 16384, pa0, pa1, pa2, pa3); d_partialSM(pB0, pB1, m_reg, mnB, alB, C);
        SWRITE(bw);
        if (j + 2 < NT) SLOAD((j + 2) * 64);
        RESC(alB); __syncthreads(); ROT();
        SBAR(); d_qkt<DQK>(pA0, pA1, K_lds + bq * 16384, P_lds + bq * 8192, qr, r32, hi);
        d_finishSM(pB0, pB1, alB, l_reg, pa0, pa1, pa2, pa3); SBAR();
        d_pv(o, vb0 + bv * 16384, pa0, pa1, pa2, pa3); d_partialSM(pA0, pA1, m_reg, mnA, alA, C);
        if (j + 2 < NT) SWRITE(bw);
        if (j + 3 < NT) SLOAD((j + 3) * 64);
        RESC(alA); __syncthreads(); ROT();
    }
    SBAR(); d_qkt<DQK>(pB0, pB1, K_lds + bq * 16384, P_lds + bq * 8192, qr, r32, hi);
    d_finishSM(pA0, pA1, alA, l_reg, pa0, pa1, pa2, pa3); SBAR();
    d_pv(o, vb0 + bv * 16384, pa0, pa1, pa2, pa3); d_partialSM(pB0, pB1, m_reg, mnB, alB, C);
    RESC(alB);
    d_finishSM(pB0, pB1, alB, l_reg, pa0, pa1, pa2, pa3); SBAR();
    d_pv(o, vb0 + bq * 16384, pa0, pa1, pa2, pa3);
#undef SLOAD
#undef SWRITE
#undef RESC
#undef ROT
    if (hi == 0) li_l[r32] = l_reg;
    asm volatile("s_waitcnt lgkmcnt(0)" ::: "memory");
    bf16_t gv[16][4];
#pragma unroll
    for (int r = 0; r < 16; ++r) {
        const bf16_t* gp = a.G + (long)(a.i0 + wid * 32 + crow(r, hi)) * a.ldg + r32;
#pragma unroll
        for (int d0 = 0; d0 < 4; ++d0) gv[r][d0] = gp[d0 * 32];
    }
#pragma unroll
    for (int r = 0; r < 16; ++r) {
        const int row = crow(r, hi);
        const float rl = __builtin_amdgcn_rcpf(li_l[row]);
        const long i = a.i0 + wid * 32 + row;
        bf16_t* op = a.O + i * a.ldo + r32;
#pragma unroll
        for (int d0 = 0; d0 < 4; ++d0) {
            const float g = bf2f(gv[r][d0]);
            const float sg = g * __builtin_amdgcn_rcpf(1.0f + __builtin_amdgcn_exp2f(-LOG2E * g));
            op[d0 * 32] = (bf16_t)cvtpk(o[d0][r] * rl * sg, 0.f);
        }
    }
}

constexpr int BL_WS = 131072, BL_LUT = 133120, BL_LUTSTRIDE = 260;
constexpr int BL_LUT2 = 65536, BL_LUT2MARGIN = 320, BL_LUT2STRIDE = 960;
struct BandArgs {
    const bf16_t* Q; long ldq;
    const bf16_t* K; const bf16_t* V; long ldk;
    const bf16_t* G; long ldg; bf16_t* O; long ldo;
    float* lse; long ldl;
    const float* bias; const float* sinks;
    int i0, L, side, dil, nt;
    float C;
};
template <int NH, bool SINK, bool WLSE, int PROBE = 0>
__device__ __forceinline__ void attn_band_unit(lds_u8* lds, const BandArgs& a) {
    constexpr int WPH = 8 / NH;
    const int tid = pg8::opaque_tid(), wid = tid >> 6, lane = tid & 63, r32 = lane & 31, hi = lane >> 5;
    const int hw = wid / WPH, rb = wid % WPH;
    LAS float* wsf = (LAS float*)(lds + BL_WS) + wid * 64; LAS float* li_l = wsf; LAS float* al_l = wsf + 32;
    LAS float* lut = (LAS float*)(lds + BL_LUT2) + hw * BL_LUT2STRIDE + BL_LUT2MARGIN;
    const int side = a.side, nlut = 2 * side + 1;
    __syncthreads();
    const int qi = a.i0 + rb * 32 + r32;
    bf16x8 qr[8];
    {
        const bf16_t* Qw = a.Q + hw * 128 + (long)qi * a.ldq + hi * 8;
#pragma unroll
        for (int d0 = 0; d0 < 8; ++d0) qr[d0] = *(const bf16x8*)(Qw + d0 * 16);
    }
    const int t_lo = (a.i0 >= side) ? 0 : (side - a.i0) / 64;
    int t_hi = (a.L - a.i0 + side) / 64; if (t_hi > a.nt) t_hi = a.nt;
    const int lo_w = rb >> 1, hi_w = (rb * 32 + 31 + 2 * side) >> 6;
    const int sr = tid >> 4, sc = (tid & 15) * 8;
    const int vst0 = v_st(sr, sc), vst1 = v_st(32 + sr, sc), kst0 = KSWZ(sr, sc * 2), kst1 = KSWZ(32 + sr, sc * 2);
    const int vbase = (int)(unsigned)(size_t)(lds + 16384) + v_rd_base(lane);
    constexpr int GT = 2;
    bf16x8 st[GT][4];
#define BLOAD(G0) do { _Pragma("unroll") for (int tt = 0; tt < GT; ++tt) { int T_ = (G0) + tt; if (T_ < t_lo) T_ = t_lo; if (T_ > t_hi - 1) T_ = t_hi - 1; \
            const long kb_ = (long)(a.i0 - side + 64 * T_); \
            st[tt][0] = *(const bf16x8*)(a.K + (kb_ + sr) * a.ldk + sc); st[tt][1] = *(const bf16x8*)(a.K + (kb_ + 32 + sr) * a.ldk + sc); \
            st[tt][2] = *(const bf16x8*)(a.V + (kb_ + sr) * a.ldk + sc); st[tt][3] = *(const bf16x8*)(a.V + (kb_ + 32 + sr) * a.ldk + sc); } } while (0)
    float m_reg = -1e29f, l_reg = 0.f;
    f32x16 o[4];
#pragma unroll
    for (int d = 0; d < 4; ++d)
#pragma unroll
        for (int r = 0; r < 16; ++r) o[d][r] = 0.f;
    const int g_lo = (t_lo / GT) * GT;
    BLOAD(g_lo);
    for (int idx = tid; idx < NH * nlut; idx += 512) { const int h = idx / nlut, e = idx - h * nlut;
        ((LAS float*)(lds + BL_LUT2))[h * BL_LUT2STRIDE + BL_LUT2MARGIN + e] = a.bias[rel_bucket((e - side) * a.dil) * 20 + h] * LOG2E; }
    for (int G0 = g_lo; G0 < t_hi; G0 += GT) {
        __syncthreads();
#pragma unroll
        for (int tt = 0; tt < GT; ++tt) {
            *(LAS bf16x8*)(lds + tt * 32768 + kst0) = st[tt][0]; *(LAS bf16x8*)(lds + tt * 32768 + kst1) = st[tt][1];
            *(LAS bf16x8*)(lds + tt * 32768 + 16384 + vst0) = st[tt][2]; *(LAS bf16x8*)(lds + tt * 32768 + 16384 + vst1) = st[tt][3];
        }
        if (G0 + GT < t_hi) BLOAD(G0 + GT);
        __syncthreads();
#pragma unroll 1
        for (int tt = 0; tt < GT; ++tt) {
            const int T = G0 + tt;
            if (T < t_lo || T >= t_hi || T < lo_w || T > hi_w) continue;
            if (PROBE >= 2) { l_reg += ((const LAS float*)(lds + tt * 32768))[tid]; continue; }
            const lds_u8* Kl = lds + tt * 32768; const int vb0 = vbase + tt * 32768;
            f32x16 p0, p1;
#pragma unroll
            for (int r = 0; r < 16; ++r) { p0[r] = 0.f; p1[r] = 0.f; }
#pragma unroll
            for (int d0 = 0; d0 < 8; ++d0) { const int cb = (d0 * 16 + hi * 8) * 2;
                const bf16x8 b0 = *(const LAS bf16x8*)(Kl + KSWZ(r32, cb)), b1 = *(const LAS bf16x8*)(Kl + KSWZ(32 + r32, cb));
                p0 = __builtin_amdgcn_mfma_f32_32x32x16_bf16(b0, qr[d0], p0, 0, 0, 0);
                p1 = __builtin_amdgcn_mfma_f32_32x32x16_bf16(b1, qr[d0], p1, 0, 0, 0); }
            const int base = a.i0 + 64 * T - qi;
            const LAS float* lrow = lut + base + 4 * hi;
            const int wlo = 64 * T - rb * 32 - 31, whi = 64 * T - rb * 32 + 63;
            if (wlo >= 0 && whi <= 2 * side) {
#pragma unroll
                for (int r = 0; r < 16; ++r) { const int c_ = (r & 3) + 8 * (r >> 2);
                    p0[r] = fmaf(p0[r], a.C, lrow[c_]); p1[r] = fmaf(p1[r], a.C, lrow[c_ + 32]); }
            } else {
                const int b0i = base + 4 * hi;
#pragma unroll
                for (int r = 0; r < 16; ++r) { const int c_ = (r & 3) + 8 * (r >> 2);
                    const bool ok0 = (unsigned)(b0i + c_) <= (unsigned)(2 * side), ok1 = (unsigned)(b0i + c_ + 32) <= (unsigned)(2 * side);
                    const float v0 = fmaf(p0[r], a.C, lrow[c_]), v1 = fmaf(p1[r], a.C, lrow[c_ + 32]);
                    p0[r] = ok0 ? v0 : -1e30f; p1[r] = ok1 ? v1 : -1e30f; }
            }
            float pmax = p0[0];
#pragma unroll
            for (int r = 1; r < 16; ++r) pmax = fmaxf(pmax, p0[r]);
#pragma unroll
            for (int r = 0; r < 16; ++r) pmax = fmaxf(pmax, p1[r]);
            { auto rr = __builtin_amdgcn_permlane32_swap(__float_as_uint(pmax), __float_as_uint(pmax), false, false);
              pmax = fmaxf(__uint_as_float(rr[0]), __uint_as_float(rr[1])); }
            const float mn = fmaxf(m_reg, pmax);
            const float alpha = __builtin_amdgcn_exp2f(m_reg - mn);
            m_reg = mn;
            float ps = 0.f;
#pragma unroll
            for (int r = 0; r < 16; ++r) { p0[r] = __builtin_amdgcn_exp2f(p0[r] - mn); p1[r] = __builtin_amdgcn_exp2f(p1[r] - mn); ps += p0[r] + p1[r]; }
            { auto rr = __builtin_amdgcn_permlane32_swap(__float_as_uint(ps), __float_as_uint(ps), false, false);
              ps = __uint_as_float(rr[0]) + __uint_as_float(rr[1]); }
            l_reg = l_reg * alpha + ps;
            if (__any(alpha < 1.f)) {
                if (hi == 0) al_l[r32] = alpha;
                asm volatile("s_waitcnt lgkmcnt(0)" ::: "memory");
#pragma unroll
                for (int r = 0; r < 16; ++r) { const float al = al_l[crow(r, hi)];
#pragma unroll
                    for (int d = 0; d < 4; ++d) o[d][r] *= al; }
            }
            bf16x8 pa0, pa1, pa2, pa3;
#define PK4(P, BASE, OUT) do { unsigned a0 = cvtpk(P[BASE + 0], P[BASE + 1]), a1 = cvtpk(P[BASE + 2], P[BASE + 3]);   \
    unsigned b0 = cvtpk(P[BASE + 4], P[BASE + 5]), b1 = cvtpk(P[BASE + 6], P[BASE + 7]);                              \
    auto r0 = __builtin_amdgcn_permlane32_swap(a0, b0, false, false); auto r1 = __builtin_amdgcn_permlane32_swap(a1, b1, false, false); \
    u32x4 w = {r0[0], r1[0], r0[1], r1[1]}; OUT = *reinterpret_cast<bf16x8*>(&w); } while (0)
            PK4(p0, 0, pa0); PK4(p0, 8, pa1); PK4(p1, 0, pa2); PK4(p1, 8, pa3);
#undef PK4
            pv_one<0>(o[0], vb0, pa0, pa1, pa2, pa3); pv_one<1>(o[1], vb0, pa0, pa1, pa2, pa3);
            pv_one<2>(o[2], vb0, pa0, pa1, pa2, pa3); pv_one<3>(o[3], vb0, pa0, pa1, pa2, pa3);
        }
    }
#undef BLOAD
    if (PROBE >= 1) { float acc_ = l_reg + m_reg; for (int d = 0; d < 4; ++d) for (int r = 0; r < 16; ++r) acc_ += o[d][r]; if (acc_ == 12345.678f) a.O[tid] = 0; return; }
    if (SINK) l_reg += __builtin_amdgcn_exp2f(a.sinks[hw] * LOG2E - m_reg);
    if (hi == 0) li_l[r32] = l_reg;
    if (WLSE) { if (hi == 0) a.lse[hw + (long)qi * a.ldl] = (m_reg + __builtin_amdgcn_logf(l_reg)) * LN2; }
    asm volatile("s_waitcnt lgkmcnt(0)" ::: "memory");
    bf16_t gv[16][4];
#pragma unroll
    for (int r = 0; r < 16; ++r) {
        const bf16_t* gp = a.G + hw * 128 + (long)(a.i0 + rb * 32 + crow(r, hi)) * a.ldg + r32;
#pragma unroll
        for (int d0 = 0; d0 < 4; ++d0) gv[r][d0] = gp[d0 * 32];
    }
#pragma unroll
    for (int r = 0; r < 16; ++r) {
        const int row = crow(r, hi);
        const float rl = __builtin_amdgcn_rcpf(li_l[row]);
        const long i = a.i0 + rb * 32 + row;
        bf16_t* op = a.O + hw * 128 + i * a.ldo + r32;
#pragma unroll
        for (int d0 = 0; d0 < 4; ++d0) {
            const float g = bf2f(gv[r][d0]);
            const float sg = g * __builtin_amdgcn_rcpf(1.0f + __builtin_amdgcn_exp2f(-LOG2E * g));
            op[d0 * 32] = (bf16_t)cvtpk(o[d0][r] * rl * sg, 0.f);
        }
    }
}

__device__ __forceinline__ void attn_phase(lds_u8* lds, const Params& p, int layer, int wg, int nwg) {
    unsigned char* ws = p.ws;
    const bf16_t* proj = (const bf16_t*)(ws + WS_PROJ);
    bf16_t* mixed = (bf16_t*)(ws + WS_MIXED);
    const float2* cs = (const float2*)(ws + WS_CS);
    constexpr int NA = 256, NC = 256, ND = 256, NBU = 384;
    for (int rep = 0; rep < REP_BAND; ++rep)
    for (int it = (rep == 0 ? wg : NA + NC + wg); it < NA + NC + ND + NBU; it += nwg) {
        AttnArgs a; a.lse = nullptr; a.ldl = 0; a.cs = cs; a.side = 0; a.dil = 1; a.bias = p.rel_bias; a.bcol = 0; a.sink2 = 0.f; a.K2 = nullptr; a.ldk2 = 0; a.L = SEQ;
        if (it < NA) {
            #ifdef LINEAR_MAP
            const int c = it, bh = c >> 4, qb = c & 15, b = bh >> 3, h = bh & 7;
#else
            const int c = it, xcd = c & 7, slot = c >> 3, bh = xcd * 2 + (slot >> 4), qb = slot & 15, b = bh >> 3, h = bh & 7;
#endif
            const size_t t0 = (size_t)b * SEQ;
            const bf16_t* qraw = (const bf16_t*)(ws + WS_QRAW); const bf16_t* kvraw = (const bf16_t*)(ws + WS_KVRAW); const bf16_t* kpe = (const bf16_t*)(ws + WS_KPE);
            a.Q = qraw + t0 * 1536 + h * 192; a.ldq = 1536;
            a.K = kvraw + t0 * 2048 + h * 256; a.ldk = 2048; a.K2 = kpe + t0 * 64; a.ldk2 = 64;
            a.V = kvraw + t0 * 2048 + h * 256 + 128; a.ldv = 2048;
            a.G = proj + t0 * NINP + C_GATE + MX_A + h * 128; a.ldg = NINP;
            a.O = mixed + t0 * MIXW + MX_A + h * 128; a.ldo = MIXW;
            a.i0 = qb * 256; a.C = 0.07216878364870322f * LOG2E;
#ifdef SIMPLE_DENSE
            attn_unit<192, false, false, false, true>(lds, a);
#else
            #ifndef DENSE3BUF
            for (int rep = 0; rep < REP_A; ++rep) attn_dense_unit<192, true, 1>(lds, a);
#else
            for (int rep = 0; rep < REP_A; ++rep) attn_dense_unit3<192, true>(lds, a);
#endif
#endif
        } else if (it < NA + NC) {
            #ifdef LINEAR_MAP
            const int c = it - NA, pair = c >> 4, qb = c & 15, b = pair >> 3, hq = pair & 7, hk = hq >> 2;
#else
            const int c = it - NA, xcd = c & 7, slot = c >> 3, pair = xcd * 2 + (slot >> 4), qb = slot & 15, b = pair >> 3, hq = pair & 7, hk = hq >> 2;
#endif
            const size_t t0 = (size_t)b * SEQ;
            const bf16_t* qc = (const bf16_t*)(ws + WS_QC); const bf16_t* kc = (const bf16_t*)(ws + WS_KC);
            a.Q = qc + t0 * 1024 + hq * 128; a.ldq = 1024;
            a.K = kc + t0 * 256 + hk * 128; a.ldk = 256;
            a.V = proj + t0 * NINP + C_CV + hk * 128; a.ldv = NINP;
            a.G = proj + t0 * NINP + C_GATE + MX_C + hq * 128; a.ldg = NINP;
            a.O = mixed + t0 * MIXW + MX_C + hq * 128; a.ldo = MIXW;
            a.i0 = qb * 256; a.C = 0.08838834764831845f * LOG2E;
#ifdef SIMPLE_DENSE
            attn_unit<128, false, false, false, false>(lds, a);
#else
            #ifndef DENSE3BUF
            for (int rep = 0; rep < REP_C; ++rep) attn_dense_unit<128, false, 2>(lds, a);
#else
            for (int rep = 0; rep < REP_C; ++rep) attn_dense_unit3<128, false>(lds, a);
#endif
#endif
        } else if (it < NA + NC + ND) {
            const int c = it - NA - NC, blk = c & 63, hk = (c >> 6) & 1, b = c >> 7;
            const size_t t0 = (size_t)b * SEQ;
            BandArgs d;
            d.Q = proj + t0 * NINP + C_DQ + hk * 512; d.ldq = NINP;
            d.K = proj + t0 * NINP + C_DK + hk * 128; d.V = proj + t0 * NINP + C_DV + hk * 128; d.ldk = NINP;
            d.G = proj + t0 * NINP + C_GATE + MX_D + hk * 512; d.ldg = NINP;
            d.O = mixed + t0 * MIXW + MX_D + hk * 512; d.ldo = MIXW;
            d.lse = nullptr; d.ldl = 0; d.bias = p.rel_bias + 12 + hk * 4; d.sinks = p.sinks + layer * 8 + hk * 4;
            d.i0 = blk * 64; d.L = SEQ; d.side = 128; d.dil = 1; d.nt = 5; d.C = 0.08838834764831845f * LOG2E;
#if defined(PROBE_D)
            attn_band_unit<4, true, false, PROBE_D>(lds, d);
#endif
            for (int rep2 = 0; rep2 < REP_D; ++rep2) attn_band_unit<4, true, false>(lds, d);
        } else {
            const int c = it - NA - NC - ND, u = c & 15, hh = (c >> 4) & 3, j = (c >> 6) % 3, b = c / 192;
            const int dil = (j == 0) ? 1 : (j == 1 ? 4 : 16), L = SEQ / dil, nblk = L / 256, r = u / nblk, qb = u % nblk;
            const size_t t0 = (size_t)b * SEQ + r; const int head = j * 4 + hh;
            BandArgs d;
            d.Q = proj + t0 * NINP + C_BQ + head * 128; d.ldq = (long)dil * NINP;
            d.K = proj + t0 * NINP + C_BK + head * 128; d.V = proj + t0 * NINP + C_BV + head * 128; d.ldk = (long)dil * NINP;
            d.G = proj + t0 * NINP + C_GATE + MX_B + head * 128; d.ldg = (long)dil * NINP;
            d.O = mixed + t0 * MIXW + MX_B + head * 128; d.ldo = (long)dil * MIXW;
            d.lse = (float*)(ws + WS_LSE) + ((size_t)j * MTOK + t0) * 4 + hh; d.ldl = (long)dil * 4;
            d.bias = p.rel_bias + head; d.sinks = nullptr;
            d.i0 = qb * 256; d.L = L; d.side = 64; d.dil = dil; d.nt = 6; d.C = 0.08838834764831845f * LOG2E;
            for (int rep2 = 0; rep2 < REP_B; ++rep2) attn_band_unit<1, false, true>(lds, d);
        }
    }
}

#define XB_TMO      128
#define XB_XCNT(j)  (256  + 64 * (j))
#define XB_XSUB(j)  (1280 + 64 * (j))
#define XB_XGEN(j)  (2304 + 64 * (j))
#define XB_TOP      3328
#define XB_TOPGEN   3392
#define XCD_BAR_WORDS 3456
#define XB_SPIN_CAP (1u << 18)

__device__ __forceinline__ unsigned xb_ld(unsigned* p)              { return __hip_atomic_load(p, __ATOMIC_RELAXED, __HIP_MEMORY_SCOPE_AGENT); }
__device__ __forceinline__ unsigned xb_add(unsigned* p, unsigned v) { return __hip_atomic_fetch_add(p, v, __ATOMIC_RELAXED, __HIP_MEMORY_SCOPE_AGENT); }
__device__ __forceinline__ unsigned xb_xcc_id() { return (unsigned)__builtin_amdgcn_s_getreg((3 << 11) | 20) & 0xFu; }
#define XB_SPIN(cond, bar) do { unsigned _sp = 0; while (cond) { __builtin_amdgcn_s_sleep(1); \
    if ((++_sp & 255u) == 0u) { if (xb_ld(&(bar)[XB_TMO])) break; if (_sp > XB_SPIN_CAP) { atomicAdd(&(bar)[XB_TMO], 1u); break; } } } } while (0)

struct XcdBarrier {
    unsigned* bar; unsigned x;
    volatile LAS unsigned* st;
};

__device__ __forceinline__ XcdBarrier xcd_barrier_post(unsigned* bar, volatile LAS unsigned* st) {
    XcdBarrier b; b.bar = bar; b.x = xb_xcc_id(); b.st = st;
    if (threadIdx.x == 0) (void)xb_add(&bar[XB_XCNT(b.x)], 1u);
    return b;
}
__device__ __forceinline__ void xcd_barrier_complete(unsigned* bar, unsigned x, unsigned& nloc, unsigned& nx) {
    const unsigned G = gridDim.x * gridDim.y * gridDim.z;
    unsigned sum, cnt, mine, sp = 0u;
    for (;;) {
        sum = 0u; cnt = 0u; mine = 0u;
#pragma unroll
        for (unsigned j = 0; j < 16; ++j) { const unsigned c = xb_ld(&bar[XB_XCNT(j)]); sum += c; cnt += (c > 0u) ? 1u : 0u; mine = (j == x) ? c : mine; }
        if (sum == G) break;
        __builtin_amdgcn_s_sleep(1);
        if ((++sp & 255u) == 0u) { if (xb_ld(&bar[XB_TMO])) break; if (sp > XB_SPIN_CAP) { atomicAdd(&bar[XB_TMO], 1u); break; } }
    }
    nloc = mine > 0u ? mine : 1u; nx = cnt > 0u ? cnt : 1u;
}

__device__ __forceinline__ void xcd_barrier(const XcdBarrier& b) {
    asm volatile("s_waitcnt vmcnt(0)" ::: "memory");
    __syncthreads();
    if (threadIdx.x == 0) {
        unsigned* bar = b.bar;
        __builtin_amdgcn_s_waitcnt(0);
        unsigned nloc = b.st[0], nx = b.st[1];
        if (nloc == 0u) { xcd_barrier_complete(bar, b.x, nloc, nx); b.st[0] = nloc; b.st[1] = nx; }
        const unsigned old = xb_add(&bar[XB_XSUB(b.x)], 1u);
        const unsigned gen = old / nloc;
        if (old + 1u == (gen + 1u) * nloc) {
            __builtin_amdgcn_fence(__ATOMIC_RELEASE, "agent");
            asm volatile("s_waitcnt vmcnt(0)" ::: "memory");
            const unsigned og = xb_add(&bar[XB_TOP], 1u);
            const unsigned tg = og / nx;
            if (og + 1u == (tg + 1u) * nx) xb_add(&bar[XB_TOPGEN], 1u);
            else XB_SPIN(xb_ld(&bar[XB_TOPGEN]) == tg, bar);
            __builtin_amdgcn_fence(__ATOMIC_ACQUIRE, "agent");
            xb_add(&bar[XB_XGEN(b.x)], 1u);
            asm volatile("s_waitcnt vmcnt(0)" ::: "memory");
        } else {
            XB_SPIN(xb_ld(&bar[XB_XGEN(b.x)]) == gen, bar);
            __builtin_amdgcn_fence(__ATOMIC_ACQUIRE, "agent");
            asm volatile("s_waitcnt vmcnt(0)" ::: "memory");
        }
    }
    __syncthreads();
}

__global__ void __launch_bounds__(512) hymba_fwd(Params p0) {
    extern __shared__ __attribute__((aligned(16))) unsigned char shm[];
    lds_u8* lds = (lds_u8*)shm;
    cg::grid_group grid = cg::this_grid();
    const int wg0 = blockIdx.x, nwg0 = gridDim.x;
    const int lo = p0.ph_lo, hi = p0.ph_hi;
    if (lo < 0) grid.sync();
    volatile LAS unsigned* bst = (volatile LAS unsigned*)(lds + LDS_BYTES - 256);
    if (threadIdx.x == 0) { bst[0] = 0u; bst[1] = 0u; }
    __syncthreads();
    XcdBarrier xbar = xcd_barrier_post((unsigned*)(p0.ws + WS_BAR), bst);
    int ph = 0;
#define PH_BEGIN if (lo <= ph && ph < hi) { auto kp4 = (__attribute__((address_space(4))) const char*)__builtin_amdgcn_kernarg_segment_ptr(); asm volatile("" : "+s"(kp4)); \
    const Params& p = *(const Params*)kp4; unsigned char* ws = p.ws; int wg = wg0, nwg = nwg0; asm volatile("" : "+s"(wg), "+s"(nwg)); \
    bf16_t* WinT = (bf16_t*)(ws + WS_WIN); bf16_t* WoutT = (bf16_t*)(ws + WS_WOUT); bf16_t* WuqT = (bf16_t*)(ws + WS_WUQ); bf16_t* WukvT = (bf16_t*)(ws + WS_WUKV); \
    bf16_t* H = (bf16_t*)(ws + WS_H); bf16_t* PROJ = (bf16_t*)(ws + WS_PROJ); float* X1 = (float*)(ws + WS_X1); \
    bf16_t* QAN = (bf16_t*)(ws + WS_QAN); bf16_t* KVAN = (bf16_t*)(ws + WS_KVAN); bf16_t* KPE = (bf16_t*)(ws + WS_KPE); \
    bf16_t* QRAW = (bf16_t*)(ws + WS_QRAW); bf16_t* KVRAW = (bf16_t*)(ws + WS_KVRAW); bf16_t* QC = (bf16_t*)(ws + WS_QC); bf16_t* KC = (bf16_t*)(ws + WS_KC); \
    bf16_t* MIXED = (bf16_t*)(ws + WS_MIXED); bf16_t* DELTA = (bf16_t*)(ws + WS_DELTA); (void)DELTA; float* LSE = (float*)(ws + WS_LSE); float2* CS = (float2*)(ws + WS_CS); \
    (void)WinT; (void)WoutT; (void)WuqT; (void)WukvT; (void)H; (void)PROJ; (void)X1; (void)QAN; (void)KVAN; (void)KPE; (void)QRAW; (void)KVRAW; (void)QC; (void)KC; (void)MIXED; (void)LSE; (void)CS;
#define PH_END } if (lo <= ph && ph + 1 < hi) xcd_barrier(xbar); ++ph;

    PH_BEGIN
        for (int rep = 0; rep < REP_CVT; ++rep) for (int l = 0; l < ((nwg == 256) ? CVT_P0_LAYERS : 2); ++l) {
            cvt_transpose(p.w_in + (size_t)l * DM * NIN, WinT + (size_t)l * NINP * DM, DM, NIN, NINP, lds, wg, nwg);
            if (HIDE_TAIL && nwg == 256 && l == 1) continue;
            cvt_transpose(p.w_out + (size_t)l * MIXW * DM, WoutT + (size_t)l * DM * MIXW, MIXW, DM, DM, lds, wg, nwg);
            cvt_transpose(p.w_uq + (size_t)l * 768 * 1536, WuqT + (size_t)l * 1536 * 768, 768, 1536, 1536, lds, wg, nwg);
            cvt_transpose(p.w_ukv + (size_t)l * 512 * 2048, WukvT + (size_t)l * 2048 * 512, 512, 2048, 2048, lds, wg, nwg);
        }
        build_cs(CS, wg, nwg);
        rmsnorm_rows<0, true>(p.x, nullptr, nullptr, p.g_attn, H, nullptr, wg, nwg);
    PH_END

#pragma unroll 1
    for (int l = 0; l < 2; ++l) {
        if (l > 0) {
            PH_BEGIN
                rmsnorm_rows<1, true>(p.x, DELTA, nullptr, p.g_attn + (size_t)l * DM, H, nullptr, wg, nwg);
            PH_END
        }
        PH_BEGIN
#ifndef NO_GEMM
            pg8::Gemm g{H, WinT + (size_t)l * NINP * DM, MTOK, NINP, DM}; pg8::StaticOrder S; S.init(MTOK, NINP, nwg, wg);
            pg8::EpiBf16P E{PROJ, NINP};
            for (int rep = 0; rep < REP_GEMM; ++rep)
            pg8::gemm_phase<pg8::EpiBf16P, pg8::StaticOrder, GEMM_ALIGN, GEMM_SP2>(lds, g, S, E);
            if (CVT_P0_LAYERS == 1 && l == 0 && nwg == 256 && wg >= 192)
                cvt_transpose(p.w_in + (size_t)DM * NIN, WinT + (size_t)NINP * DM, DM, NIN, NINP, lds, wg - 192, 64);
#endif
        PH_END
        PH_BEGIN
            for (int rep = 0; rep < REP_MISC; ++rep) prep_tokens(PROJ, p.g_qa + l * 768, p.g_kva + l * 512, p.g_qn + l * 128, p.g_kn + l * 128, CS, QAN, KVAN, KPE, QC, KC, (bf16_t*)(ws + WS_DKV), wg, nwg);
        PH_END
        PH_BEGIN
#ifndef NO_GEMM
            for (int rep = 0; rep < REP_UP; ++rep) {
            { pg8::Gemm g{QAN, WuqT + (size_t)l * 1536 * 768, MTOK, 1536, 768}; pg8::StaticOrder S; S.init(MTOK, 1536, nwg, wg);
              pg8::EpiBf16P E{QRAW, 1536};
              pg8::gemm_phase<pg8::EpiBf16P, pg8::StaticOrder, GEMM_ALIGN, GEMM_SP2>(lds, g, S, E); }
            { pg8::Gemm g{KVAN, WukvT + (size_t)l * 2048 * 512, MTOK, 2048, 512}; pg8::StaticOrder S; S.init(MTOK, 2048, nwg, nwg - 1 - wg);
              pg8::EpiBf16P E{KVRAW, 2048};
              pg8::gemm_phase<pg8::EpiBf16P, pg8::StaticOrder, GEMM_ALIGN, GEMM_SP2>(lds, g, S, E); }
            }
#endif
        PH_END
        PH_BEGIN
#ifndef NO_ATTN
            for (int rep = 0; rep < REP_ATTN; ++rep) attn_phase(lds, p, l, wg, nwg);
            if ((CVT_P0_LAYERS == 1 || HIDE_TAIL) && l == 0 && nwg == 256 && wg >= 128) {
                cvt_transpose(p.w_out + (size_t)MIXW * DM, WoutT + (size_t)DM * MIXW, MIXW, DM, DM, lds, wg - 128, 128);
                cvt_transpose(p.w_uq + (size_t)768 * 1536, WuqT + (size_t)1536 * 768, 768, 1536, 1536, lds, wg - 128, 128);
                cvt_transpose(p.w_ukv + (size_t)512 * 2048, WukvT + (size_t)2048 * 512, 512, 2048, 2048, lds, wg - 128, 128);
            }
#endif
        PH_END
        PH_BEGIN
            fixup_b(MIXED, LSE, wg, nwg);
        PH_END
        PH_BEGIN
#ifndef NO_GEMM
            pg8::Gemm g{MIXED, WoutT + (size_t)l * DM * MIXW, MTOK, DM, MIXW}; pg8::StaticOrder S; S.init(MTOK, DM, nwg, wg);
            pg8::EpiBf16P E{DELTA + (size_t)l * MTOK * DM, DM};
            for (int rep = 0; rep < REP_OUT; ++rep)
            pg8::gemm_phase<pg8::EpiBf16P, pg8::StaticOrder, GEMM_ALIGN, GEMM_SP2>(lds, g, S, E);
#endif
        PH_END
    }
    for (int rep = 0; rep < REP_SYNC; ++rep) xcd_barrier(xbar);
    PH_BEGIN
        rmsnorm_rows<2, false>(p.x, DELTA, DELTA + (size_t)MTOK * DM, p.g_final, nullptr, p.out, wg, nwg);
    PH_END
#undef PH_BEGIN
#undef PH_END
}

constexpr int N_PHASES = 15;

extern "C" void kernel_launch(void* const* d_in, const int* in_sizes, int n_in, void* d_out, int out_size, void* d_ws, size_t ws_size, hipStream_t stream) {
    static int grid_blocks = 0;
    if (grid_blocks == 0) {
        if (n_in != 13 || ws_size < WS_END || out_size != MTOK * DM) { fprintf(stderr, "kernel_launch: unexpected shapes (n_in %d, out %d, ws %zu, need %zu)\n", n_in, out_size, ws_size, (size_t)WS_END); grid_blocks = -1; return; }
        int dev = 0, cus = 0, per_cu = 0;
        hipGetDevice(&dev);
        hipDeviceGetAttribute(&cus, hipDeviceAttributeMultiprocessorCount, dev);
        if (hipFuncSetAttribute((const void*)hymba_fwd, hipFuncAttributeMaxDynamicSharedMemorySize, LDS_BYTES) != hipSuccess) { fprintf(stderr, "kernel_launch: hipFuncSetAttribute failed\n"); grid_blocks = -1; return; }
        if (hipOccupancyMaxActiveBlocksPerMultiprocessor(&per_cu, (const void*)hymba_fwd, 512, LDS_BYTES) != hipSuccess || per_cu < 1) { fprintf(stderr, "kernel_launch: occupancy query gave %d\n", per_cu); per_cu = 1; }
        (void)hipGetLastError();
        grid_blocks = cus * 1;
        fprintf(stderr, "kernel_launch: cus %d per_cu %d grid %d\n", cus, per_cu, grid_blocks);
    }
    if (grid_blocks < 0) return;
    Params p{};
    p.x = (const float*)d_in[0]; p.g_attn = (const float*)d_in[1]; p.w_in = (const float*)d_in[2]; p.g_qa = (const float*)d_in[3]; p.g_kva = (const float*)d_in[4];
    p.w_uq = (const float*)d_in[5]; p.w_ukv = (const float*)d_in[6]; p.g_qn = (const float*)d_in[7]; p.g_kn = (const float*)d_in[8]; p.sinks = (const float*)d_in[9];
    p.w_out = (const float*)d_in[10]; p.rel_bias = (const float*)d_in[11]; p.g_final = (const float*)d_in[12];
    p.out = (float*)d_out; p.ws = (unsigned char*)d_ws;
#if defined(MULTI_LAUNCH)
    for (int k = 0; k < N_PHASES; ++k) { p.ph_lo = k; p.ph_hi = k + 1; hipLaunchKernelGGL(hymba_fwd, dim3(grid_blocks), dim3(512), LDS_BYTES, stream, p); }
#else
    p.ph_lo = 0; p.ph_hi = N_PHASES;
    if (hipMemsetAsync((char*)d_ws + WS_BAR, 0, 3456 * 4, stream) != hipSuccess) { fprintf(stderr, "kernel_launch: memset of the barrier words failed\n"); return; }
    void* args[] = {&p};
    hipError_t e = hipLaunchCooperativeKernel((const void*)hymba_fwd, dim3(grid_blocks), dim3(512), args, LDS_BYTES, stream);
    if (e != hipSuccess) fprintf(stderr, "cooperative launch failed: %s (grid %d)\n", hipGetErrorString(e), grid_blocks);
#endif
}
```

```cpp
#include <hip/hip_runtime.h>
#include <hip/hip_cooperative_groups.h>
#include <cstdio>
namespace cg = cooperative_groups;
namespace pg8 {
#define PG8_LAS __attribute__((address_space(3)))
typedef unsigned short bf16_t;
__device__ __forceinline__ int opaque_tid() { int t = threadIdx.x; asm volatile("" : "+v"(t)); return t; }
typedef short bf16x8 __attribute__((ext_vector_type(8)));
typedef float f32x4 __attribute__((ext_vector_type(4)));
typedef unsigned u32x4 __attribute__((ext_vector_type(4)));
constexpr int BM = 256, BK = 64, HALF = 128, HTB = HALF * BK * 2  , STAGE_BYTES = 8 * HTB, NXCD = 8, WGM = 8;

__host__ __device__ __forceinline__ int lds_byte(int r, int c) { const int st = (r >> 4) * 2 + (c >> 5), rr = r & 15, cc = c & 31, ob = rr * 64 + cc * 2; return st * 1024 + (ob ^ (((ob >> 9) & 1) << 5)); }
__host__ __device__ __forceinline__ void stage_rc(int b, int& R, int& C) { const int st = b / 1024, sb = b % 1024, swz = sb ^ (((sb >> 9) & 1) << 5); R = (st >> 1) * 16 + swz / 64; C = (st & 1) * 32 + (swz % 64) / 2; }
__host__ __device__ __forceinline__ int perm32(int rho) { const int n = rho >> 4, i = rho & 15; return 8 * (i >> 2) + 4 * n + (i & 3); }

struct Unit { int pm, pn; };
struct Gemm { const bf16_t* A; const bf16_t* Bt; int M, N, K; };
struct StaticOrder {
    int nM, nN, nwg, G, c;
    __host__ __device__ void init(int M, int N, int G_, int c_) { nM = M / BM; nN = N / BM; nwg = nM * nN; G = G_; c = c_; }
    __host__ __device__ bool next(int i, Unit& u) const {
        const long L = (long)i * G + c; if (L >= nwg) return false;
        int wgid = (int)L; { const int q = nwg / NXCD, r = nwg % NXCD, xcd = wgid % NXCD, off = wgid / NXCD; wgid = (xcd < r ? xcd * (q + 1) : r * (q + 1) + (xcd - r) * q) + off; }
        const int nig = WGM * nN, gid = wgid / nig, fm = gid * WGM, gsz = (nM - fm) < WGM ? (nM - fm) : WGM;
        u.pm = fm + ((wgid % nig) % gsz); u.pn = (wgid % nig) / gsz; return true;
    }
    __device__ __forceinline__ void a_ready(const Unit&) const {}
    __device__ __forceinline__ void done(const Unit&) const {}
};
__device__ __forceinline__ unsigned cvt_pk_bf16(float lo, float hi) { unsigned r; asm volatile("v_cvt_pk_bf16_f32 %0, %1, %2" : "=v"(r) : "v"(lo), "v"(hi)); return r; }
typedef float f32x2 __attribute__((ext_vector_type(2)));
struct EpiBf16P {
    static constexpr bool PERM = true, AFTER_DRAIN = false;
    bf16_t* O; int ldc;
    __device__ __forceinline__ void operator()(const f32x4 (&acc)[2][2][4][2], const Unit& u, int wr, int wc, int fr, int fq) const {
        const int row0 = u.pm * BM + wr * 64 + fr; const int col0 = u.pn * BM + wc * 32 + 8 * fq;
#pragma unroll
        for (int ai = 0; ai < 2; ++ai)
#pragma unroll
            for (int m = 0; m < 4; ++m) { bf16_t* rowp = O + (size_t)(row0 + ai * HALF + m * 16) * ldc + col0;
#pragma unroll
                for (int bj = 0; bj < 2; ++bj) { const f32x4 v0 = acc[ai][bj][m][0], v1 = acc[ai][bj][m][1];
                    u32x4 w; w.x = cvt_pk_bf16(v0[0], v0[1]); w.y = cvt_pk_bf16(v0[2], v0[3]); w.z = cvt_pk_bf16(v1[0], v1[1]); w.w = cvt_pk_bf16(v1[2], v1[3]);
                    *(u32x4*)(rowp + bj * HALF) = w; } }
    }
};
struct EpiResF32 {
    static constexpr bool PERM = false, AFTER_DRAIN = false;
    const float* base; float* out; int ldc;
    __device__ __forceinline__ void operator()(const f32x4 (&acc)[2][2][4][2], const Unit& u, int wr, int wc, int fr, int fq) const {
        const int row0 = u.pm * BM + wr * 64 + fr, col0 = u.pn * BM + wc * 32 + 4 * fq;
#pragma unroll
        for (int ai = 0; ai < 2; ++ai)
#pragma unroll
            for (int m = 0; m < 4; ++m) { const size_t off = (size_t)(row0 + ai * HALF + m * 16) * ldc + col0;
#pragma unroll
                for (int bj = 0; bj < 2; ++bj)
#pragma unroll
                    for (int n = 0; n < 2; ++n) { const f32x4 b = *(const f32x4*)(base + off + bj * HALF + n * 16); *(f32x4*)(out + off + bj * HALF + n * 16) = acc[ai][bj][m][n] + b; } }
    }
};
template <class Epi, class Sched, bool ALIGN_EPI = false, bool SP2 = false>
__device__ __forceinline__ void gemm_phase(PG8_LAS unsigned char* lds, const Gemm g, const Sched& S, const Epi& E) {
    const int tid = opaque_tid(), wid = __builtin_amdgcn_readfirstlane(tid >> 6), lane = tid & 63, wr = wid >> 2, wc = wid & 3, fr = lane & 15, fq = lane >> 4;
    const int K = g.K, nt = K / BK;
    unsigned voffA[2], voffB[2];
#pragma unroll
    for (int i = 0; i < 2; ++i) { int R, C; stage_rc(tid * 16 + i * 8192, R, C); const int Rb = Epi::PERM ? ((R & ~31) + perm32(R & 31)) : R;
        voffA[i] = (unsigned)(R * K + C) * 2u; voffB[i] = (unsigned)(Rb * K + C) * 2u; }
    const size_t kstep = (size_t)(BK * 2);
    const size_t hstep = (size_t)HALF * K * 2;
    const size_t tstep = 2 * hstep;
    const unsigned ldsw = (unsigned)wid * 1024u;
    const int aoff = lds_byte(wr * 64 + fr, fq * 8), boff = lds_byte(wc * 32 + fr, fq * 8);
#define PG8_SA(b, h) (((b) * 2 + (h)) * HTB)
#define PG8_SB(b, h) ((4 + (b) * 2 + (h)) * HTB)
#define PG8_STAGE(bufoff, gbase, voff) do { _Pragma("unroll") for (int _i = 0; _i < 2; ++_i) \
        __builtin_amdgcn_global_load_lds((const unsigned*)((const char*)(gbase) + (voff)[_i]), (PG8_LAS unsigned*)(lds + (bufoff) + ldsw + _i * 8192), 16, 0, 0); } while (0)
#define PG8_LDA(dst, b, h) do { _Pragma("unroll") for (int m = 0; m < 4; ++m) _Pragma("unroll") for (int k = 0; k < 2; ++k) dst[m][k] = *(const PG8_LAS bf16x8*)(lds + PG8_SA(b, h) + aoff + m * 2048 + k * 1024); } while (0)
#define PG8_LDB(dst, b, h) do { _Pragma("unroll") for (int n = 0; n < 2; ++n) _Pragma("unroll") for (int k = 0; k < 2; ++k) dst[n][k] = *(const PG8_LAS bf16x8*)(lds + PG8_SB(b, h) + boff + n * 2048 + k * 1024); } while (0)
#define PG8_MMA(ai, bj, At, Bt) do { __builtin_amdgcn_s_setprio(1); _Pragma("unroll") for (int m = 0; m < 4; ++m) _Pragma("unroll") for (int n = 0; n < 2; ++n) _Pragma("unroll") for (int k = 0; k < 2; ++k) \
        acc[ai][bj][m][n] = __builtin_amdgcn_mfma_f32_16x16x32_bf16(Bt[n][k], At[m][k], acc[ai][bj][m][n], 0, 0, 0); __builtin_amdgcn_s_setprio(0); } while (0)
#define PG8_WAIT_V(n) asm volatile("s_waitcnt vmcnt(" #n ")" ::: "memory")
#define PG8_WAIT_L(n) asm volatile("s_waitcnt lgkmcnt(" #n ")" ::: "memory")
#define PG8_BAR __builtin_amdgcn_s_barrier()
#define PG8_SCHED __builtin_amdgcn_sched_barrier(0)
    Unit cur, nxt; int ui = 0;
    if (!S.next(0, cur)) return;
    f32x4 acc[2][2][4][2];
#pragma unroll
    for (int a = 0; a < 2; ++a)
#pragma unroll
        for (int b = 0; b < 2; ++b)
#pragma unroll
            for (int m = 0; m < 4; ++m)
#pragma unroll
                for (int n = 0; n < 2; ++n) acc[a][b][m][n] = (f32x4){0.f, 0.f, 0.f, 0.f};
    bf16x8 At[4][2], B0[2][2], B1[2][2];
    const char* cA = (const char*)g.A + (size_t)cur.pm * tstep; const char* cB = (const char*)g.Bt + (size_t)cur.pn * tstep;
    S.a_ready(cur);
    if constexpr (SP2) {
        PG8_STAGE(PG8_SB(0, 0), cB, voffB); PG8_STAGE(PG8_SB(0, 1), cB + hstep, voffB); PG8_STAGE(PG8_SA(0, 0), cA, voffA); PG8_STAGE(PG8_SA(0, 1), cA + hstep, voffA);
        if (wr == 1) PG8_BAR;
        PG8_WAIT_V(2); PG8_BAR;
        PG8_STAGE(PG8_SB(1, 0), cB + kstep, voffB); PG8_STAGE(PG8_SA(1, 0), cA + kstep, voffA); PG8_STAGE(PG8_SB(1, 1), cB + hstep + kstep, voffB);
        PG8_WAIT_V(6); PG8_BAR;
    } else {
        PG8_STAGE(PG8_SB(0, 0), cB, voffB); PG8_STAGE(PG8_SA(0, 0), cA, voffA); PG8_STAGE(PG8_SB(0, 1), cB + hstep, voffB); PG8_STAGE(PG8_SA(0, 1), cA + hstep, voffA);
        if (wr == 1) PG8_BAR;
        PG8_WAIT_V(4); PG8_BAR;
        PG8_STAGE(PG8_SB(1, 0), cB + kstep, voffB); PG8_STAGE(PG8_SA(1, 0), cA + kstep, voffA); PG8_STAGE(PG8_SB(1, 1), cB + hstep + kstep, voffB);
        PG8_WAIT_V(6); PG8_BAR;
    }
    for (;;) {
        const bool has_next = S.next(ui + 1, nxt);
        const char* nA = has_next ? (const char*)g.A + (size_t)nxt.pm * tstep : cA; const char* nB = has_next ? (const char*)g.Bt + (size_t)nxt.pn * tstep : cB;
        for (int t = 0; t < nt; t += 2) {
            const bool last = (t == nt - 2);
            const char* a1 = cA + (size_t)(t + 1) * kstep;
            const char* a2 = last ? nA : cA + (size_t)(t + 2) * kstep; const char* b2 = last ? nB : cB + (size_t)(t + 2) * kstep;
            const char* a3 = a2 + kstep; const char* b3 = b2 + kstep;
            if (last && has_next) S.a_ready(nxt);
            if constexpr (SP2) {
            PG8_LDB(B0, 0, 0); PG8_LDB(B1, 0, 1); PG8_SCHED; PG8_LDA(At, 0, 0); PG8_STAGE(PG8_SA(1, 1), a1 + hstep, voffA);
            PG8_WAIT_V(8); PG8_WAIT_L(0); PG8_BAR; PG8_MMA(0, 0, At, B0); PG8_MMA(0, 1, At, B1); PG8_BAR; PG8_SCHED;
            PG8_LDA(At, 0, 1); PG8_STAGE(PG8_SB(0, 0), b2, voffB); PG8_STAGE(PG8_SB(0, 1), b2 + hstep, voffB); PG8_STAGE(PG8_SA(0, 0), a2, voffA);
            PG8_WAIT_V(8); PG8_WAIT_L(0); PG8_BAR; PG8_MMA(1, 0, At, B0); PG8_MMA(1, 1, At, B1); PG8_BAR; PG8_SCHED;
            PG8_LDB(B0, 1, 0); PG8_LDB(B1, 1, 1); PG8_SCHED; PG8_LDA(At, 1, 0); PG8_STAGE(PG8_SA(0, 1), a2 + hstep, voffA);
            PG8_WAIT_V(8); PG8_WAIT_L(0); PG8_BAR; PG8_MMA(0, 0, At, B0); PG8_MMA(0, 1, At, B1); PG8_BAR; PG8_SCHED;
            PG8_LDA(At, 1, 1); PG8_STAGE(PG8_SB(1, 0), b3, voffB); PG8_STAGE(PG8_SB(1, 1), b3 + hstep, voffB); PG8_STAGE(PG8_SA(1, 0), a3, voffA);
            PG8_WAIT_V(8); PG8_WAIT_L(0); PG8_BAR; PG8_MMA(1, 0, At, B0); PG8_MMA(1, 1, At, B1); PG8_BAR; PG8_SCHED;
            } else {
            PG8_LDB(B0, 0, 0); PG8_SCHED; PG8_LDA(At, 0, 0); PG8_STAGE(PG8_SA(1, 1), a1 + hstep, voffA);
            PG8_WAIT_L(8); PG8_BAR; PG8_WAIT_L(0); PG8_MMA(0, 0, At, B0); PG8_BAR; PG8_SCHED;
            PG8_LDB(B1, 0, 1); PG8_STAGE(PG8_SB(0, 0), b2, voffB);
            PG8_BAR; PG8_WAIT_L(0); PG8_MMA(0, 1, At, B1); PG8_BAR;
            PG8_LDA(At, 0, 1); PG8_STAGE(PG8_SA(0, 0), a2, voffA);
            PG8_BAR; PG8_WAIT_L(0); PG8_MMA(1, 0, At, B0); PG8_BAR; PG8_SCHED;
            PG8_STAGE(PG8_SB(0, 1), b2 + hstep, voffB);
            PG8_WAIT_V(6); PG8_BAR; PG8_MMA(1, 1, At, B1); PG8_BAR;
            PG8_LDB(B0, 1, 0); PG8_SCHED; PG8_LDA(At, 1, 0); PG8_STAGE(PG8_SA(0, 1), a2 + hstep, voffA);
            PG8_WAIT_L(8); PG8_BAR; PG8_WAIT_L(0); PG8_MMA(0, 0, At, B0); PG8_BAR; PG8_SCHED;
            PG8_LDB(B1, 1, 1); PG8_STAGE(PG8_SB(1, 0), b3, voffB);
            PG8_BAR; PG8_WAIT_L(0); PG8_MMA(0, 1, At, B1); PG8_BAR;
            PG8_LDA(At, 1, 1); PG8_STAGE(PG8_SA(1, 0), a3, voffA);
            PG8_BAR; PG8_WAIT_L(0); PG8_MMA(1, 0, At, B0); PG8_BAR; PG8_SCHED;
            PG8_STAGE(PG8_SB(1, 1), b3 + hstep, voffB);
            PG8_WAIT_V(6); PG8_BAR; PG8_MMA(1, 1, At, B1); PG8_BAR;
            }
        }
        if constexpr (ALIGN_EPI) { if (wr == 0) PG8_BAR; }
        if constexpr (!Epi::AFTER_DRAIN) { E(acc, cur, wr, wc, fr, fq); S.done(cur); }
        if (!has_next) break;
#pragma unroll
        for (int a = 0; a < 2; ++a)
#pragma unroll
            for (int b = 0; b < 2; ++b)
#pragma unroll
                for (int m = 0; m < 4; ++m)
#pragma unroll
                    for (int n = 0; n < 2; ++n) acc[a][b][m][n] = (f32x4){0.f, 0.f, 0.f, 0.f};
        cur = nxt; cA = nA; cB = nB; ++ui;
        if constexpr (ALIGN_EPI) { if (wr == 1) PG8_BAR; }
    }
    PG8_WAIT_V(0);
    if constexpr (!ALIGN_EPI) { if (wr == 0) PG8_BAR; }
    PG8_BAR;
    if constexpr (Epi::AFTER_DRAIN) { E.fused(acc, cur, wr, wc, fr, fq, lds, wid, lane); S.done(cur); }
#undef PG8_SA
#undef PG8_SB
#undef PG8_STAGE
#undef PG8_LDA
#undef PG8_LDB
#undef PG8_MMA
#undef PG8_WAIT_V
#undef PG8_WAIT_L
#undef PG8_BAR
#undef PG8_SCHED
}
}

typedef pg8::bf16_t bf16_t;
typedef pg8::bf16x8 bf16x8;
typedef pg8::f32x4 f32x4;
typedef pg8::u32x4 u32x4;
typedef short s16x4 __attribute__((ext_vector_type(4)));
typedef float f32x16 __attribute__((ext_vector_type(16)));
typedef unsigned u32x2 __attribute__((ext_vector_type(2)));
#define LAS __attribute__((address_space(3)))
typedef LAS unsigned char lds_u8;

constexpr int SEQ = 4096, NBATCH = 2, MTOK = 8192, DM = 4096, NIN = 13632, NINP = 13824, MIXW = 4608;
constexpr int C_ACQ = 0, C_ACKV = 768, C_KPE = 1280, C_BQ = 1344, C_BK = 2880, C_BV = 4416, C_CQ = 5952, C_CK = 6976, C_CV = 7232,
              C_DQ = 7488, C_DK = 8512, C_DV = 8768, C_GATE = 9024;
constexpr int MX_A = 0, MX_B = 1024, MX_C = 2560, MX_D = 3584;
constexpr float EPS = 1e-6f;
constexpr float LOG2E = 1.4426950408889634f, LN2 = 0.6931471805599453f;

constexpr size_t AL(size_t x) { return (x + 255) / 256 * 256; }
constexpr size_t WS_WIN   = 0;
constexpr size_t WS_WOUT  = WS_WIN   + AL((size_t)2 * NINP * DM * 2);
constexpr size_t WS_WUQ   = WS_WOUT  + AL((size_t)2 * DM * MIXW * 2);
constexpr size_t WS_WUKV  = WS_WUQ   + AL((size_t)2 * 1536 * 768 * 2);
constexpr size_t WS_H     = WS_WUKV  + AL((size_t)2 * 2048 * 512 * 2);
constexpr size_t WS_PROJ  = WS_H     + AL((size_t)MTOK * DM * 2);
constexpr size_t WS_X1    = WS_PROJ  + AL((size_t)MTOK * NINP * 2);
constexpr size_t WS_QAN   = WS_X1    + AL((size_t)MTOK * DM * 4);
constexpr size_t WS_KVAN  = WS_QAN   + AL((size_t)MTOK * 768 * 2);
constexpr size_t WS_KPE   = WS_KVAN  + AL((size_t)MTOK * 512 * 2);
constexpr size_t WS_QRAW  = WS_KPE   + AL((size_t)MTOK * 64 * 2);
constexpr size_t WS_KVRAW = WS_QRAW  + AL((size_t)MTOK * 1536 * 2);
constexpr size_t WS_QC    = WS_KVRAW + AL((size_t)MTOK * 2048 * 2);
constexpr size_t WS_KC    = WS_QC    + AL((size_t)MTOK * 1024 * 2);
constexpr size_t WS_MIXED = WS_KC    + AL((size_t)MTOK * 256 * 2);
constexpr size_t WS_LSE   = WS_MIXED + AL((size_t)MTOK * MIXW * 2);
constexpr size_t WS_CS    = WS_LSE   + AL((size_t)3 * MTOK * 4 * 4);
constexpr size_t WS_DELTA = WS_CS    + AL((size_t)SEQ * 32 * 8);
constexpr size_t WS_DKV   = WS_DELTA + AL((size_t)2 * MTOK * DM * 2);
constexpr size_t WS_BAR   = WS_DKV   + AL((size_t)MTOK * 512 * 2);
constexpr size_t WS_END   = WS_BAR   + AL((size_t)3456 * 4);

constexpr int LDS_BYTES = 141312;

#ifndef REP_GEMM
#define REP_GEMM 1
#endif
#ifndef REP_OUT
#define REP_OUT 1
#endif
#ifndef REP_UP
#define REP_UP 1
#endif
#ifndef REP_SYNC
#define REP_SYNC 0
#endif
#ifndef REP_BAND
#define REP_BAND 1
#endif
#ifndef REP_A
#define REP_A 1
#endif
#ifndef REP_C
#define REP_C 1
#endif
#ifndef HIDE_TAIL
#define HIDE_TAIL 0
#endif
#ifndef CVT_P0_LAYERS
#define CVT_P0_LAYERS 2
#endif
#ifndef GEMM_ALIGN
#define GEMM_ALIGN true
#endif
#ifndef GEMM_SP2
#define GEMM_SP2 true
#endif
#ifndef REP_D
#define REP_D 1
#endif
#ifndef REP_B
#define REP_B 1
#endif
#ifndef REP_ATTN
#define REP_ATTN 1
#endif
#ifndef REP_CVT
#define REP_CVT 1
#endif
#ifndef REP_MISC
#define REP_MISC 1
#endif
struct Params {
    const float *x, *g_attn, *w_in, *g_qa, *g_kva, *w_uq, *w_ukv, *g_qn, *g_kn, *sinks, *w_out, *rel_bias, *g_final;
    float* out; unsigned char* ws; int ph_lo, ph_hi;
};

__device__ __forceinline__ bf16_t f2bf(float f) { unsigned u = __float_as_uint(f); u += 0x7FFFu + ((u >> 16) & 1u); return (bf16_t)(u >> 16); }
__device__ __forceinline__ float bf2f(bf16_t b) { return __uint_as_float(((unsigned)b) << 16); }
__device__ __forceinline__ float bflo(unsigned w) { return __uint_as_float(w << 16); }
__device__ __forceinline__ float bfhi(unsigned w) { return __uint_as_float(w & 0xffff0000u); }
__device__ __forceinline__ unsigned cvtpk(float lo, float hi) { unsigned r; asm volatile("v_cvt_pk_bf16_f32 %0, %1, %2" : "=v"(r) : "v"(lo), "v"(hi)); return r; }
__device__ __forceinline__ float wave_sum(float v) {
#pragma unroll
    for (int o = 32; o >= 1; o >>= 1) v += __shfl_xor(v, o);
    return v;
}
__device__ __forceinline__ int rel_bucket(int rel) {
    const int n = rel < 0 ? -rel : rel; int b;
    if (n < 8) b = n;
    else b = 8 + (n >= 15) + (n >= 27) + (n >= 50) + (n >= 91) + (n >= 166) + (n >= 305) + (n >= 559);
    return b + (rel > 0 ? 16 : 0);
}

constexpr int CVT_NQ = 4;
__device__ __forceinline__ void cvt_transpose(const float* __restrict__ src, bf16_t* __restrict__ dst, int K, int N, int Npad, lds_u8* lds, int wg, int nwg) {
    LAS float* tile = (LAS float*)lds;
    const int tid = pg8::opaque_tid(), tn4 = Npad / (64 * CVT_NQ), tk = K / 64;
    __syncthreads();
    for (int t = wg; t < tn4 * tk; t += nwg) {
        const int nt4 = t % tn4, kt = t / tn4;
        f32x4 v[CVT_NQ][2];
#pragma unroll
        for (int q = 0; q < CVT_NQ; ++q)
#pragma unroll
            for (int i = 0; i < 2; ++i) {
                const int row = (tid >> 4) + 32 * i, c4 = (tid & 15) * 4, n = (nt4 * CVT_NQ + q) * 64 + c4;
                v[q][i] = (f32x4){0.f, 0.f, 0.f, 0.f};
                if (n < N) v[q][i] = __builtin_nontemporal_load((const f32x4*)(src + (size_t)(kt * 64 + row) * N + n));
            }
#pragma unroll
        for (int q = 0; q < CVT_NQ; ++q)
#pragma unroll
            for (int i = 0; i < 2; ++i) {
                const int row = (tid >> 4) + 32 * i, c4 = (tid & 15) * 4;
                LAS float* tp = tile + q * (64 * 65) + row * 65 + c4;
                tp[0] = v[q][i][0]; tp[1] = v[q][i][1]; tp[2] = v[q][i][2]; tp[3] = v[q][i][3];
            }
        __syncthreads();
#pragma unroll
        for (int q = 0; q < CVT_NQ; ++q) {
            const int nl = tid >> 3, kc = (tid & 7) * 8;
            float f[8];
#pragma unroll
            for (int j = 0; j < 8; ++j) f[j] = tile[q * (64 * 65) + (kc + j) * 65 + nl];
            u32x4 w; w.x = cvtpk(f[0], f[1]); w.y = cvtpk(f[2], f[3]); w.z = cvtpk(f[4], f[5]); w.w = cvtpk(f[6], f[7]);
            *(u32x4*)(dst + (size_t)((nt4 * CVT_NQ + q) * 64 + nl) * K + kt * 64 + kc) = w;
        }
        __syncthreads();
    }
}

__device__ __forceinline__ void build_cs(float2* cs, int wg, int nwg) {
    for (int idx = wg * 512 + pg8::opaque_tid(); idx < SEQ * 32; idx += nwg * 512) {
        const int pos = idx >> 5, i = idx & 31;
        const float inv = exp2f(-(float)i * (13.287712379549449f / 32.0f));
        const float ang = (float)pos * inv;
        const float k = rintf(ang * 0.15915494309189535f);
        float r = fmaf(-k, 6.2831854820251465f, ang); r = fmaf(-k, -1.7484555e-7f, r);
        cs[idx] = make_float2(__cosf(r), __sinf(r));
    }
}

template <int NDELTA, bool TO_BF16>
__device__ __forceinline__ void rmsnorm_rows(const float* __restrict__ x, const bf16_t* __restrict__ delta0, const bf16_t* __restrict__ delta1, const float* __restrict__ g,
                                             bf16_t* __restrict__ hout, float* __restrict__ fout, int wg, int nwg) {
    const int tid = pg8::opaque_tid(), wid = tid >> 6, lane = tid & 63;
    f32x4 gk[16];
#pragma unroll
    for (int k = 0; k < 16; ++k) gk[k] = *(const f32x4*)(g + k * 256 + lane * 4);
    for (int row = wg * 8 + wid; row < MTOK; row += nwg * 8) {
        const float* xr = x + (size_t)row * DM + lane * 4;
        f32x4 v[16];
#pragma unroll
        for (int k = 0; k < 16; ++k) v[k] = __builtin_nontemporal_load((const f32x4*)(xr + k * 256));
        if (NDELTA >= 1) {
            u32x2 d[16];
#pragma unroll
            for (int k = 0; k < 16; ++k) d[k] = __builtin_nontemporal_load((const u32x2*)(delta0 + (size_t)row * DM + k * 256 + lane * 4));
#pragma unroll
            for (int k = 0; k < 16; ++k) { v[k][0] += bflo(d[k].x); v[k][1] += bfhi(d[k].x); v[k][2] += bflo(d[k].y); v[k][3] += bfhi(d[k].y); }
        }
        if (NDELTA >= 2) {
            u32x2 d[16];
#pragma unroll
            for (int k = 0; k < 16; ++k) d[k] = __builtin_nontemporal_load((const u32x2*)(delta1 + (size_t)row * DM + k * 256 + lane * 4));
#pragma unroll
            for (int k = 0; k < 16; ++k) { v[k][0] += bflo(d[k].x); v[k][1] += bfhi(d[k].x); v[k][2] += bflo(d[k].y); v[k][3] += bfhi(d[k].y); }
        }
        float ss = 0.f;
#pragma unroll
        for (int k = 0; k < 16; ++k) ss += v[k][0] * v[k][0] + v[k][1] * v[k][1] + v[k][2] * v[k][2] + v[k][3] * v[k][3];
        ss = wave_sum(ss);
        const float rstd = rsqrtf(ss * (1.0f / DM) + EPS);
#pragma unroll
        for (int k = 0; k < 16; ++k) {
            const f32x4 y = v[k] * rstd * gk[k];
            if (TO_BF16) { u32x2 w; w.x = cvtpk(y[0], y[1]); w.y = cvtpk(y[2], y[3]); *(u32x2*)(hout + (size_t)row * DM + k * 256 + lane * 4) = w; }
            else __builtin_nontemporal_store(y, (f32x4*)(fout + (size_t)row * DM + k * 256 + lane * 4));
        }
    }
}

__device__ __forceinline__ void prep_tokens(const bf16_t* __restrict__ proj, const float* __restrict__ g_qa, const float* __restrict__ g_kva,
                                            const float* __restrict__ g_qn, const float* __restrict__ g_kn, const float2* __restrict__ cs,
                                            bf16_t* __restrict__ qan, bf16_t* __restrict__ kvan, bf16_t* __restrict__ kpe, bf16_t* __restrict__ qc, bf16_t* __restrict__ kc, bf16_t* __restrict__ dkv, int wg, int nwg) {
    const int tid = pg8::opaque_tid(), wid = tid >> 6, lane = tid & 63, hf = lane >> 5, i = lane & 31;
    for (int t = wg * 8 + wid; t < MTOK; t += nwg * 8) {
        const bf16_t* pr = proj + (size_t)t * NINP;
        const int pos = t & (SEQ - 1);
        u32x2 wq[3], wk[2];
#pragma unroll
        for (int k = 0; k < 3; ++k) wq[k] = *(const u32x2*)(pr + C_ACQ + k * 256 + lane * 4);
#pragma unroll
        for (int k = 0; k < 2; ++k) wk[k] = *(const u32x2*)(pr + C_ACKV + k * 256 + lane * 4);
        bf16_t hv[5][4];
#pragma unroll
        for (int s = 0; s < 5; ++s)
#pragma unroll
            for (int q = 0; q < 4; ++q) hv[s][q] = pr[C_CQ + (2 * s + hf) * 128 + q * 32 + i];
        const bf16_t kp1 = pr[C_KPE + i], kp2 = pr[C_KPE + 32 + i];
        const float2 ct = cs[pos * 32 + i], crow_ = cs[(pos >> 6) * 32 + i], ccol = cs[(pos & 63) * 32 + i];
        {
            float v[12]; float ss = 0.f;
#pragma unroll
            for (int k = 0; k < 3; ++k) { v[4 * k] = bflo(wq[k].x); v[4 * k + 1] = bfhi(wq[k].x); v[4 * k + 2] = bflo(wq[k].y); v[4 * k + 3] = bfhi(wq[k].y); }
#pragma unroll
            for (int j = 0; j < 12; ++j) ss += v[j] * v[j];
            ss = wave_sum(ss);
            const float rstd = rsqrtf(ss * (1.0f / 768.0f) + EPS);
#pragma unroll
            for (int k = 0; k < 3; ++k) { const f32x4 gg = *(const f32x4*)(g_qa + k * 256 + lane * 4);
                u32x2 w; w.x = cvtpk(v[4 * k] * rstd * gg[0], v[4 * k + 1] * rstd * gg[1]); w.y = cvtpk(v[4 * k + 2] * rstd * gg[2], v[4 * k + 3] * rstd * gg[3]);
                *(u32x2*)(qan + (size_t)t * 768 + k * 256 + lane * 4) = w; }
        }
        {
            float v[8]; float ss = 0.f;
#pragma unroll
            for (int k = 0; k < 2; ++k) { v[4 * k] = bflo(wk[k].x); v[4 * k + 1] = bfhi(wk[k].x); v[4 * k + 2] = bflo(wk[k].y); v[4 * k + 3] = bfhi(wk[k].y); }
#pragma unroll
            for (int j = 0; j < 8; ++j) ss += v[j] * v[j];
            ss = wave_sum(ss);
            const float rstd = rsqrtf(ss * (1.0f / 512.0f) + EPS);
#pragma unroll
            for (int k = 0; k < 2; ++k) { const f32x4 gg = *(const f32x4*)(g_kva + k * 256 + lane * 4);
                u32x2 w; w.x = cvtpk(v[4 * k] * rstd * gg[0], v[4 * k + 1] * rstd * gg[1]); w.y = cvtpk(v[4 * k + 2] * rstd * gg[2], v[4 * k + 3] * rstd * gg[3]);
                *(u32x2*)(kvan + (size_t)t * 512 + k * 256 + lane * 4) = w; }
        }
        if (hf == 0) {
            const float x1 = bf2f(kp1), x2 = bf2f(kp2);
            kpe[(size_t)t * 64 + i] = f2bf(x1 * ct.x - x2 * ct.y);
            kpe[(size_t)t * 64 + 32 + i] = f2bf(x2 * ct.x + x1 * ct.y);
        }
#pragma unroll
        for (int s = 0; s < 5; ++s) {
            const int head = 2 * s + hf;
            const float* gg = (head < 8) ? g_qn : g_kn;
            float a0 = bf2f(hv[s][0]), a1 = bf2f(hv[s][1]), a2 = bf2f(hv[s][2]), a3 = bf2f(hv[s][3]);
            float ss = a0 * a0 + a1 * a1 + a2 * a2 + a3 * a3;
#pragma unroll
            for (int o = 16; o >= 1; o >>= 1) ss += __shfl_xor(ss, o);
            const float rstd = rsqrtf(ss * (1.0f / 128.0f) + EPS);
            a0 *= rstd * gg[i]; a1 *= rstd * gg[32 + i]; a2 *= rstd * gg[64 + i]; a3 *= rstd * gg[96 + i];
            bf16_t* dst = (head < 8) ? (qc + (size_t)t * 1024 + head * 128) : (kc + (size_t)t * 256 + (head - 8) * 128);
            dst[i] = f2bf(a0 * crow_.x - a1 * crow_.y); dst[32 + i] = f2bf(a1 * crow_.x + a0 * crow_.y);
            dst[64 + i] = f2bf(a2 * ccol.x - a3 * ccol.y); dst[96 + i] = f2bf(a3 * ccol.x + a2 * ccol.y);
        }
    }
}

__device__ __forceinline__ void fixup_b(bf16_t* mixed, const float* __restrict__ lse, int wg, int nwg) {
    const int tid = pg8::opaque_tid(), wid = tid >> 6, lane = tid & 63, hh = lane >> 4;
    for (int t = wg * 8 + wid; t < MTOK; t += nwg * 8) {
        const float l0 = lse[((size_t)0 * MTOK + t) * 4 + hh], l1 = lse[((size_t)1 * MTOK + t) * 4 + hh], l2 = lse[((size_t)2 * MTOK + t) * 4 + hh];
        const float mx = fmaxf(l0, fmaxf(l1, l2));
        const float e0 = __expf(l0 - mx), e1 = __expf(l1 - mx), e2 = __expf(l2 - mx), inv = 1.0f / (e0 + e1 + e2);
        const float al[3] = {e0 * inv, e1 * inv, e2 * inv};
        u32x4 wv[3];
#pragma unroll
        for (int k = 0; k < 3; ++k) wv[k] = *(const u32x4*)(mixed + (size_t)t * MIXW + MX_B + k * 512 + lane * 8);
#pragma unroll
        for (int k = 0; k < 3; ++k) {
            u32x4 w = wv[k];
            const float a = al[k];
            w.x = cvtpk(bflo(w.x) * a, bfhi(w.x) * a); w.y = cvtpk(bflo(w.y) * a, bfhi(w.y) * a);
            w.z = cvtpk(bflo(w.z) * a, bfhi(w.z) * a); w.w = cvtpk(bflo(w.w) * a, bfhi(w.w) * a);
            *(u32x4*)(mixed + (size_t)t * MIXW + MX_B + k * 512 + lane * 8) = w;
        }
    }
}

__device__ __forceinline__ int crow(int r, int hi) { return (r & 3) + 8 * (r >> 2) + 4 * hi; }
#define KSWZ(row, colB) ((row) * 256 + ((colB) ^ (((row) & 7) << 4)))
#define PSWZ(row, colB) ((row) * 128 + ((colB) ^ (((row) & 7) << 4)))
__device__ __forceinline__ int v_st(int k, int c) { const int kk = (k & ~0xC) | ((k & 4) << 1) | ((k & 8) >> 1); return ((kk >> 3) * 4 + (c >> 5)) * 512 + ((kk & 7) * 32 + (c & 31)) * 2; }
__device__ __forceinline__ int v_rd_base(int lane) { return ((lane & 3) << 3) | (((lane >> 2) & 3) << 6) | (((lane >> 4) & 1) << 5) | (((lane >> 5) & 1) << 8); }
constexpr int v_rd_off(int d0, int ks, int half) { return d0 * 512 + ks * 4096 + half * 2048; }
template <int OFF> __device__ __forceinline__ s16x4 tr_read(int vb) {
    s16x4 r; asm volatile("ds_read_b64_tr_b16 %0, %1 offset:%2" : "=&v"(r) : "v"(vb), "i"(OFF) : "memory"); return r;
}
template <int D0> __device__ __forceinline__ void pv_one(f32x16& od, int vb, bf16x8 pa0, bf16x8 pa1, bf16x8 pa2, bf16x8 pa3) {
    const s16x4 l0 = tr_read<v_rd_off(D0, 0, 0)>(vb), h0 = tr_read<v_rd_off(D0, 0, 1)>(vb), l1 = tr_read<v_rd_off(D0, 1, 0)>(vb), h1 = tr_read<v_rd_off(D0, 1, 1)>(vb);
    const s16x4 l2 = tr_read<v_rd_off(D0, 2, 0)>(vb), h2 = tr_read<v_rd_off(D0, 2, 1)>(vb), l3 = tr_read<v_rd_off(D0, 3, 0)>(vb), h3 = tr_read<v_rd_off(D0, 3, 1)>(vb);
    asm volatile("s_waitcnt lgkmcnt(0)" ::: "memory"); __builtin_amdgcn_sched_barrier(0);
#define PK(L, H) (bf16x8){L[0], L[1], L[2], L[3], H[0], H[1], H[2], H[3]}
    od = __builtin_amdgcn_mfma_f32_32x32x16_bf16(pa0, PK(l0, h0), od, 0, 0, 0);
    od = __builtin_amdgcn_mfma_f32_32x32x16_bf16(pa1, PK(l1, h1), od, 0, 0, 0);
    od = __builtin_amdgcn_mfma_f32_32x32x16_bf16(pa2, PK(l2, h2), od, 0, 0, 0);
    od = __builtin_amdgcn_mfma_f32_32x32x16_bf16(pa3, PK(l3, h3), od, 0, 0, 0);
#undef PK
}

constexpr int AL_V = 0, AL_K = 16384, AL_KP = 32768, AL_WS = 40960, AL_LUT = 43008;

struct AttnArgs {
    const bf16_t* Q; long ldq;
    const bf16_t* K; long ldk;
    const bf16_t* K2; long ldk2;
    const bf16_t* V; long ldv;
    const bf16_t* G; long ldg;
    bf16_t* O; long ldo;
    float* lse; long ldl;
    const float2* cs;
    int i0, L, side, dil;
    const float* bias; int bcol;
    float C;
    float sink2;
};

template <int DQK, bool BAND, bool SINK, bool WLSE, bool ROPEQ>
__device__ __forceinline__ void attn_unit(lds_u8* lds, const AttnArgs& a) {
    constexpr int ND0 = DQK / 16;
    const int tid = pg8::opaque_tid(), wid = tid >> 6, lane = tid & 63, r32 = lane & 31, hi = lane >> 5;
    lds_u8* Vl = lds + AL_V; lds_u8* Kl = lds + AL_K; lds_u8* Kp = lds + AL_KP;
    LAS float* wsf = (LAS float*)(lds + AL_WS) + wid * 64; LAS float* li_l = wsf; LAS float* al_l = wsf + 32;
    LAS float* lut = (LAS float*)(lds + AL_LUT);
    __syncthreads();
    if (BAND) {
        if (tid <= 2 * a.side) { const int rel = tid - a.side; lut[tid] = a.bias[rel_bucket(rel * a.dil) * 20 + a.bcol] * LOG2E; }
    }
    const int qi = a.i0 + wid * 32 + r32;
    bf16x8 qr[ND0];
    {
        const bf16_t* Qw = a.Q + (long)qi * a.ldq + hi * 8;
#pragma unroll
        for (int d0 = 0; d0 < ND0; ++d0) qr[d0] = *(const bf16x8*)(Qw + d0 * 16);
    }
    if constexpr (ROPEQ) {
#pragma unroll
        for (int dd = 0; dd < 2; ++dd) {
            bf16x8 x1 = qr[8 + dd], x2 = qr[10 + dd];
#pragma unroll
            for (int j = 0; j < 8; ++j) {
                const float2 c = a.cs[qi * 32 + dd * 16 + hi * 8 + j];
                const float f1 = bf2f((bf16_t)x1[j]), f2 = bf2f((bf16_t)x2[j]);
                x1[j] = (short)f2bf(f1 * c.x - f2 * c.y); x2[j] = (short)f2bf(f2 * c.x + f1 * c.y);
            }
            qr[8 + dd] = x1; qr[10 + dd] = x2;
        }
    }
    int t_lo = 0, t_hi = a.L / 64, lo_w = 0, hi_w = 1 << 30;
    if (BAND) {
        t_lo = (a.i0 - a.side) / 64; if (t_lo < 0) t_lo = 0;
        int th = (a.i0 + 256 + a.side) / 64; if (th < t_hi) t_hi = th;
        const int w0 = a.i0 + wid * 32;
        lo_w = (w0 - a.side) >> 6; hi_w = (w0 + 31 + a.side) >> 6;
    }
    const int sr = tid >> 4, sc = (tid & 15) * 8;
    const int vst0 = v_st(sr, sc), vst1 = v_st(32 + sr, sc), kst0 = KSWZ(sr, sc * 2), kst1 = KSWZ(32 + sr, sc * 2);
    const int pr_ = tid >> 3, pc = (tid & 7) * 8, pst = PSWZ(pr_, pc * 2);
    const int vb0 = (int)(unsigned)(size_t)Vl + v_rd_base(lane);
    bf16x8 kA, kB, vA, vB, kP;
#define ALOAD(T) do { const long j0 = (long)(T) * 64; \
        kA = *(const bf16x8*)(a.K + (j0 + sr) * a.ldk + sc); kB = *(const bf16x8*)(a.K + (j0 + 32 + sr) * a.ldk + sc); \
        vA = *(const bf16x8*)(a.V + (j0 + sr) * a.ldv + sc); vB = *(const bf16x8*)(a.V + (j0 + 32 + sr) * a.ldv + sc); \
        if constexpr (DQK == 192) kP = *(const bf16x8*)(a.K2 + (j0 + pr_) * a.ldk2 + pc); } while (0)
    float m_reg = -1e29f, l_reg = 0.f;
    f32x16 o[4];
#pragma unroll
    for (int d = 0; d < 4; ++d)
#pragma unroll
        for (int r = 0; r < 16; ++r) o[d][r] = 0.f;
    ALOAD(t_lo);
    for (int T = t_lo; T < t_hi; ++T) {
        __syncthreads();
        *(LAS bf16x8*)(Kl + kst0) = kA; *(LAS bf16x8*)(Kl + kst1) = kB;
        *(LAS bf16x8*)(Vl + vst0) = vA; *(LAS bf16x8*)(Vl + vst1) = vB;
        if constexpr (DQK == 192) *(LAS bf16x8*)(Kp + pst) = kP;
        if (T + 1 < t_hi) ALOAD(T + 1);
        __syncthreads();
        if (T >= lo_w && T <= hi_w) {
            f32x16 p0, p1;
#pragma unroll
            for (int r = 0; r < 16; ++r) { p0[r] = 0.f; p1[r] = 0.f; }
#pragma unroll
            for (int d0 = 0; d0 < 8; ++d0) { const int cb = (d0 * 16 + hi * 8) * 2;
                const bf16x8 b0 = *(const LAS bf16x8*)(Kl + KSWZ(r32, cb)), b1 = *(const LAS bf16x8*)(Kl + KSWZ(32 + r32, cb));
                p0 = __builtin_amdgcn_mfma_f32_32x32x16_bf16(b0, qr[d0], p0, 0, 0, 0);
                p1 = __builtin_amdgcn_mfma_f32_32x32x16_bf16(b1, qr[d0], p1, 0, 0, 0); }
            if constexpr (DQK == 192) {
#pragma unroll
                for (int d0 = 0; d0 < 4; ++d0) { const int cb = (d0 * 16 + hi * 8) * 2;
                    const bf16x8 b0 = *(const LAS bf16x8*)(Kp + PSWZ(r32, cb)), b1 = *(const LAS bf16x8*)(Kp + PSWZ(32 + r32, cb));
                    p0 = __builtin_amdgcn_mfma_f32_32x32x16_bf16(b0, qr[8 + d0], p0, 0, 0, 0);
                    p1 = __builtin_amdgcn_mfma_f32_32x32x16_bf16(b1, qr[8 + d0], p1, 0, 0, 0); }
            }
            if (BAND) {
                const int base = T * 64 - qi + a.side;
#pragma unroll
                for (int r = 0; r < 16; ++r) {
                    const int i0_ = base + crow(r, hi), i1_ = i0_ + 32;
                    const bool ok0 = (unsigned)i0_ <= (unsigned)(2 * a.side), ok1 = (unsigned)i1_ <= (unsigned)(2 * a.side);
                    const float b0 = lut[ok0 ? i0_ : 0], b1 = lut[ok1 ? i1_ : 0];
                    p0[r] = ok0 ? fmaf(p0[r], a.C, b0) : -1e30f; p1[r] = ok1 ? fmaf(p1[r], a.C, b1) : -1e30f;
                }
            } else {
#pragma unroll
                for (int r = 0; r < 16; ++r) { p0[r] *= a.C; p1[r] *= a.C; }
            }
            float pmax = p0[0];
#pragma unroll
            for (int r = 1; r < 16; ++r) pmax = fmaxf(pmax, p0[r]);
#pragma unroll
            for (int r = 0; r < 16; ++r) pmax = fmaxf(pmax, p1[r]);
            { auto rr = __builtin_amdgcn_permlane32_swap(__float_as_uint(pmax), __float_as_uint(pmax), false, false);
              pmax = fmaxf(__uint_as_float(rr[0]), __uint_as_float(rr[1])); }
            const float mn = fmaxf(m_reg, pmax);
            const float alpha = __builtin_amdgcn_exp2f(m_reg - mn);
            m_reg = mn;
            float ps = 0.f;
#pragma unroll
            for (int r = 0; r < 16; ++r) { p0[r] = __builtin_amdgcn_exp2f(p0[r] - mn); p1[r] = __builtin_amdgcn_exp2f(p1[r] - mn); ps += p0[r] + p1[r]; }
            { auto rr = __builtin_amdgcn_permlane32_swap(__float_as_uint(ps), __float_as_uint(ps), false, false);
              ps = __uint_as_float(rr[0]) + __uint_as_float(rr[1]); }
            l_reg = l_reg * alpha + ps;
            if (__any(alpha < 1.f)) {
                if (hi == 0) al_l[r32] = alpha;
                asm volatile("s_waitcnt lgkmcnt(0)" ::: "memory");
#pragma unroll
                for (int r = 0; r < 16; ++r) { const float al = al_l[crow(r, hi)];
#pragma unroll
                    for (int d = 0; d < 4; ++d) o[d][r] *= al; }
            }
            bf16x8 pa0, pa1, pa2, pa3;
#define PK4(P, BASE, OUT) do { unsigned a0 = cvtpk(P[BASE + 0], P[BASE + 1]), a1 = cvtpk(P[BASE + 2], P[BASE + 3]);   \
    unsigned b0 = cvtpk(P[BASE + 4], P[BASE + 5]), b1 = cvtpk(P[BASE + 6], P[BASE + 7]);                              \
    auto r0 = __builtin_amdgcn_permlane32_swap(a0, b0, false, false); auto r1 = __builtin_amdgcn_permlane32_swap(a1, b1, false, false); \
    u32x4 w = {r0[0], r1[0], r0[1], r1[1]}; OUT = *reinterpret_cast<bf16x8*>(&w); } while (0)
            PK4(p0, 0, pa0); PK4(p0, 8, pa1); PK4(p1, 0, pa2); PK4(p1, 8, pa3);
#undef PK4
            pv_one<0>(o[0], vb0, pa0, pa1, pa2, pa3); pv_one<1>(o[1], vb0, pa0, pa1, pa2, pa3);
            pv_one<2>(o[2], vb0, pa0, pa1, pa2, pa3); pv_one<3>(o[3], vb0, pa0, pa1, pa2, pa3);
        }
    }
#undef ALOAD
    if (SINK) l_reg += __builtin_amdgcn_exp2f(a.sink2 - m_reg);
    if (hi == 0) li_l[r32] = l_reg;
    if (WLSE) { if (hi == 0) a.lse[(long)qi * a.ldl] = (m_reg + __builtin_amdgcn_logf(l_reg)) * LN2; }
    asm volatile("s_waitcnt lgkmcnt(0)" ::: "memory");
    bf16_t gv[16][4];
#pragma unroll
    for (int r = 0; r < 16; ++r) {
        const bf16_t* gp = a.G + (long)(a.i0 + wid * 32 + crow(r, hi)) * a.ldg + r32;
#pragma unroll
        for (int d0 = 0; d0 < 4; ++d0) gv[r][d0] = gp[d0 * 32];
    }
#pragma unroll
    for (int r = 0; r < 16; ++r) {
        const int row = crow(r, hi);
        const float rl = __builtin_amdgcn_rcpf(li_l[row]);
        const long i = a.i0 + wid * 32 + row;
        bf16_t* op = a.O + i * a.ldo + r32;
#pragma unroll
        for (int d0 = 0; d0 < 4; ++d0) {
            const float g = bf2f(gv[r][d0]);
            const float sg = g * __builtin_amdgcn_rcpf(1.0f + __builtin_amdgcn_exp2f(-LOG2E * g));
            op[d0 * 32] = (bf16_t)cvtpk(o[d0][r] * rl * sg, 0.f);
        }
    }
}


constexpr int DL_V = 0, DL_K = 32768, DL_P = 65536, DL_WS = 81920;
template <int DQK>
__device__ __forceinline__ void d_qkt(f32x16& p0, f32x16& p1, const lds_u8* Ks, const lds_u8* Ps, const bf16x8* qr, int r32, int hi) {
#pragma unroll
    for (int r = 0; r < 16; ++r) { p0[r] = 0.f; p1[r] = 0.f; }
#pragma unroll
    for (int d0 = 0; d0 < 8; ++d0) { const int cb = (d0 * 16 + hi * 8) * 2;
        const bf16x8 b0 = *(const LAS bf16x8*)(Ks + KSWZ(r32, cb)), b1 = *(const LAS bf16x8*)(Ks + KSWZ(32 + r32, cb));
        p0 = __builtin_amdgcn_mfma_f32_32x32x16_bf16(b0, qr[d0], p0, 0, 0, 0);
        p1 = __builtin_amdgcn_mfma_f32_32x32x16_bf16(b1, qr[d0], p1, 0, 0, 0); }
    if constexpr (DQK == 192) {
#pragma unroll
        for (int d0 = 0; d0 < 4; ++d0) { const int cb = (d0 * 16 + hi * 8) * 2;
            const bf16x8 b0 = *(const LAS bf16x8*)(Ps + PSWZ(r32, cb)), b1 = *(const LAS bf16x8*)(Ps + PSWZ(32 + r32, cb));
            p0 = __builtin_amdgcn_mfma_f32_32x32x16_bf16(b0, qr[8 + d0], p0, 0, 0, 0);
            p1 = __builtin_amdgcn_mfma_f32_32x32x16_bf16(b1, qr[8 + d0], p1, 0, 0, 0); }
    }
}
__device__ __forceinline__ void d_partialSM(f32x16& p0, f32x16& p1, float& m_reg, float& mn, float& alpha, const float C) {
    float pmax = p0[0];
#pragma unroll
    for (int r = 1; r < 16; ++r) pmax = fmaxf(pmax, p0[r]);
#pragma unroll
    for (int r = 0; r < 16; ++r) pmax = fmaxf(pmax, p1[r]);
    { auto rr = __builtin_amdgcn_permlane32_swap(__float_as_uint(pmax), __float_as_uint(pmax), false, false);
      pmax = fmaxf(__uint_as_float(rr[0]), __uint_as_float(rr[1])); }
    if (__builtin_expect(__all((pmax - m_reg) * C <= 8.0f * LOG2E), 1)) { mn = m_reg; alpha = 1.f; }
    else { mn = fmaxf(m_reg, pmax); alpha = __builtin_amdgcn_exp2f((m_reg - mn) * C); m_reg = mn; }
    const float mnC = -mn * C;
#pragma unroll
    for (int r = 0; r < 16; ++r) p0[r] = fmaf(p0[r], C, mnC);
#pragma unroll
    for (int r = 0; r < 16; ++r) p1[r] = fmaf(p1[r], C, mnC);
#pragma unroll
    for (int r = 0; r < 16; ++r) p0[r] = __builtin_amdgcn_exp2f(p0[r]);
}
__device__ __forceinline__ void d_finishSM(f32x16& p0, f32x16& p1, float alpha, float& l_reg, bf16x8& pa0, bf16x8& pa1, bf16x8& pa2, bf16x8& pa3) {
#pragma unroll
    for (int r = 0; r < 16; ++r) p1[r] = __builtin_amdgcn_exp2f(p1[r]);
    float ps = 0;
#pragma unroll
    for (int r = 0; r < 16; ++r) ps += p0[r];
#pragma unroll
    for (int r = 0; r < 16; ++r) ps += p1[r];
    { auto rr = __builtin_amdgcn_permlane32_swap(__float_as_uint(ps), __float_as_uint(ps), false, false);
      ps = __uint_as_float(rr[0]) + __uint_as_float(rr[1]); }
    l_reg = l_reg * alpha + ps;
#define PK4(P, BASE, OUT) do { unsigned a0 = cvtpk(P[BASE + 0], P[BASE + 1]), a1 = cvtpk(P[BASE + 2], P[BASE + 3]);   \
    unsigned b0 = cvtpk(P[BASE + 4], P[BASE + 5]), b1 = cvtpk(P[BASE + 6], P[BASE + 7]);                              \
    auto r0 = __builtin_amdgcn_permlane32_swap(a0, b0, false, false); auto r1 = __builtin_amdgcn_permlane32_swap(a1, b1, false, false); \
    u32x4 w = {r0[0], r1[0], r0[1], r1[1]}; OUT = *reinterpret_cast<bf16x8*>(&w); } while (0)
    PK4(p0, 0, pa0); PK4(p0, 8, pa1); PK4(p1, 0, pa2); PK4(p1, 8, pa3);
#undef PK4
}
__device__ __forceinline__ void d_pv(f32x16* o, int vb, bf16x8 pa0, bf16x8 pa1, bf16x8 pa2, bf16x8 pa3) {
    pv_one<0>(o[0], vb, pa0, pa1, pa2, pa3); pv_one<1>(o[1], vb, pa0, pa1, pa2, pa3); pv_one<2>(o[2], vb, pa0, pa1, pa2, pa3); pv_one<3>(o[3], vb, pa0, pa1, pa2, pa3);
}
#define SBAR() __builtin_amdgcn_sched_barrier(0)

template <int DQK, bool ROPEQ, int SDEPTH>
__device__ __forceinline__ void attn_dense_unit(lds_u8* lds, const AttnArgs& a) {
    constexpr int ND0 = DQK / 16;
    const int tid = pg8::opaque_tid(), wid = tid >> 6, lane = tid & 63, r32 = lane & 31, hi = lane >> 5;
    lds_u8* V_lds = lds + DL_V; lds_u8* K_lds = lds + DL_K; lds_u8* P_lds = lds + DL_P;
    LAS float* wsf = (LAS float*)(lds + DL_WS) + wid * 64; LAS float* li_l = wsf; LAS float* al_l = wsf + 32;
    const float C = a.C;
    __syncthreads();
    const int qi = a.i0 + wid * 32 + r32;
    float m_reg = -1e30f, l_reg = 0.f;
    f32x16 o[4];
#pragma unroll
    for (int d = 0; d < 4; ++d)
#pragma unroll
        for (int r = 0; r < 16; ++r) o[d][r] = 0.f;
    bf16x8 qr[ND0];
    {
        const bf16_t* Qw = a.Q + (long)qi * a.ldq + hi * 8;
#pragma unroll
        for (int d0 = 0; d0 < ND0; ++d0) qr[d0] = *(const bf16x8*)(Qw + d0 * 16);
    }
    if constexpr (ROPEQ) {
#pragma unroll
        for (int dd = 0; dd < 2; ++dd) {
            bf16x8 x1 = qr[8 + dd], x2 = qr[10 + dd];
#pragma unroll
            for (int j = 0; j < 8; ++j) {
                const float2 c = a.cs[qi * 32 + dd * 16 + hi * 8 + j];
                const float f1 = bf2f((bf16_t)x1[j]), f2 = bf2f((bf16_t)x2[j]);
                x1[j] = (short)f2bf(f1 * c.x - f2 * c.y); x2[j] = (short)f2bf(f2 * c.x + f1 * c.y);
            }
            qr[8 + dd] = x1; qr[10 + dd] = x2;
        }
    }
    const int sr = tid >> 4, sc = (tid & 15) * 8, vst0 = v_st(sr, sc), vst1 = v_st(32 + sr, sc), kst0 = KSWZ(sr, sc * 2), kst1 = KSWZ(32 + sr, sc * 2);
    const int pr_ = tid >> 3, pc = (tid & 7) * 8, pst = PSWZ(pr_, pc * 2);
    const int vb0 = (int)(unsigned)(size_t)V_lds + v_rd_base(lane);
    struct { bf16x8 vs0, vs1, ks0, ks1, kp; } sr_[SDEPTH];
#define SLOAD(i, k0) do { sr_[i].vs0 = *(const bf16x8*)(a.V + (long)((k0) + sr) * a.ldv + sc); sr_[i].vs1 = *(const bf16x8*)(a.V + (long)((k0) + 32 + sr) * a.ldv + sc); \
    sr_[i].ks0 = *(const bf16x8*)(a.K + (long)((k0) + sr) * a.ldk + sc); sr_[i].ks1 = *(const bf16x8*)(a.K + (long)((k0) + 32 + sr) * a.ldk + sc); \
    if constexpr (DQK == 192) sr_[i].kp = *(const bf16x8*)(a.K2 + (long)((k0) + pr_) * a.ldk2 + pc); } while (0)
#define SWRITE(b, i) do { *(LAS bf16x8*)(V_lds + (b) * 16384 + vst0) = sr_[i].vs0; *(LAS bf16x8*)(V_lds + (b) * 16384 + vst1) = sr_[i].vs1; \
    *(LAS bf16x8*)(K_lds + (b) * 16384 + kst0) = sr_[i].ks0; *(LAS bf16x8*)(K_lds + (b) * 16384 + kst1) = sr_[i].ks1; \
    if constexpr (DQK == 192) *(LAS bf16x8*)(P_lds + (b) * 8192 + pst) = sr_[i].kp; } while (0)
#define SWAIT() do { if constexpr (SDEPTH == 2) { if constexpr (DQK == 192) asm volatile("s_waitcnt vmcnt(5)" ::: "memory"); else asm volatile("s_waitcnt vmcnt(4)" ::: "memory"); } \
    else asm volatile("s_waitcnt vmcnt(0)" ::: "memory"); } while (0)
#define RESC(al) do { if (__any((al) < 1.f)) { if (hi == 0) al_l[r32] = (al); asm volatile("s_waitcnt lgkmcnt(0)" ::: "memory"); \
    _Pragma("unroll") for (int r = 0; r < 16; ++r) { const float s_ = al_l[crow(r, hi)]; _Pragma("unroll") for (int d = 0; d < 4; ++d) o[d][r] *= s_; } } } while (0)
    f32x16 pA0, pA1, pB0, pB1; float mnA, mnB, alA, alB; bf16x8 pa0, pa1, pa2, pa3; const int NT = a.L / 64;
    constexpr int SE = 0, SO = SDEPTH - 1;
    SLOAD(SE, 0); asm volatile("s_waitcnt vmcnt(0)" ::: "memory"); SWRITE(0, SE); __syncthreads();
    d_qkt<DQK>(pA0, pA1, K_lds, P_lds, qr, r32, hi); d_partialSM(pA0, pA1, m_reg, mnA, alA, C);
    SLOAD(SO, 64); if constexpr (SDEPTH == 2) { if (2 < NT) SLOAD(SE, 128); }
    SWAIT(); SWRITE(1, SO); __syncthreads();
    for (int j = 1; j + 1 < NT; j += 2) {
        SBAR(); d_qkt<DQK>(pB0, pB1, K_lds + 16384, P_lds + 8192, qr, r32, hi);
        d_finishSM(pA0, pA1, alA, l_reg, pa0, pa1, pa2, pa3); SBAR();
        SLOAD(SO, (j + SDEPTH) * 64); SBAR();
        d_pv(o, vb0, pa0, pa1, pa2, pa3); d_partialSM(pB0, pB1, m_reg, mnB, alB, C);
        __syncthreads(); SWAIT(); SWRITE(0, SE);
        RESC(alB); __syncthreads();
        SBAR(); d_qkt<DQK>(pA0, pA1, K_lds, P_lds, qr, r32, hi);
        d_finishSM(pB0, pB1, alB, l_reg, pa0, pa1, pa2, pa3); SBAR();
        if (SDEPTH == 1 || j + 3 < NT) SLOAD(SE, (j + 1 + SDEPTH) * 64); SBAR();
        d_pv(o, vb0 + 16384, pa0, pa1, pa2, pa3); d_partialSM(pA0, pA1, m_reg, mnA, alA, C);
        __syncthreads(); SWAIT(); SWRITE(1, SO);
        RESC(alA); __syncthreads();
    }
    SBAR(); d_qkt<DQK>(pB0, pB1, K_lds + 16384, P_lds + 8192, qr, r32, hi);
    d_finishSM(pA0, pA1, alA, l_reg, pa0, pa1, pa2, pa3); SBAR();
    d_pv(o, vb0, pa0, pa1, pa2, pa3); d_partialSM(pB0, pB1, m_reg, mnB, alB, C);
    __syncthreads(); RESC(alB);
    d_finishSM(pB0, pB1, alB, l_reg, pa0, pa1, pa2, pa3); SBAR();
    d_pv(o, vb0 + 16384, pa0, pa1, pa2, pa3);
#undef SLOAD
#undef SWRITE
#undef SWAIT
#undef RESC
    if (hi == 0) li_l[r32] = l_reg;
    asm volatile("s_waitcnt lgkmcnt(0)" ::: "memory");
    bf16_t gv[16][4];
#pragma unroll
    for (int r = 0; r < 16; ++r) {
        const bf16_t* gp = a.G + (long)(a.i0 + wid * 32 + crow(r, hi)) * a.ldg + r32;
#pragma unroll
        for (int d0 = 0; d0 < 4; ++d0) gv[r][d0] = gp[d0 * 32];
    }
#pragma unroll
    for (int r = 0; r < 16; ++r) {
        const int row = crow(r, hi);
        const float rl = __builtin_amdgcn_rcpf(li_l[row]);
        const long i = a.i0 + wid * 32 + row;
        bf16_t* op = a.O + i * a.ldo + r32;
#pragma unroll
        for (int d0 = 0; d0 < 4; ++d0) {
            const float g = bf2f(gv[r][d0]);
            const float sg = g * __builtin_amdgcn_rcpf(1.0f + __builtin_amdgcn_exp2f(-LOG2E * g));
            op[d0 * 32] = (bf16_t)cvtpk(o[d0][r] * rl * sg, 0.f);
        }
    }
}


constexpr int D3_V = 0, D3_K = 49152, D3_P = 98304, D3_WS = 122880;
template <int DQK, bool ROPEQ>
__device__ __forceinline__ void attn_dense_unit3(lds_u8* lds, const AttnArgs& a) {
    constexpr int ND0 = DQK / 16;
    const int tid = pg8::opaque_tid(), wid = tid >> 6, lane = tid & 63, r32 = lane & 31, hi = lane >> 5;
    lds_u8* V_lds = lds + D3_V; lds_u8* K_lds = lds + D3_K; lds_u8* P_lds = lds + D3_P;
    LAS float* wsf = (LAS float*)(lds + D3_WS) + wid * 64; LAS float* li_l = wsf; LAS float* al_l = wsf + 32;
    const float C = a.C;
    __syncthreads();
    const int qi = a.i0 + wid * 32 + r32;
    float m_reg = -1e30f, l_reg = 0.f;
    f32x16 o[4];
#pragma unroll
    for (int d = 0; d < 4; ++d)
#pragma unroll
        for (int r = 0; r < 16; ++r) o[d][r] = 0.f;
    bf16x8 qr[ND0];
    {
        const bf16_t* Qw = a.Q + (long)qi * a.ldq + hi * 8;
#pragma unroll
        for (int d0 = 0; d0 < ND0; ++d0) qr[d0] = *(const bf16x8*)(Qw + d0 * 16);
    }
    if constexpr (ROPEQ) {
#pragma unroll
        for (int dd = 0; dd < 2; ++dd) {
            bf16x8 x1 = qr[8 + dd], x2 = qr[10 + dd];
#pragma unroll
            for (int j = 0; j < 8; ++j) {
                const float2 c = a.cs[qi * 32 + dd * 16 + hi * 8 + j];
                const float f1 = bf2f((bf16_t)x1[j]), f2 = bf2f((bf16_t)x2[j]);
                x1[j] = (short)f2bf(f1 * c.x - f2 * c.y); x2[j] = (short)f2bf(f2 * c.x + f1 * c.y);
            }
            qr[8 + dd] = x1; qr[10 + dd] = x2;
        }
    }
    const int sr = tid >> 4, sc = (tid & 15) * 8, vst0 = v_st(sr, sc), vst1 = v_st(32 + sr, sc), kst0 = KSWZ(sr, sc * 2), kst1 = KSWZ(32 + sr, sc * 2);
    const int pr_ = tid >> 3, pc = (tid & 7) * 8, pst = PSWZ(pr_, pc * 2);
    const int vb0 = (int)(unsigned)(size_t)V_lds + v_rd_base(lane);
    bf16x8 s_vs0, s_vs1, s_ks0, s_ks1, s_kp;
#define SLOAD(k0) do { s_vs0 = *(const bf16x8*)(a.V + (long)((k0) + sr) * a.ldv + sc); s_vs1 = *(const bf16x8*)(a.V + (long)((k0) + 32 + sr) * a.ldv + sc); \
    s_ks0 = *(const bf16x8*)(a.K + (long)((k0) + sr) * a.ldk + sc); s_ks1 = *(const bf16x8*)(a.K + (long)((k0) + 32 + sr) * a.ldk + sc); \
    if constexpr (DQK == 192) s_kp = *(const bf16x8*)(a.K2 + (long)((k0) + pr_) * a.ldk2 + pc); } while (0)
#define SWRITE(b) do { *(LAS bf16x8*)(V_lds + (b) * 16384 + vst0) = s_vs0; *(LAS bf16x8*)(V_lds + (b) * 16384 + vst1) = s_vs1; \
    *(LAS bf16x8*)(K_lds + (b) * 16384 + kst0) = s_ks0; *(LAS bf16x8*)(K_lds + (b) * 16384 + kst1) = s_ks1; \
    if constexpr (DQK == 192) *(LAS bf16x8*)(P_lds + (b) * 8192 + pst) = s_kp; } while (0)
#define RESC(al) do { if (__any((al) < 1.f)) { if (hi == 0) al_l[r32] = (al); asm volatile("s_waitcnt lgkmcnt(0)" ::: "memory"); \
    _Pragma("unroll") for (int r = 0; r < 16; ++r) { const float s_ = al_l[crow(r, hi)]; _Pragma("unroll") for (int d = 0; d < 4; ++d) o[d][r] *= s_; } } } while (0)
#define ROT() do { bv = bq; bq = bw; bw = (bw == 2) ? 0 : bw + 1; } while (0)
    f32x16 pA0, pA1, pB0, pB1; float mnA, mnB, alA, alB; bf16x8 pa0, pa1, pa2, pa3; const int NT = a.L / 64;
    SLOAD(0); SWRITE(0); SLOAD(64); SWRITE(1); SLOAD(128); __syncthreads();
    d_qkt<DQK>(pA0, pA1, K_lds, P_lds, qr, r32, hi); d_partialSM(pA0, pA1, m_reg, mnA, alA, C);
    int bq = 1, bv = 0, bw = 2;
    for (int j = 1; j + 1 < NT; j += 2) {
        SBAR(); d_qkt<DQK>(pB0, pB1, K_lds + bq * 16384, P_lds + bq * 8192, qr, r32, hi);
        d_finishSM(pA0, pA1, alA, l_reg, pa0, pa1, pa2, pa3); SBAR();
        d_pv(o, vb0 + bv * 16384, pa0, pa1, pa2, pa3); d_partialSM(pB0, pB1, m_reg, mnB, alB, C);
        SWRITE(bw);
        if (j + 2 < NT) SLOAD((j + 2) * 64);
        RESC(alB); __syncthreads(); ROT();
        SBAR(); d_qkt<DQK>(pA0, pA1, K_lds + bq * 16384, P_lds + bq * 8192, qr, r32, hi);
        d_finishSM(pB0, pB1, alB, l_reg, pa0, pa1, pa2, pa3); SBAR();
        d_pv(o, vb0 + bv * 16384, pa0, pa1, pa2, pa3); d_partialSM(pA0, pA1, m_reg, mnA, alA, C);
        if (j + 2 < NT) SWRITE(bw);
        if (j + 3 < NT) SLOAD((j + 3) * 64);
        RESC(alA); __syncthreads(); ROT();
    }
    SBAR(); d_qkt<DQK>(pB0, pB1, K_lds + bq * 16384, P_lds + bq * 8192, qr, r32, hi);
    d_finishSM(pA0, pA1, alA, l_reg, pa0, pa1, pa2, pa3); SBAR();
    d_pv(o, vb0 + bv * 16384, pa0, pa1, pa2, pa3); d_partialSM(pB0, pB1, m_reg, mnB, alB, C);
    RESC(alB);
    d_finishSM(pB0, pB1, alB, l_reg, pa0, pa1, pa2, pa3); SBAR();
    d_pv(o, vb0 + bq * 16384, pa0, pa1, pa2, pa3);
#undef SLOAD
#undef SWRITE
#undef RESC
#undef ROT
    if (hi == 0) li_l[r32] = l_reg;
    asm volatile("s_waitcnt lgkmcnt(0)" ::: "memory");
    bf16_t gv[16][4];
#pragma unroll
    for (int r = 0; r < 16; ++r) {
        const bf16_t* gp = a.G + (long)(a.i0 + wid * 32 + crow(r, hi)) * a.ldg + r32;
#pragma unroll
        for (int d0 = 0; d0 < 4; ++d0) gv[r][d0] = gp[d0 * 32];
    }
#pragma unroll
    for (int r = 0; r < 16; ++r) {
        const int row = crow(r, hi);
        const float rl = __builtin_amdgcn_rcpf(li_l[row]);
        const long i = a.i0 + wid * 32 + row;
        bf16_t* op = a.O + i * a.ldo + r32;
#pragma unroll
        for (int d0 = 0; d0 < 4; ++d0) {
            const float g = bf2f(gv[r][d0]);
            const float sg = g * __builtin_amdgcn_rcpf(1.0f + __builtin_amdgcn_exp2f(-LOG2E * g));
            op[d0 * 32] = (bf16_t)cvtpk(o[d0][r] * rl * sg, 0.f);
        }
    }
}

constexpr int BL_WS = 131072, BL_LUT = 133120, BL_LUTSTRIDE = 260;
constexpr int BL_LUT2 = 65536, BL_LUT2MARGIN = 320, BL_LUT2STRIDE = 960;
struct BandArgs {
    const bf16_t* Q; long ldq;
    const bf16_t* K; const bf16_t* V; long ldk;
    const bf16_t* G; long ldg; bf16_t* O; long ldo;
    float* lse; long ldl;
    const float* bias; const float* sinks;
    int i0, L, side, dil, nt;
    float C;
};
template <int NH, bool SINK, bool WLSE, int PROBE = 0>
__device__ __forceinline__ void attn_band_unit(lds_u8* lds, const BandArgs& a) {
    constexpr int WPH = 8 / NH;
    const int tid = pg8::opaque_tid(), wid = tid >> 6, lane = tid & 63, r32 = lane & 31, hi = lane >> 5;
    const int hw = wid / WPH, rb = wid % WPH;
    LAS float* wsf = (LAS float*)(lds + BL_WS) + wid * 64; LAS float* li_l = wsf; LAS float* al_l = wsf + 32;
    LAS float* lut = (LAS float*)(lds + BL_LUT2) + hw * BL_LUT2STRIDE + BL_LUT2MARGIN;
    const int side = a.side, nlut = 2 * side + 1;
    __syncthreads();
    const int qi = a.i0 + rb * 32 + r32;
    bf16x8 qr[8];
    {
        const bf16_t* Qw = a.Q + hw * 128 + (long)qi * a.ldq + hi * 8;
#pragma unroll
        for (int d0 = 0; d0 < 8; ++d0) qr[d0] = *(const bf16x8*)(Qw + d0 * 16);
    }
    const int t_lo = (a.i0 >= side) ? 0 : (side - a.i0) / 64;
    int t_hi = (a.L - a.i0 + side) / 64; if (t_hi > a.nt) t_hi = a.nt;
    const int lo_w = rb >> 1, hi_w = (rb * 32 + 31 + 2 * side) >> 6;
    const int sr = tid >> 4, sc = (tid & 15) * 8;
    const int vst0 = v_st(sr, sc), vst1 = v_st(32 + sr, sc), kst0 = KSWZ(sr, sc * 2), kst1 = KSWZ(32 + sr, sc * 2);
    const int vbase = (int)(unsigned)(size_t)(lds + 16384) + v_rd_base(lane);
    constexpr int GT = 2;
    bf16x8 st[GT][4];
#define BLOAD(G0) do { _Pragma("unroll") for (int tt = 0; tt < GT; ++tt) { int T_ = (G0) + tt; if (T_ < t_lo) T_ = t_lo; if (T_ > t_hi - 1) T_ = t_hi - 1; \
            const long kb_ = (long)(a.i0 - side + 64 * T_); \
            st[tt][0] = *(const bf16x8*)(a.K + (kb_ + sr) * a.ldk + sc); st[tt][1] = *(const bf16x8*)(a.K + (kb_ + 32 + sr) * a.ldk + sc); \
            st[tt][2] = *(const bf16x8*)(a.V + (kb_ + sr) * a.ldk + sc); st[tt][3] = *(const bf16x8*)(a.V + (kb_ + 32 + sr) * a.ldk + sc); } } while (0)
    float m_reg = -1e29f, l_reg = 0.f;
    f32x16 o[4];
#pragma unroll
    for (int d = 0; d < 4; ++d)
#pragma unroll
        for (int r = 0; r < 16; ++r) o[d][r] = 0.f;
    const int g_lo = (t_lo / GT) * GT;
    BLOAD(g_lo);
    for (int idx = tid; idx < NH * nlut; idx += 512) { const int h = idx / nlut, e = idx - h * nlut;
        ((LAS float*)(lds + BL_LUT2))[h * BL_LUT2STRIDE + BL_LUT2MARGIN + e] = a.bias[rel_bucket((e - side) * a.dil) * 20 + h] * LOG2E; }
    for (int G0 = g_lo; G0 < t_hi; G0 += GT) {
        __syncthreads();
#pragma unroll
        for (int tt = 0; tt < GT; ++tt) {
            *(LAS bf16x8*)(lds + tt * 32768 + kst0) = st[tt][0]; *(LAS bf16x8*)(lds + tt * 32768 + kst1) = st[tt][1];
            *(LAS bf16x8*)(lds + tt * 32768 + 16384 + vst0) = st[tt][2]; *(LAS bf16x8*)(lds + tt * 32768 + 16384 + vst1) = st[tt][3];
        }
        if (G0 + GT < t_hi) BLOAD(G0 + GT);
        __syncthreads();
#pragma unroll 1
        for (int tt = 0; tt < GT; ++tt) {
            const int T = G0 + tt;
            if (T < t_lo || T >= t_hi || T < lo_w || T > hi_w) continue;
            if (PROBE >= 2) { l_reg += ((const LAS float*)(lds + tt * 32768))[tid]; continue; }
            const lds_u8* Kl = lds + tt * 32768; const int vb0 = vbase + tt * 32768;
            f32x16 p0, p1;
#pragma unroll
            for (int r = 0; r < 16; ++r) { p0[r] = 0.f; p1[r] = 0.f; }
#pragma unroll
            for (int d0 = 0; d0 < 8; ++d0) { const int cb = (d0 * 16 + hi * 8) * 2;
                const bf16x8 b0 = *(const LAS bf16x8*)(Kl + KSWZ(r32, cb)), b1 = *(const LAS bf16x8*)(Kl + KSWZ(32 + r32, cb));
                p0 = __builtin_amdgcn_mfma_f32_32x32x16_bf16(b0, qr[d0], p0, 0, 0, 0);
                p1 = __builtin_amdgcn_mfma_f32_32x32x16_bf16(b1, qr[d0], p1, 0, 0, 0); }
            const int base = a.i0 + 64 * T - qi;
            const LAS float* lrow = lut + base + 4 * hi;
            const int wlo = 64 * T - rb * 32 - 31, whi = 64 * T - rb * 32 + 63;
            if (wlo >= 0 && whi <= 2 * side) {
#pragma unroll
                for (int r = 0; r < 16; ++r) { const int c_ = (r & 3) + 8 * (r >> 2);
                    p0[r] = fmaf(p0[r], a.C, lrow[c_]); p1[r] = fmaf(p1[r], a.C, lrow[c_ + 32]); }
            } else {
                const int b0i = base + 4 * hi;
#pragma unroll
                for (int r = 0; r < 16; ++r) { const int c_ = (r & 3) + 8 * (r >> 2);
                    const bool ok0 = (unsigned)(b0i + c_) <= (unsigned)(2 * side), ok1 = (unsigned)(b0i + c_ + 32) <= (unsigned)(2 * side);
                    const float v0 = fmaf(p0[r], a.C, lrow[c_]), v1 = fmaf(p1[r], a.C, lrow[c_ + 32]);
                    p0[r] = ok0 ? v0 : -1e30f; p1[r] = ok1 ? v1 : -1e30f; }
            }
            float pmax = p0[0];
#pragma unroll
            for (int r = 1; r < 16; ++r) pmax = fmaxf(pmax, p0[r]);
#pragma unroll
            for (int r = 0; r < 16; ++r) pmax = fmaxf(pmax, p1[r]);
            { auto rr = __builtin_amdgcn_permlane32_swap(__float_as_uint(pmax), __float_as_uint(pmax), false, false);
              pmax = fmaxf(__uint_as_float(rr[0]), __uint_as_float(rr[1])); }
            const float mn = fmaxf(m_reg, pmax);
            const float alpha = __builtin_amdgcn_exp2f(m_reg - mn);
            m_reg = mn;
            float ps = 0.f;
#pragma unroll
            for (int r = 0; r < 16; ++r) { p0[r] = __builtin_amdgcn_exp2f(p0[r] - mn); p1[r] = __builtin_amdgcn_exp2f(p1[r] - mn); ps += p0[r] + p1[r]; }
            { auto rr = __builtin_amdgcn_permlane32_swap(__float_as_uint(ps), __float_as_uint(ps), false, false);
              ps = __uint_as_float(rr[0]) + __uint_as_float(rr[1]); }
            l_reg = l_reg * alpha + ps;
            if (__any(alpha < 1.f)) {
                if (hi == 0) al_l[r32] = alpha;
                asm volatile("s_waitcnt lgkmcnt(0)" ::: "memory");
#pragma unroll
                for (int r = 0; r < 16; ++r) { const float al = al_l[crow(r, hi)];
#pragma unroll
                    for (int d = 0; d < 4; ++d) o[d][r] *= al; }
            }
            bf16x8 pa0, pa1, pa2, pa3;
#define PK4(P, BASE, OUT) do { unsigned a0 = cvtpk(P[BASE + 0], P[BASE + 1]), a1 = cvtpk(P[BASE + 2], P[BASE + 3]);   \
    unsigned b0 = cvtpk(P[BASE + 4], P[BASE + 5]), b1 = cvtpk(P[BASE + 6], P[BASE + 7]);                              \
    auto r0 = __builtin_amdgcn_permlane32_swap(a0, b0, false, false); auto r1 = __builtin_amdgcn_permlane32_swap(a1, b1, false, false); \
    u32x4 w = {r0[0], r1[0], r0[1], r1[1]}; OUT = *reinterpret_cast<bf16x8*>(&w); } while (0)
            PK4(p0, 0, pa0); PK4(p0, 8, pa1); PK4(p1, 0, pa2); PK4(p1, 8, pa3);
#undef PK4
            pv_one<0>(o[0], vb0, pa0, pa1, pa2, pa3); pv_one<1>(o[1], vb0, pa0, pa1, pa2, pa3);
            pv_one<2>(o[2], vb0, pa0, pa1, pa2, pa3); pv_one<3>(o[3], vb0, pa0, pa1, pa2, pa3);
        }
    }
#undef BLOAD
    if (PROBE >= 1) { float acc_ = l_reg + m_reg; for (int d = 0; d < 4; ++d) for (int r = 0; r < 16; ++r) acc_ += o[d][r]; if (acc_ == 12345.678f) a.O[tid] = 0; return; }
    if (SINK) l_reg += __builtin_amdgcn_exp2f(a.sinks[hw] * LOG2E - m_reg);
    if (hi == 0) li_l[r32] = l_reg;
    if (WLSE) { if (hi == 0) a.lse[hw + (long)qi * a.ldl] = (m_reg + __builtin_amdgcn_logf(l_reg)) * LN2; }
    asm volatile("s_waitcnt lgkmcnt(0)" ::: "memory");
    bf16_t gv[16][4];
#pragma unroll
    for (int r = 0; r < 16; ++r) {
        const bf16_t* gp = a.G + hw * 128 + (long)(a.i0 + rb * 32 + crow(r, hi)) * a.ldg + r32;
#pragma unroll
        for (int d0 = 0; d0 < 4; ++d0) gv[r][d0] = gp[d0 * 32];
    }
#pragma unroll
    for (int r = 0; r < 16; ++r) {
        const int row = crow(r, hi);
        const float rl = __builtin_amdgcn_rcpf(li_l[row]);
        const long i = a.i0 + rb * 32 + row;
        bf16_t* op = a.O + hw * 128 + i * a.ldo + r32;
#pragma unroll
        for (int d0 = 0; d0 < 4; ++d0) {
            const float g = bf2f(gv[r][d0]);
            const float sg = g * __builtin_amdgcn_rcpf(1.0f + __builtin_amdgcn_exp2f(-LOG2E * g));
            op[d0 * 32] = (bf16_t)cvtpk(o[d0][r] * rl * sg, 0.f);
        }
    }
}

__device__ __forceinline__ void attn_phase(lds_u8* lds, const Params& p, int layer, int wg, int nwg) {
    unsigned char* ws = p.ws;
    const bf16_t* proj = (const bf16_t*)(ws + WS_PROJ);
    bf16_t* mixed = (bf16_t*)(ws + WS_MIXED);
    const float2* cs = (const float2*)(ws + WS_CS);
    constexpr int NA = 256, NC = 256, ND = 256, NBU = 384;
    for (int rep = 0; rep < REP_BAND; ++rep)
    for (int it = (rep == 0 ? wg : NA + NC + wg); it < NA + NC + ND + NBU; it += nwg) {
        AttnArgs a; a.lse = nullptr; a.ldl = 0; a.cs = cs; a.side = 0; a.dil = 1; a.bias = p.rel_bias; a.bcol = 0; a.sink2 = 0.f; a.K2 = nullptr; a.ldk2 = 0; a.L = SEQ;
        if (it < NA) {
            #ifdef LINEAR_MAP
            const int c = it, bh = c >> 4, qb = c & 15, b = bh >> 3, h = bh & 7;
#else
            const int c = it, xcd = c & 7, slot = c >> 3, bh = xcd * 2 + (slot >> 4), qb = slot & 15, b = bh >> 3, h = bh & 7;
#endif
            const size_t t0 = (size_t)b * SEQ;
            const bf16_t* qraw = (const bf16_t*)(ws + WS_QRAW); const bf16_t* kvraw = (const bf16_t*)(ws + WS_KVRAW); const bf16_t* kpe = (const bf16_t*)(ws + WS_KPE);
            a.Q = qraw + t0 * 1536 + h * 192; a.ldq = 1536;
            a.K = kvraw + t0 * 2048 + h * 256; a.ldk = 2048; a.K2 = kpe + t0 * 64; a.ldk2 = 64;
            a.V = kvraw + t0 * 2048 + h * 256 + 128; a.ldv = 2048;
            a.G = proj + t0 * NINP + C_GATE + MX_A + h * 128; a.ldg = NINP;
            a.O = mixed + t0 * MIXW + MX_A + h * 128; a.ldo = MIXW;
            a.i0 = qb * 256; a.C = 0.07216878364870322f * LOG2E;
#ifdef SIMPLE_DENSE
            attn_unit<192, false, false, false, true>(lds, a);
#else
            #ifndef DENSE3BUF
            for (int rep = 0; rep < REP_A; ++rep) attn_dense_unit<192, true, 1>(lds, a);
#else
            for (int rep = 0; rep < REP_A; ++rep) attn_dense_unit3<192, true>(lds, a);
#endif
#endif
        } else if (it < NA + NC) {
            #ifdef LINEAR_MAP
            const int c = it - NA, pair = c >> 4, qb = c & 15, b = pair >> 3, hq = pair & 7, hk = hq >> 2;
#else
            const int c = it - NA, xcd = c & 7, slot = c >> 3, pair = xcd * 2 + (slot >> 4), qb = slot & 15, b = pair >> 3, hq = pair & 7, hk = hq >> 2;
#endif
            const size_t t0 = (size_t)b * SEQ;
            const bf16_t* qc = (const bf16_t*)(ws + WS_QC); const bf16_t* kc = (const bf16_t*)(ws + WS_KC);
            a.Q = qc + t0 * 1024 + hq * 128; a.ldq = 1024;
            a.K = kc + t0 * 256 + hk * 128; a.ldk = 256;
            a.V = proj + t0 * NINP + C_CV + hk * 128; a.ldv = NINP;
            a.G = proj + t0 * NINP + C_GATE + MX_C + hq * 128; a.ldg = NINP;
            a.O = mixed + t0 * MIXW + MX_C + hq * 128; a.ldo = MIXW;
            a.i0 = qb * 256; a.C = 0.08838834764831845f * LOG2E;
#ifdef SIMPLE_DENSE
            attn_unit<128, false, false, false, false>(lds, a);
#else
            #ifndef DENSE3BUF
            for (int rep = 0; rep < REP_C; ++rep) attn_dense_unit<128, false, 2>(lds, a);
#else
            for (int rep = 0; rep < REP_C; ++rep) attn_dense_unit3<128, false>(lds, a);
#endif
#endif
        } else if (it < NA + NC + ND) {
            const int c = it - NA - NC, blk = c & 63, hk = (c >> 6) & 1, b = c >> 7;
            const size_t t0 = (size_t)b * SEQ;
            BandArgs d;
            d.Q = proj + t0 * NINP + C_DQ + hk * 512; d.ldq = NINP;
            d.K = proj + t0 * NINP + C_DK + hk * 128; d.V = proj + t0 * NINP + C_DV + hk * 128; d.ldk = NINP;
            d.G = proj + t0 * NINP + C_GATE + MX_D + hk * 512; d.ldg = NINP;
            d.O = mixed + t0 * MIXW + MX_D + hk * 512; d.ldo = MIXW;
            d.lse = nullptr; d.ldl = 0; d.bias = p.rel_bias + 12 + hk * 4; d.sinks = p.sinks + layer * 8 + hk * 4;
            d.i0 = blk * 64; d.L = SEQ; d.side = 128; d.dil = 1; d.nt = 5; d.C = 0.08838834764831845f * LOG2E;
#if defined(PROBE_D)
            attn_band_unit<4, true, false, PROBE_D>(lds, d);
#endif
            for (int rep2 = 0; rep2 < REP_D; ++rep2) attn_band_unit<4, true, false>(lds, d);
        } else {
            const int c = it - NA - NC - ND, u = c & 15, hh = (c >> 4) & 3, j = (c >> 6) % 3, b = c / 192;
            const int dil = (j == 0) ? 1 : (j == 1 ? 4 : 16), L = SEQ / dil, nblk = L / 256, r = u / nblk, qb = u % nblk;
            const size_t t0 = (size_t)b * SEQ + r; const int head = j * 4 + hh;
            BandArgs d;
            d.Q = proj + t0 * NINP + C_BQ + head * 128; d.ldq = (long)dil * NINP;
            d.K = proj + t0 * NINP + C_BK + head * 128; d.V = proj + t0 * NINP + C_BV + head * 128; d.ldk = (long)dil * NINP;
            d.G = proj + t0 * NINP + C_GATE + MX_B + head * 128; d.ldg = (long)dil * NINP;
            d.O = mixed + t0 * MIXW + MX_B + head * 128; d.ldo = (long)dil * MIXW;
            d.lse = (float*)(ws + WS_LSE) + ((size_t)j * MTOK + t0) * 4 + hh; d.ldl = (long)dil * 4;
            d.bias = p.rel_bias + head; d.sinks = nullptr;
            d.i0 = qb * 256; d.L = L; d.side = 64; d.dil = dil; d.nt = 6; d.C = 0.08838834764831845f * LOG2E;
            for (int rep2 = 0; rep2 < REP_B; ++rep2) attn_band_unit<1, false, true>(lds, d);
        }
    }
}

#define XB_TMO      128
#define XB_XCNT(j)  (256  + 64 * (j))
#define XB_XSUB(j)  (1280 + 64 * (j))
#define XB_XGEN(j)  (2304 + 64 * (j))
#define XB_TOP      3328
#define XB_TOPGEN   3392
#define XCD_BAR_WORDS 3456
#define XB_SPIN_CAP (1u << 18)

__device__ __forceinline__ unsigned xb_ld(unsigned* p)              { return __hip_atomic_load(p, __ATOMIC_RELAXED, __HIP_MEMORY_SCOPE_AGENT); }
__device__ __forceinline__ unsigned xb_add(unsigned* p, unsigned v) { return __hip_atomic_fetch_add(p, v, __ATOMIC_RELAXED, __HIP_MEMORY_SCOPE_AGENT); }
__device__ __forceinline__ unsigned xb_xcc_id() { return (unsigned)__builtin_amdgcn_s_getreg((3 << 11) | 20) & 0xFu; }
#define XB_SPIN(cond, bar) do { unsigned _sp = 0; while (cond) { __builtin_amdgcn_s_sleep(1); \
    if ((++_sp & 255u) == 0u) { if (xb_ld(&(bar)[XB_TMO])) break; if (_sp > XB_SPIN_CAP) { atomicAdd(&(bar)[XB_TMO], 1u); break; } } } } while (0)

struct XcdBarrier {
    unsigned* bar; unsigned x;
    volatile LAS unsigned* st;
};

__device__ __forceinline__ XcdBarrier xcd_barrier_post(unsigned* bar, volatile LAS unsigned* st) {
    XcdBarrier b; b.bar = bar; b.x = xb_xcc_id(); b.st = st;
    if (threadIdx.x == 0) (void)xb_add(&bar[XB_XCNT(b.x)], 1u);
    return b;
}
__device__ __forceinline__ void xcd_barrier_complete(unsigned* bar, unsigned x, unsigned& nloc, unsigned& nx) {
    const unsigned G = gridDim.x * gridDim.y * gridDim.z;
    unsigned sum, cnt, mine, sp = 0u;
    for (;;) {
        sum = 0u; cnt = 0u; mine = 0u;
#pragma unroll
        for (unsigned j = 0; j < 16; ++j) { const unsigned c = xb_ld(&bar[XB_XCNT(j)]); sum += c; cnt += (c > 0u) ? 1u : 0u; mine = (j == x) ? c : mine; }
        if (sum == G) break;
        __builtin_amdgcn_s_sleep(1);
        if ((++sp & 255u) == 0u) { if (xb_ld(&bar[XB_TMO])) break; if (sp > XB_SPIN_CAP) { atomicAdd(&bar[XB_TMO], 1u); break; } }
    }
    nloc = mine > 0u ? mine : 1u; nx = cnt > 0u ? cnt : 1u;
}

__device__ __forceinline__ void xcd_barrier(const XcdBarrier& b) {
    asm volatile("s_waitcnt vmcnt(0)" ::: "memory");
    __syncthreads();
    if (threadIdx.x == 0) {
        unsigned* bar = b.bar;
        __builtin_amdgcn_s_waitcnt(0);
        unsigned nloc = b.st[0], nx = b.st[1];
        if (nloc == 0u) { xcd_barrier_complete(bar, b.x, nloc, nx); b.st[0] = nloc; b.st[1] = nx; }
        const unsigned old = xb_add(&bar[XB_XSUB(b.x)], 1u);
        const unsigned gen = old / nloc;
        if (old + 1u == (gen + 1u) * nloc) {
            __builtin_amdgcn_fence(__ATOMIC_RELEASE, "agent");
            asm volatile("s_waitcnt vmcnt(0)" ::: "memory");
            const unsigned og = xb_add(&bar[XB_TOP], 1u);
            const unsigned tg = og / nx;
            if (og + 1u == (tg + 1u) * nx) xb_add(&bar[XB_TOPGEN], 1u);
            else XB_SPIN(xb_ld(&bar[XB_TOPGEN]) == tg, bar);
            __builtin_amdgcn_fence(__ATOMIC_ACQUIRE, "agent");
            xb_add(&bar[XB_XGEN(b.x)], 1u);
            asm volatile("s_waitcnt vmcnt(0)" ::: "memory");
        } else {
            XB_SPIN(xb_ld(&bar[XB_XGEN(b.x)]) == gen, bar);
            __builtin_amdgcn_fence(__ATOMIC_ACQUIRE, "agent");
            asm volatile("s_waitcnt vmcnt(0)" ::: "memory");
        }
    }
    __syncthreads();
}

__global__ void __launch_bounds__(512) hymba_fwd(Params p0) {
    extern __shared__ __attribute__((aligned(16))) unsigned char shm[];
    lds_u8* lds = (lds_u8*)shm;
    cg::grid_group grid = cg::this_grid();
    const int wg0 = blockIdx.x, nwg0 = gridDim.x;
    const int lo = p0.ph_lo, hi = p0.ph_hi;
    if (lo < 0) grid.sync();
    volatile LAS unsigned* bst = (volatile LAS unsigned*)(lds + LDS_BYTES - 256);
    if (threadIdx.x == 0) { bst[0] = 0u; bst[1] = 0u; }
    __syncthreads();
    XcdBarrier xbar = xcd_barrier_post((unsigned*)(p0.ws + WS_BAR), bst);
    int ph = 0;
#define PH_BEGIN if (lo <= ph && ph < hi) { auto kp4 = (__attribute__((address_space(4))) const char*)__builtin_amdgcn_kernarg_segment_ptr(); asm volatile("" : "+s"(kp4)); \
    const Params& p = *(const Params*)kp4; unsigned char* ws = p.ws; int wg = wg0, nwg = nwg0; asm volatile("" : "+s"(wg), "+s"(nwg)); \
    bf16_t* WinT = (bf16_t*)(ws + WS_WIN); bf16_t* WoutT = (bf16_t*)(ws + WS_WOUT); bf16_t* WuqT = (bf16_t*)(ws + WS_WUQ); bf16_t* WukvT = (bf16_t*)(ws + WS_WUKV); \
    bf16_t* H = (bf16_t*)(ws + WS_H); bf16_t* PROJ = (bf16_t*)(ws + WS_PROJ); float* X1 = (float*)(ws + WS_X1); \
    bf16_t* QAN = (bf16_t*)(ws + WS_QAN); bf16_t* KVAN = (bf16_t*)(ws + WS_KVAN); bf16_t* KPE = (bf16_t*)(ws + WS_KPE); \
    bf16_t* QRAW = (bf16_t*)(ws + WS_QRAW); bf16_t* KVRAW = (bf16_t*)(ws + WS_KVRAW); bf16_t* QC = (bf16_t*)(ws + WS_QC); bf16_t* KC = (bf16_t*)(ws + WS_KC); \
    bf16_t* MIXED = (bf16_t*)(ws + WS_MIXED); bf16_t* DELTA = (bf16_t*)(ws + WS_DELTA); (void)DELTA; float* LSE = (float*)(ws + WS_LSE); float2* CS = (float2*)(ws + WS_CS); \
    (void)WinT; (void)WoutT; (void)WuqT; (void)WukvT; (void)H; (void)PROJ; (void)X1; (void)QAN; (void)KVAN; (void)KPE; (void)QRAW; (void)KVRAW; (void)QC; (void)KC; (void)MIXED; (void)LSE; (void)CS;
#define PH_END } if (lo <= ph && ph + 1 < hi) xcd_barrier(xbar); ++ph;

    PH_BEGIN
        for (int l = 1; l >= 0; --l) {
            cvt_transpose(p.w_out + (size_t)l * MIXW * DM, WoutT + (size_t)l * DM * MIXW, MIXW, DM, DM, lds, wg, nwg);
            cvt_transpose(p.w_ukv + (size_t)l * 512 * 2048, WukvT + (size_t)l * 2048 * 512, 512, 2048, 2048, lds, wg, nwg);
            cvt_transpose(p.w_uq + (size_t)l * 768 * 1536, WuqT + (size_t)l * 1536 * 768, 768, 1536, 1536, lds, wg, nwg);
            cvt_transpose(p.w_in + (size_t)l * DM * NIN, WinT + (size_t)l * NINP * DM, DM, NIN, NINP, lds, wg, nwg);
        }
        build_cs(CS, wg, nwg);
        rmsnorm_rows<0, true>(p.x, nullptr, nullptr, p.g_attn, H, nullptr, wg, nwg);
    PH_END

#pragma unroll 1
    for (int l = 0; l < 2; ++l) {
        if (l > 0) {
            PH_BEGIN
                rmsnorm_rows<1, true>(p.x, DELTA, nullptr, p.g_attn + (size_t)l * DM, H, nullptr, wg, nwg);
            PH_END
        }
        PH_BEGIN
#ifndef NO_GEMM
            pg8::Gemm g{H, WinT + (size_t)l * NINP * DM, MTOK, NINP, DM}; pg8::StaticOrder S; S.init(MTOK, NINP, nwg, wg);
            pg8::EpiBf16P E{PROJ, NINP};
            for (int rep = 0; rep < REP_GEMM; ++rep)
            pg8::gemm_phase<pg8::EpiBf16P, pg8::StaticOrder, GEMM_ALIGN, GEMM_SP2>(lds, g, S, E);
            if (CVT_P0_LAYERS == 1 && l == 0 && nwg == 256 && wg >= 192)
                cvt_transpose(p.w_in + (size_t)DM * NIN, WinT + (size_t)NINP * DM, DM, NIN, NINP, lds, wg - 192, 64);
#endif
        PH_END
        PH_BEGIN
            for (int rep = 0; rep < REP_MISC; ++rep) prep_tokens(PROJ, p.g_qa + l * 768, p.g_kva + l * 512, p.g_qn + l * 128, p.g_kn + l * 128, CS, QAN, KVAN, KPE, QC, KC, (bf16_t*)(ws + WS_DKV), wg, nwg);
        PH_END
        PH_BEGIN
#ifndef NO_GEMM
            for (int rep = 0; rep < REP_UP; ++rep) {
            { pg8::Gemm g{QAN, WuqT + (size_t)l * 1536 * 768, MTOK, 1536, 768}; pg8::StaticOrder S; S.init(MTOK, 1536, nwg, wg);
              pg8::EpiBf16P E{QRAW, 1536};
              pg8::gemm_phase<pg8::EpiBf16P, pg8::StaticOrder, GEMM_ALIGN, GEMM_SP2>(lds, g, S, E); }
            { pg8::Gemm g{KVAN, WukvT + (size_t)l * 2048 * 512, MTOK, 2048, 512}; pg8::StaticOrder S; S.init(MTOK, 2048, nwg, nwg - 1 - wg);
              pg8::EpiBf16P E{KVRAW, 2048};
              pg8::gemm_phase<pg8::EpiBf16P, pg8::StaticOrder, GEMM_ALIGN, GEMM_SP2>(lds, g, S, E); }
            }
#endif
        PH_END
        PH_BEGIN
#ifndef NO_ATTN
            for (int rep = 0; rep < REP_ATTN; ++rep) attn_phase(lds, p, l, wg, nwg);
            if ((CVT_P0_LAYERS == 1 || HIDE_TAIL) && l == 0 && nwg == 256 && wg >= 128) {
                cvt_transpose(p.w_out + (size_t)MIXW * DM, WoutT + (size_t)DM * MIXW, MIXW, DM, DM, lds, wg - 128, 128);
                cvt_transpose(p.w_uq + (size_t)768 * 1536, WuqT + (size_t)1536 * 768, 768, 1536, 1536, lds, wg - 128, 128);
                cvt_transpose(p.w_ukv + (size_t)512 * 2048, WukvT + (size_t)2048 * 512, 512, 2048, 2048, lds, wg - 128, 128);
            }
#endif
        PH_END
        PH_BEGIN
            fixup_b(MIXED, LSE, wg, nwg);
        PH_END
        PH_BEGIN
#ifndef NO_GEMM
            pg8::Gemm g{MIXED, WoutT + (size_t)l * DM * MIXW, MTOK, DM, MIXW}; pg8::StaticOrder S; S.init(MTOK, DM, nwg, wg);
            pg8::EpiBf16P E{DELTA + (size_t)l * MTOK * DM, DM};
            for (int rep = 0; rep < REP_OUT; ++rep)
            pg8::gemm_phase<pg8::EpiBf16P, pg8::StaticOrder, GEMM_ALIGN, GEMM_SP2>(lds, g, S, E);
#endif
        PH_END
    }
    for (int rep = 0; rep < REP_SYNC; ++rep) xcd_barrier(xbar);
    PH_BEGIN
        rmsnorm_rows<2, false>(p.x, DELTA, DELTA + (size_t)MTOK * DM, p.g_final, nullptr, p.out, wg, nwg);
    PH_END
#undef PH_BEGIN
#undef PH_END
}

constexpr int N_PHASES = 15;

extern "C" void kernel_launch(void* const* d_in, const int* in_sizes, int n_in, void* d_out, int out_size, void* d_ws, size_t ws_size, hipStream_t stream) {
    static int grid_blocks = 0;
    if (grid_blocks == 0) {
        if (n_in != 13 || ws_size < WS_END || out_size != MTOK * DM) { fprintf(stderr, "kernel_launch: unexpected shapes (n_in %d, out %d, ws %zu, need %zu)\n", n_in, out_size, ws_size, (size_t)WS_END); grid_blocks = -1; return; }
        int dev = 0, cus = 0, per_cu = 0;
        hipGetDevice(&dev);
        hipDeviceGetAttribute(&cus, hipDeviceAttributeMultiprocessorCount, dev);
        if (hipFuncSetAttribute((const void*)hymba_fwd, hipFuncAttributeMaxDynamicSharedMemorySize, LDS_BYTES) != hipSuccess) { fprintf(stderr, "kernel_launch: hipFuncSetAttribute failed\n"); grid_blocks = -1; return; }
        if (hipOccupancyMaxActiveBlocksPerMultiprocessor(&per_cu, (const void*)hymba_fwd, 512, LDS_BYTES) != hipSuccess || per_cu < 1) { fprintf(stderr, "kernel_launch: occupancy query gave %d\n", per_cu); per_cu = 1; }
        (void)hipGetLastError();
        grid_blocks = cus * 1;
        fprintf(stderr, "kernel_launch: cus %d per_cu %d grid %d\n", cus, per_cu, grid_blocks);
    }
    if (grid_blocks < 0) return;
    Params p{};
    p.x = (const float*)d_in[0]; p.g_attn = (const float*)d_in[1]; p.w_in = (const float*)d_in[2]; p.g_qa = (const float*)d_in[3]; p.g_kva = (const float*)d_in[4];
    p.w_uq = (const float*)d_in[5]; p.w_ukv = (const float*)d_in[6]; p.g_qn = (const float*)d_in[7]; p.g_kn = (const float*)d_in[8]; p.sinks = (const float*)d_in[9];
    p.w_out = (const float*)d_in[10]; p.rel_bias = (const float*)d_in[11]; p.g_final = (const float*)d_in[12];
    p.out = (float*)d_out; p.ws = (unsigned char*)d_ws;
#if defined(MULTI_LAUNCH)
    for (int k = 0; k < N_PHASES; ++k) { p.ph_lo = k; p.ph_hi = k + 1; hipLaunchKernelGGL(hymba_fwd, dim3(grid_blocks), dim3(512), LDS_BYTES, stream, p); }
#else
    p.ph_lo = 0; p.ph_hi = N_PHASES;
    if (hipMemsetAsync((char*)d_ws + WS_BAR, 0, 3456 * 4, stream) != hipSuccess) { fprintf(stderr, "kernel_launch: memset of the barrier words failed\n"); return; }
    void* args[] = {&p};
    hipError_t e = hipLaunchCooperativeKernel((const void*)hymba_fwd, dim3(grid_blocks), dim3(512), args, LDS_BYTES, stream);
    if (e != hipSuccess) fprintf(stderr, "cooperative launch failed: %s (grid %d)\n", hipGetErrorString(e), grid_blocks);
#endif
}
```

```cpp
#include <hip/hip_runtime.h>
#include <hip/hip_cooperative_groups.h>
#include <cstdio>
namespace cg = cooperative_groups;
namespace pg8 {
#define PG8_LAS __attribute__((address_space(3)))
typedef unsigned short bf16_t;
__device__ __forceinline__ int opaque_tid() { int t = threadIdx.x; asm volatile("" : "+v"(t)); return t; }
typedef short bf16x8 __attribute__((ext_vector_type(8)));
typedef float f32x4 __attribute__((ext_vector_type(4)));
typedef unsigned u32x4 __attribute__((ext_vector_type(4)));
constexpr int BM = 256, BK = 64, HALF = 128, HTB = HALF * BK * 2  , STAGE_BYTES = 8 * HTB, NXCD = 8, WGM = 8;

__host__ __device__ __forceinline__ int lds_byte(int r, int c) { const int st = (r >> 4) * 2 + (c >> 5), rr = r & 15, cc = c & 31, ob = rr * 64 + cc * 2; return st * 1024 + (ob ^ (((ob >> 9) & 1) << 5)); }
__host__ __device__ __forceinline__ void stage_rc(int b, int& R, int& C) { const int st = b / 1024, sb = b % 1024, swz = sb ^ (((sb >> 9) & 1) << 5); R = (st >> 1) * 16 + swz / 64; C = (st & 1) * 32 + (swz % 64) / 2; }
__host__ __device__ __forceinline__ int perm32(int rho) { const int n = rho >> 4, i = rho & 15; return 8 * (i >> 2) + 4 * n + (i & 3); }

struct Unit { int pm, pn; };
struct Gemm { const bf16_t* A; const bf16_t* Bt; int M, N, K; };
struct StaticOrder {
    int nM, nN, nwg, G, c;
    __host__ __device__ void init(int M, int N, int G_, int c_) { nM = M / BM; nN = N / BM; nwg = nM * nN; G = G_; c = c_; }
    __host__ __device__ bool next(int i, Unit& u) const {
        const long L = (long)i * G + c; if (L >= nwg) return false;
        int wgid = (int)L; { const int q = nwg / NXCD, r = nwg % NXCD, xcd = wgid % NXCD, off = wgid / NXCD; wgid = (xcd < r ? xcd * (q + 1) : r * (q + 1) + (xcd - r) * q) + off; }
        const int nig = WGM * nN, gid = wgid / nig, fm = gid * WGM, gsz = (nM - fm) < WGM ? (nM - fm) : WGM;
        u.pm = fm + ((wgid % nig) % gsz); u.pn = (wgid % nig) / gsz; return true;
    }
    __device__ __forceinline__ void a_ready(const Unit&) const {}
    __device__ __forceinline__ void done(const Unit&) const {}
};
struct RevColOrder : StaticOrder {
    __host__ __device__ bool next(int i, Unit& u) const { const bool r = StaticOrder::next(i, u); if (r) u.pn = nN - 1 - u.pn; return r; }
};
__device__ __forceinline__ unsigned cvt_pk_bf16(float lo, float hi) { unsigned r; asm volatile("v_cvt_pk_bf16_f32 %0, %1, %2" : "=v"(r) : "v"(lo), "v"(hi)); return r; }
typedef float f32x2 __attribute__((ext_vector_type(2)));
struct EpiBf16P {
    static constexpr bool PERM = true, AFTER_DRAIN = false;
    bf16_t* O; int ldc;
    __device__ __forceinline__ void operator()(const f32x4 (&acc)[2][2][4][2], const Unit& u, int wr, int wc, int fr, int fq) const {
        const int row0 = u.pm * BM + wr * 64 + fr; const int col0 = u.pn * BM + wc * 32 + 8 * fq;
#pragma unroll
        for (int ai = 0; ai < 2; ++ai)
#pragma unroll
            for (int m = 0; m < 4; ++m) { bf16_t* rowp = O + (size_t)(row0 + ai * HALF + m * 16) * ldc + col0;
#pragma unroll
                for (int bj = 0; bj < 2; ++bj) { const f32x4 v0 = acc[ai][bj][m][0], v1 = acc[ai][bj][m][1];
                    u32x4 w; w.x = cvt_pk_bf16(v0[0], v0[1]); w.y = cvt_pk_bf16(v0[2], v0[3]); w.z = cvt_pk_bf16(v1[0], v1[1]); w.w = cvt_pk_bf16(v1[2], v1[3]);
                    *(u32x4*)(rowp + bj * HALF) = w; } }
    }
};
struct EpiResF32 {
    static constexpr bool PERM = false, AFTER_DRAIN = false;
    const float* base; float* out; int ldc;
    __device__ __forceinline__ void operator()(const f32x4 (&acc)[2][2][4][2], const Unit& u, int wr, int wc, int fr, int fq) const {
        const int row0 = u.pm * BM + wr * 64 + fr, col0 = u.pn * BM + wc * 32 + 4 * fq;
#pragma unroll
        for (int ai = 0; ai < 2; ++ai)
#pragma unroll
            for (int m = 0; m < 4; ++m) { const size_t off = (size_t)(row0 + ai * HALF + m * 16) * ldc + col0;
#pragma unroll
                for (int bj = 0; bj < 2; ++bj)
#pragma unroll
                    for (int n = 0; n < 2; ++n) { const f32x4 b = *(const f32x4*)(base + off + bj * HALF + n * 16); *(f32x4*)(out + off + bj * HALF + n * 16) = acc[ai][bj][m][n] + b; } }
    }
};
template <class Epi, class Sched, bool ALIGN_EPI = false, bool SP2 = false>
__device__ __forceinline__ void gemm_phase(PG8_LAS unsigned char* lds, const Gemm g, const Sched& S, const Epi& E) {
    const int tid = opaque_tid(), wid = __builtin_amdgcn_readfirstlane(tid >> 6), lane = tid & 63, wr = wid >> 2, wc = wid & 3, fr = lane & 15, fq = lane >> 4;
    const int K = g.K, nt = K / BK;
    unsigned voffA[2], voffB[2];
#pragma unroll
    for (int i = 0; i < 2; ++i) { int R, C; stage_rc(tid * 16 + i * 8192, R, C); const int Rb = Epi::PERM ? ((R & ~31) + perm32(R & 31)) : R;
        voffA[i] = (unsigned)(R * K + C) * 2u; voffB[i] = (unsigned)(Rb * K + C) * 2u; }
    const size_t kstep = (size_t)(BK * 2);
    const size_t hstep = (size_t)HALF * K * 2;
    const size_t tstep = 2 * hstep;
    const unsigned ldsw = (unsigned)wid * 1024u;
    const int aoff = lds_byte(wr * 64 + fr, fq * 8), boff = lds_byte(wc * 32 + fr, fq * 8);
#define PG8_SA(b, h) (((b) * 2 + (h)) * HTB)
#define PG8_SB(b, h) ((4 + (b) * 2 + (h)) * HTB)
#define PG8_STAGE(bufoff, gbase, voff) do { _Pragma("unroll") for (int _i = 0; _i < 2; ++_i) \
        __builtin_amdgcn_global_load_lds((const unsigned*)((const char*)(gbase) + (voff)[_i]), (PG8_LAS unsigned*)(lds + (bufoff) + ldsw + _i * 8192), 16, 0, 0); } while (0)
#define PG8_LDA(dst, b, h) do { _Pragma("unroll") for (int m = 0; m < 4; ++m) _Pragma("unroll") for (int k = 0; k < 2; ++k) dst[m][k] = *(const PG8_LAS bf16x8*)(lds + PG8_SA(b, h) + aoff + m * 2048 + k * 1024); } while (0)
#define PG8_LDB(dst, b, h) do { _Pragma("unroll") for (int n = 0; n < 2; ++n) _Pragma("unroll") for (int k = 0; k < 2; ++k) dst[n][k] = *(const PG8_LAS bf16x8*)(lds + PG8_SB(b, h) + boff + n * 2048 + k * 1024); } while (0)
#define PG8_MMA(ai, bj, At, Bt) do { __builtin_amdgcn_s_setprio(1); _Pragma("unroll") for (int m = 0; m < 4; ++m) _Pragma("unroll") for (int n = 0; n < 2; ++n) _Pragma("unroll") for (int k = 0; k < 2; ++k) \
        acc[ai][bj][m][n] = __builtin_amdgcn_mfma_f32_16x16x32_bf16(Bt[n][k], At[m][k], acc[ai][bj][m][n], 0, 0, 0); __builtin_amdgcn_s_setprio(0); } while (0)
#define PG8_WAIT_V(n) asm volatile("s_waitcnt vmcnt(" #n ")" ::: "memory")
#define PG8_WAIT_L(n) asm volatile("s_waitcnt lgkmcnt(" #n ")" ::: "memory")
#define PG8_BAR __builtin_amdgcn_s_barrier()
#define PG8_SCHED __builtin_amdgcn_sched_barrier(0)
    Unit cur, nxt; int ui = 0;
    if (!S.next(0, cur)) return;
    f32x4 acc[2][2][4][2];
#pragma unroll
    for (int a = 0; a < 2; ++a)
#pragma unroll
        for (int b = 0; b < 2; ++b)
#pragma unroll
            for (int m = 0; m < 4; ++m)
#pragma unroll
                for (int n = 0; n < 2; ++n) acc[a][b][m][n] = (f32x4){0.f, 0.f, 0.f, 0.f};
    bf16x8 At[4][2], B0[2][2], B1[2][2];
    const char* cA = (const char*)g.A + (size_t)cur.pm * tstep; const char* cB = (const char*)g.Bt + (size_t)cur.pn * tstep;
    S.a_ready(cur);
    if constexpr (SP2) {
        PG8_STAGE(PG8_SB(0, 0), cB, voffB); PG8_STAGE(PG8_SB(0, 1), cB + hstep, voffB); PG8_STAGE(PG8_SA(0, 0), cA, voffA); PG8_STAGE(PG8_SA(0, 1), cA + hstep, voffA);
        if (wr == 1) PG8_BAR;
        PG8_WAIT_V(2); PG8_BAR;
        PG8_STAGE(PG8_SB(1, 0), cB + kstep, voffB); PG8_STAGE(PG8_SA(1, 0), cA + kstep, voffA); PG8_STAGE(PG8_SB(1, 1), cB + hstep + kstep, voffB);
        PG8_WAIT_V(6); PG8_BAR;
    } else {
        PG8_STAGE(PG8_SB(0, 0), cB, voffB); PG8_STAGE(PG8_SA(0, 0), cA, voffA); PG8_STAGE(PG8_SB(0, 1), cB + hstep, voffB); PG8_STAGE(PG8_SA(0, 1), cA + hstep, voffA);
        if (wr == 1) PG8_BAR;
        PG8_WAIT_V(4); PG8_BAR;
        PG8_STAGE(PG8_SB(1, 0), cB + kstep, voffB); PG8_STAGE(PG8_SA(1, 0), cA + kstep, voffA); PG8_STAGE(PG8_SB(1, 1), cB + hstep + kstep, voffB);
        PG8_WAIT_V(6); PG8_BAR;
    }
    for (;;) {
        const bool has_next = S.next(ui + 1, nxt);
        const char* nA = has_next ? (const char*)g.A + (size_t)nxt.pm * tstep : cA; const char* nB = has_next ? (const char*)g.Bt + (size_t)nxt.pn * tstep : cB;
        for (int t = 0; t < nt; t += 2) {
            const bool last = (t == nt - 2);
            const char* a1 = cA + (size_t)(t + 1) * kstep;
            const char* a2 = last ? nA : cA + (size_t)(t + 2) * kstep; const char* b2 = last ? nB : cB + (size_t)(t + 2) * kstep;
            const char* a3 = a2 + kstep; const char* b3 = b2 + kstep;
            if (last && has_next) S.a_ready(nxt);
            if constexpr (SP2) {
            PG8_LDB(B0, 0, 0); PG8_LDB(B1, 0, 1); PG8_SCHED; PG8_LDA(At, 0, 0); PG8_STAGE(PG8_SA(1, 1), a1 + hstep, voffA);
            PG8_WAIT_V(8); PG8_WAIT_L(0); PG8_BAR; PG8_MMA(0, 0, At, B0); PG8_MMA(0, 1, At, B1); PG8_BAR; PG8_SCHED;
            PG8_LDA(At, 0, 1); PG8_STAGE(PG8_SB(0, 0), b2, voffB); PG8_STAGE(PG8_SB(0, 1), b2 + hstep, voffB); PG8_STAGE(PG8_SA(0, 0), a2, voffA);
            PG8_WAIT_V(8); PG8_WAIT_L(0); PG8_BAR; PG8_MMA(1, 0, At, B0); PG8_MMA(1, 1, At, B1); PG8_BAR; PG8_SCHED;
            PG8_LDB(B0, 1, 0); PG8_LDB(B1, 1, 1); PG8_SCHED; PG8_LDA(At, 1, 0); PG8_STAGE(PG8_SA(0, 1), a2 + hstep, voffA);
            PG8_WAIT_V(8); PG8_WAIT_L(0); PG8_BAR; PG8_MMA(0, 0, At, B0); PG8_MMA(0, 1, At, B1); PG8_BAR; PG8_SCHED;
            PG8_LDA(At, 1, 1); PG8_STAGE(PG8_SB(1, 0), b3, voffB); PG8_STAGE(PG8_SB(1, 1), b3 + hstep, voffB); PG8_STAGE(PG8_SA(1, 0), a3, voffA);
            PG8_WAIT_V(8); PG8_WAIT_L(0); PG8_BAR; PG8_MMA(1, 0, At, B0); PG8_MMA(1, 1, At, B1); PG8_BAR; PG8_SCHED;
            } else {
            PG8_LDB(B0, 0, 0); PG8_SCHED; PG8_LDA(At, 0, 0); PG8_STAGE(PG8_SA(1, 1), a1 + hstep, voffA);
            PG8_WAIT_L(8); PG8_BAR; PG8_WAIT_L(0); PG8_MMA(0, 0, At, B0); PG8_BAR; PG8_SCHED;
            PG8_LDB(B1, 0, 1); PG8_STAGE(PG8_SB(0, 0), b2, voffB);
            PG8_BAR; PG8_WAIT_L(0); PG8_MMA(0, 1, At, B1); PG8_BAR;
            PG8_LDA(At, 0, 1); PG8_STAGE(PG8_SA(0, 0), a2, voffA);
            PG8_BAR; PG8_WAIT_L(0); PG8_MMA(1, 0, At, B0); PG8_BAR; PG8_SCHED;
            PG8_STAGE(PG8_SB(0, 1), b2 + hstep, voffB);
            PG8_WAIT_V(6); PG8_BAR; PG8_MMA(1, 1, At, B1); PG8_BAR;
            PG8_LDB(B0, 1, 0); PG8_SCHED; PG8_LDA(At, 1, 0); PG8_STAGE(PG8_SA(0, 1), a2 + hstep, voffA);
            PG8_WAIT_L(8); PG8_BAR; PG8_WAIT_L(0); PG8_MMA(0, 0, At, B0); PG8_BAR; PG8_SCHED;
            PG8_LDB(B1, 1, 1); PG8_STAGE(PG8_SB(1, 0), b3, voffB);
            PG8_BAR; PG8_WAIT_L(0); PG8_MMA(0, 1, At, B1); PG8_BAR;
            PG8_LDA(At, 1, 1); PG8_STAGE(PG8_SA(1, 0), a3, voffA);
            PG8_BAR; PG8_WAIT_L(0); PG8_MMA(1, 0, At, B0); PG8_BAR; PG8_SCHED;
            PG8_STAGE(PG8_SB(1, 1), b3 + hstep, voffB);
            PG8_WAIT_V(6); PG8_BAR; PG8_MMA(1, 1, At, B1); PG8_BAR;
            }
        }
        if constexpr (ALIGN_EPI) { if (wr == 0) PG8_BAR; }
        if constexpr (!Epi::AFTER_DRAIN) { E(acc, cur, wr, wc, fr, fq); S.done(cur); }
        if (!has_next) break;
#pragma unroll
        for (int a = 0; a < 2; ++a)
#pragma unroll
            for (int b = 0; b < 2; ++b)
#pragma unroll
                for (int m = 0; m < 4; ++m)
#pragma unroll
                    for (int n = 0; n < 2; ++n) acc[a][b][m][n] = (f32x4){0.f, 0.f, 0.f, 0.f};
        cur = nxt; cA = nA; cB = nB; ++ui;
        if constexpr (ALIGN_EPI) { if (wr == 1) PG8_BAR; }
    }
    PG8_WAIT_V(0);
    if constexpr (!ALIGN_EPI) { if (wr == 0) PG8_BAR; }
    PG8_BAR;
    if constexpr (Epi::AFTER_DRAIN) { E.fused(acc, cur, wr, wc, fr, fq, lds, wid, lane); S.done(cur); }
#undef PG8_SA
#undef PG8_SB
#undef PG8_STAGE
#undef PG8_LDA
#undef PG8_LDB
#undef PG8_MMA
#undef PG8_WAIT_V
#undef PG8_WAIT_L
#undef PG8_BAR
#undef PG8_SCHED
}
}

typedef pg8::bf16_t bf16_t;
typedef pg8::bf16x8 bf16x8;
typedef pg8::f32x4 f32x4;
typedef pg8::u32x4 u32x4;
typedef short s16x4 __attribute__((ext_vector_type(4)));
typedef float f32x16 __attribute__((ext_vector_type(16)));
typedef unsigned u32x2 __attribute__((ext_vector_type(2)));
#define LAS __attribute__((address_space(3)))
typedef LAS unsigned char lds_u8;

constexpr int SEQ = 4096, NBATCH = 2, MTOK = 8192, DM = 4096, NIN = 13632, NINP = 13824, MIXW = 4608;
constexpr int C_ACQ = 0, C_ACKV = 768, C_KPE = 1280, C_BQ = 1344, C_BK = 2880, C_BV = 4416, C_CQ = 5952, C_CK = 6976, C_CV = 7232,
              C_DQ = 7488, C_DK = 8512, C_DV = 8768, C_GATE = 9024;
constexpr int MX_A = 0, MX_B = 1024, MX_C = 2560, MX_D = 3584;
constexpr float EPS = 1e-6f;
constexpr float LOG2E = 1.4426950408889634f, LN2 = 0.6931471805599453f;

constexpr size_t AL(size_t x) { return (x + 255) / 256 * 256; }
constexpr size_t WS_WIN   = 0;
constexpr size_t WS_WOUT  = WS_WIN   + AL((size_t)2 * NINP * DM * 2);
constexpr size_t WS_WUQ   = WS_WOUT  + AL((size_t)2 * DM * MIXW * 2);
constexpr size_t WS_WUKV  = WS_WUQ   + AL((size_t)2 * 1536 * 768 * 2);
constexpr size_t WS_H     = WS_WUKV  + AL((size_t)2 * 2048 * 512 * 2);
constexpr size_t WS_PROJ  = WS_H     + AL((size_t)MTOK * DM * 2);
constexpr size_t WS_X1    = WS_PROJ  + AL((size_t)MTOK * NINP * 2);
constexpr size_t WS_QAN   = WS_X1    + AL((size_t)MTOK * DM * 4);
constexpr size_t WS_KVAN  = WS_QAN   + AL((size_t)MTOK * 768 * 2);
constexpr size_t WS_KPE   = WS_KVAN  + AL((size_t)MTOK * 512 * 2);
constexpr size_t WS_QRAW  = WS_KPE   + AL((size_t)MTOK * 64 * 2);
constexpr size_t WS_KVRAW = WS_QRAW  + AL((size_t)MTOK * 1536 * 2);
constexpr size_t WS_QC    = WS_KVRAW + AL((size_t)MTOK * 2048 * 2);
constexpr size_t WS_KC    = WS_QC    + AL((size_t)MTOK * 1024 * 2);
constexpr size_t WS_MIXED = WS_KC    + AL((size_t)MTOK * 256 * 2);
constexpr size_t WS_LSE   = WS_MIXED + AL((size_t)MTOK * MIXW * 2);
constexpr size_t WS_CS    = WS_LSE   + AL((size_t)3 * MTOK * 4 * 4);
constexpr size_t WS_DELTA = WS_CS    + AL((size_t)SEQ * 32 * 8);
constexpr size_t WS_DKV   = WS_DELTA + AL((size_t)2 * MTOK * DM * 2);
constexpr size_t WS_BAR   = WS_DKV   + AL((size_t)MTOK * 512 * 2);
constexpr size_t WS_END   = WS_BAR   + AL((size_t)3456 * 4);

constexpr int LDS_BYTES = 141312;

#ifndef REP_GEMM
#define REP_GEMM 1
#endif
#ifndef REP_OUT
#define REP_OUT 1
#endif
#ifndef REP_UP
#define REP_UP 1
#endif
#ifndef REP_SYNC
#define REP_SYNC 0
#endif
#ifndef REP_BAND
#define REP_BAND 1
#endif
#ifndef REP_A
#define REP_A 1
#endif
#ifndef REP_C
#define REP_C 1
#endif
#ifndef HIDE_TAIL
#define HIDE_TAIL 0
#endif
#ifndef CVT_P0_LAYERS
#define CVT_P0_LAYERS 2
#endif
#ifndef GEMM_ALIGN
#define GEMM_ALIGN true
#endif
#ifndef GEMM_SP2
#define GEMM_SP2 true
#endif
#ifndef REP_D
#define REP_D 1
#endif
#ifndef REP_B
#define REP_B 1
#endif
#ifndef REP_ATTN
#define REP_ATTN 1
#endif
#ifndef REP_CVT
#define REP_CVT 1
#endif
#ifndef REP_MISC
#define REP_MISC 1
#endif
struct Params {
    const float *x, *g_attn, *w_in, *g_qa, *g_kva, *w_uq, *w_ukv, *g_qn, *g_kn, *sinks, *w_out, *rel_bias, *g_final;
    float* out; unsigned char* ws; int ph_lo, ph_hi;
};

__device__ __forceinline__ bf16_t f2bf(float f) { unsigned u = __float_as_uint(f); u += 0x7FFFu + ((u >> 16) & 1u); return (bf16_t)(u >> 16); }
__device__ __forceinline__ float bf2f(bf16_t b) { return __uint_as_float(((unsigned)b) << 16); }
__device__ __forceinline__ float bflo(unsigned w) { return __uint_as_float(w << 16); }
__device__ __forceinline__ float bfhi(unsigned w) { return __uint_as_float(w & 0xffff0000u); }
__device__ __forceinline__ unsigned cvtpk(float lo, float hi) { unsigned r; asm volatile("v_cvt_pk_bf16_f32 %0, %1, %2" : "=v"(r) : "v"(lo), "v"(hi)); return r; }
__device__ __forceinline__ float wave_sum(float v) {
#pragma unroll
    for (int o = 32; o >= 1; o >>= 1) v += __shfl_xor(v, o);
    return v;
}
__device__ __forceinline__ int rel_bucket(int rel) {
    const int n = rel < 0 ? -rel : rel; int b;
    if (n < 8) b = n;
    else b = 8 + (n >= 15) + (n >= 27) + (n >= 50) + (n >= 91) + (n >= 166) + (n >= 305) + (n >= 559);
    return b + (rel > 0 ? 16 : 0);
}

constexpr int CVT_NQ = 4;
__device__ __forceinline__ void cvt_transpose(const float* __restrict__ src, bf16_t* __restrict__ dst, int K, int N, int Npad, lds_u8* lds, int wg, int nwg) {
    LAS float* tile = (LAS float*)lds;
    const int tid = pg8::opaque_tid(), tn4 = Npad / (64 * CVT_NQ), tk = K / 64;
    __syncthreads();
    for (int t = wg; t < tn4 * tk; t += nwg) {
        const int nt4 = t % tn4, kt = t / tn4;
        f32x4 v[CVT_NQ][2];
#pragma unroll
        for (int q = 0; q < CVT_NQ; ++q)
#pragma unroll
            for (int i = 0; i < 2; ++i) {
                const int row = (tid >> 4) + 32 * i, c4 = (tid & 15) * 4, n = (nt4 * CVT_NQ + q) * 64 + c4;
                v[q][i] = (f32x4){0.f, 0.f, 0.f, 0.f};
                if (n < N) v[q][i] = __builtin_nontemporal_load((const f32x4*)(src + (size_t)(kt * 64 + row) * N + n));
            }
#pragma unroll
        for (int q = 0; q < CVT_NQ; ++q)
#pragma unroll
            for (int i = 0; i < 2; ++i) {
                const int row = (tid >> 4) + 32 * i, c4 = (tid & 15) * 4;
                LAS float* tp = tile + q * (64 * 65) + row * 65 + c4;
                tp[0] = v[q][i][0]; tp[1] = v[q][i][1]; tp[2] = v[q][i][2]; tp[3] = v[q][i][3];
            }
        __syncthreads();
#pragma unroll
        for (int q = 0; q < CVT_NQ; ++q) {
            const int nl = tid >> 3, kc = (tid & 7) * 8;
            float f[8];
#pragma unroll
            for (int j = 0; j < 8; ++j) f[j] = tile[q * (64 * 65) + (kc + j) * 65 + nl];
            u32x4 w; w.x = cvtpk(f[0], f[1]); w.y = cvtpk(f[2], f[3]); w.z = cvtpk(f[4], f[5]); w.w = cvtpk(f[6], f[7]);
            *(u32x4*)(dst + (size_t)((nt4 * CVT_NQ + q) * 64 + nl) * K + kt * 64 + kc) = w;
        }
        __syncthreads();
    }
}

__device__ __forceinline__ void build_cs(float2* cs, int wg, int nwg) {
    for (int idx = wg * 512 + pg8::opaque_tid(); idx < SEQ * 32; idx += nwg * 512) {
        const int pos = idx >> 5, i = idx & 31;
        const float inv = exp2f(-(float)i * (13.287712379549449f / 32.0f));
        const float ang = (float)pos * inv;
        const float k = rintf(ang * 0.15915494309189535f);
        float r = fmaf(-k, 6.2831854820251465f, ang); r = fmaf(-k, -1.7484555e-7f, r);
        cs[idx] = make_float2(__cosf(r), __sinf(r));
    }
}

template <int NDELTA, bool TO_BF16>
__device__ __forceinline__ void rmsnorm_rows(const float* __restrict__ x, const bf16_t* __restrict__ delta0, const bf16_t* __restrict__ delta1, const float* __restrict__ g,
                                             bf16_t* __restrict__ hout, float* __restrict__ fout, int wg, int nwg) {
    const int tid = pg8::opaque_tid(), wid = tid >> 6, lane = tid & 63;
    f32x4 gk[16];
#pragma unroll
    for (int k = 0; k < 16; ++k) gk[k] = *(const f32x4*)(g + k * 256 + lane * 4);
    for (int row = wg * 8 + wid; row < MTOK; row += nwg * 8) {
        const float* xr = x + (size_t)row * DM + lane * 4;
        f32x4 v[16];
#pragma unroll
        for (int k = 0; k < 16; ++k) v[k] = __builtin_nontemporal_load((const f32x4*)(xr + k * 256));
        if (NDELTA >= 1) {
            u32x2 d[16];
#pragma unroll
            for (int k = 0; k < 16; ++k) d[k] = __builtin_nontemporal_load((const u32x2*)(delta0 + (size_t)row * DM + k * 256 + lane * 4));
#pragma unroll
            for (int k = 0; k < 16; ++k) { v[k][0] += bflo(d[k].x); v[k][1] += bfhi(d[k].x); v[k][2] += bflo(d[k].y); v[k][3] += bfhi(d[k].y); }
        }
        if (NDELTA >= 2) {
            u32x2 d[16];
#pragma unroll
            for (int k = 0; k < 16; ++k) d[k] = __builtin_nontemporal_load((const u32x2*)(delta1 + (size_t)row * DM + k * 256 + lane * 4));
#pragma unroll
            for (int k = 0; k < 16; ++k) { v[k][0] += bflo(d[k].x); v[k][1] += bfhi(d[k].x); v[k][2] += bflo(d[k].y); v[k][3] += bfhi(d[k].y); }
        }
        float ss = 0.f;
#pragma unroll
        for (int k = 0; k < 16; ++k) ss += v[k][0] * v[k][0] + v[k][1] * v[k][1] + v[k][2] * v[k][2] + v[k][3] * v[k][3];
        ss = wave_sum(ss);
        const float rstd = rsqrtf(ss * (1.0f / DM) + EPS);
#pragma unroll
        for (int k = 0; k < 16; ++k) {
            const f32x4 y = v[k] * rstd * gk[k];
            if (TO_BF16) { u32x2 w; w.x = cvtpk(y[0], y[1]); w.y = cvtpk(y[2], y[3]); *(u32x2*)(hout + (size_t)row * DM + k * 256 + lane * 4) = w; }
            else __builtin_nontemporal_store(y, (f32x4*)(fout + (size_t)row * DM + k * 256 + lane * 4));
        }
    }
}

__device__ __forceinline__ void prep_tokens(const bf16_t* __restrict__ proj, const float* __restrict__ g_qa, const float* __restrict__ g_kva,
                                            const float* __restrict__ g_qn, const float* __restrict__ g_kn, const float2* __restrict__ cs,
                                            bf16_t* __restrict__ qan, bf16_t* __restrict__ kvan, bf16_t* __restrict__ kpe, bf16_t* __restrict__ qc, bf16_t* __restrict__ kc, bf16_t* __restrict__ dkv, int wg, int nwg) {
    const int tid = pg8::opaque_tid(), wid = tid >> 6, lane = tid & 63, hf = lane >> 5, i = lane & 31;
    for (int t = wg * 8 + wid; t < MTOK; t += nwg * 8) {
        const bf16_t* pr = proj + (size_t)t * NINP;
        const int pos = t & (SEQ - 1);
        u32x2 wq[3], wk[2];
#pragma unroll
        for (int k = 0; k < 3; ++k) wq[k] = *(const u32x2*)(pr + C_ACQ + k * 256 + lane * 4);
#pragma unroll
        for (int k = 0; k < 2; ++k) wk[k] = *(const u32x2*)(pr + C_ACKV + k * 256 + lane * 4);
        bf16_t hv[5][4];
#pragma unroll
        for (int s = 0; s < 5; ++s)
#pragma unroll
            for (int q = 0; q < 4; ++q) hv[s][q] = pr[C_CQ + (2 * s + hf) * 128 + q * 32 + i];
        const bf16_t kp1 = pr[C_KPE + i], kp2 = pr[C_KPE + 32 + i];
        const float2 ct = cs[pos * 32 + i], crow_ = cs[(pos >> 6) * 32 + i], ccol = cs[(pos & 63) * 32 + i];
        {
            float v[12]; float ss = 0.f;
#pragma unroll
            for (int k = 0; k < 3; ++k) { v[4 * k] = bflo(wq[k].x); v[4 * k + 1] = bfhi(wq[k].x); v[4 * k + 2] = bflo(wq[k].y); v[4 * k + 3] = bfhi(wq[k].y); }
#pragma unroll
            for (int j = 0; j < 12; ++j) ss += v[j] * v[j];
            ss = wave_sum(ss);
            const float rstd = rsqrtf(ss * (1.0f / 768.0f) + EPS);
#pragma unroll
            for (int k = 0; k < 3; ++k) { const f32x4 gg = *(const f32x4*)(g_qa + k * 256 + lane * 4);
                u32x2 w; w.x = cvtpk(v[4 * k] * rstd * gg[0], v[4 * k + 1] * rstd * gg[1]); w.y = cvtpk(v[4 * k + 2] * rstd * gg[2], v[4 * k + 3] * rstd * gg[3]);
                *(u32x2*)(qan + (size_t)t * 768 + k * 256 + lane * 4) = w; }
        }
        {
            float v[8]; float ss = 0.f;
#pragma unroll
            for (int k = 0; k < 2; ++k) { v[4 * k] = bflo(wk[k].x); v[4 * k + 1] = bfhi(wk[k].x); v[4 * k + 2] = bflo(wk[k].y); v[4 * k + 3] = bfhi(wk[k].y); }
#pragma unroll
            for (int j = 0; j < 8; ++j) ss += v[j] * v[j];
            ss = wave_sum(ss);
            const float rstd = rsqrtf(ss * (1.0f / 512.0f) + EPS);
#pragma unroll
            for (int k = 0; k < 2; ++k) { const f32x4 gg = *(const f32x4*)(g_kva + k * 256 + lane * 4);
                u32x2 w; w.x = cvtpk(v[4 * k] * rstd * gg[0], v[4 * k + 1] * rstd * gg[1]); w.y = cvtpk(v[4 * k + 2] * rstd * gg[2], v[4 * k + 3] * rstd * gg[3]);
                *(u32x2*)(kvan + (size_t)t * 512 + k * 256 + lane * 4) = w; }
        }
        if (hf == 0) {
            const float x1 = bf2f(kp1), x2 = bf2f(kp2);
            kpe[(size_t)t * 64 + i] = f2bf(x1 * ct.x - x2 * ct.y);
            kpe[(size_t)t * 64 + 32 + i] = f2bf(x2 * ct.x + x1 * ct.y);
        }
#pragma unroll
        for (int s = 0; s < 5; ++s) {
            const int head = 2 * s + hf;
            const float* gg = (head < 8) ? g_qn : g_kn;
            float a0 = bf2f(hv[s][0]), a1 = bf2f(hv[s][1]), a2 = bf2f(hv[s][2]), a3 = bf2f(hv[s][3]);
            float ss = a0 * a0 + a1 * a1 + a2 * a2 + a3 * a3;
#pragma unroll
            for (int o = 16; o >= 1; o >>= 1) ss += __shfl_xor(ss, o);
            const float rstd = rsqrtf(ss * (1.0f / 128.0f) + EPS);
            a0 *= rstd * gg[i]; a1 *= rstd * gg[32 + i]; a2 *= rstd * gg[64 + i]; a3 *= rstd * gg[96 + i];
            bf16_t* dst = (head < 8) ? (qc + (size_t)t * 1024 + head * 128) : (kc + (size_t)t * 256 + (head - 8) * 128);
            dst[i] = f2bf(a0 * crow_.x - a1 * crow_.y); dst[32 + i] = f2bf(a1 * crow_.x + a0 * crow_.y);
            dst[64 + i] = f2bf(a2 * ccol.x - a3 * ccol.y); dst[96 + i] = f2bf(a3 * ccol.x + a2 * ccol.y);
        }
    }
}

__device__ __forceinline__ void fixup_b(bf16_t* mixed, const float* __restrict__ lse, int wg, int nwg) {
    const int tid = pg8::opaque_tid(), wid = tid >> 6, lane = tid & 63, hh = lane >> 4;
    for (int t = wg * 8 + wid; t < MTOK; t += nwg * 8) {
        const float l0 = lse[((size_t)0 * MTOK + t) * 4 + hh], l1 = lse[((size_t)1 * MTOK + t) * 4 + hh], l2 = lse[((size_t)2 * MTOK + t) * 4 + hh];
        const float mx = fmaxf(l0, fmaxf(l1, l2));
        const float e0 = __expf(l0 - mx), e1 = __expf(l1 - mx), e2 = __expf(l2 - mx), inv = 1.0f / (e0 + e1 + e2);
        const float al[3] = {e0 * inv, e1 * inv, e2 * inv};
        u32x4 wv[3];
#pragma unroll
        for (int k = 0; k < 3; ++k) wv[k] = *(const u32x4*)(mixed + (size_t)t * MIXW + MX_B + k * 512 + lane * 8);
#pragma unroll
        for (int k = 0; k < 3; ++k) {
            u32x4 w = wv[k];
            const float a = al[k];
            w.x = cvtpk(bflo(w.x) * a, bfhi(w.x) * a); w.y = cvtpk(bflo(w.y) * a, bfhi(w.y) * a);
            w.z = cvtpk(bflo(w.z) * a, bfhi(w.z) * a); w.w = cvtpk(bflo(w.w) * a, bfhi(w.w) * a);
            *(u32x4*)(mixed + (size_t)t * MIXW + MX_B + k * 512 + lane * 8) = w;
        }
    }
}

__device__ __forceinline__ int crow(int r, int hi) { return (r & 3) + 8 * (r >> 2) + 4 * hi; }
#define KSWZ(row, colB) ((row) * 256 + ((colB) ^ (((row) & 7) << 4)))
#define PSWZ(row, colB) ((row) * 128 + ((colB) ^ (((row) & 7) << 4)))
__device__ __forceinline__ int v_st(int k, int c) { const int kk = (k & ~0xC) | ((k & 4) << 1) | ((k & 8) >> 1); return ((kk >> 3) * 4 + (c >> 5)) * 512 + ((kk & 7) * 32 + (c & 31)) * 2; }
__device__ __forceinline__ int v_rd_base(int lane) { return ((lane & 3) << 3) | (((lane >> 2) & 3) << 6) | (((lane >> 4) & 1) << 5) | (((lane >> 5) & 1) << 8); }
constexpr int v_rd_off(int d0, int ks, int half) { return d0 * 512 + ks * 4096 + half * 2048; }
template <int OFF> __device__ __forceinline__ s16x4 tr_read(int vb) {
    s16x4 r; asm volatile("ds_read_b64_tr_b16 %0, %1 offset:%2" : "=&v"(r) : "v"(vb), "i"(OFF) : "memory"); return r;
}
template <int D0> __device__ __forceinline__ void pv_one(f32x16& od, int vb, bf16x8 pa0, bf16x8 pa1, bf16x8 pa2, bf16x8 pa3) {
    const s16x4 l0 = tr_read<v_rd_off(D0, 0, 0)>(vb), h0 = tr_read<v_rd_off(D0, 0, 1)>(vb), l1 = tr_read<v_rd_off(D0, 1, 0)>(vb), h1 = tr_read<v_rd_off(D0, 1, 1)>(vb);
    const s16x4 l2 = tr_read<v_rd_off(D0, 2, 0)>(vb), h2 = tr_read<v_rd_off(D0, 2, 1)>(vb), l3 = tr_read<v_rd_off(D0, 3, 0)>(vb), h3 = tr_read<v_rd_off(D0, 3, 1)>(vb);
    asm volatile("s_waitcnt lgkmcnt(0)" ::: "memory"); __builtin_amdgcn_sched_barrier(0);
#define PK(L, H) (bf16x8){L[0], L[1], L[2], L[3], H[0], H[1], H[2], H[3]}
    od = __builtin_amdgcn_mfma_f32_32x32x16_bf16(pa0, PK(l0, h0), od, 0, 0, 0);
    od = __builtin_amdgcn_mfma_f32_32x32x16_bf16(pa1, PK(l1, h1), od, 0, 0, 0);
    od = __builtin_amdgcn_mfma_f32_32x32x16_bf16(pa2, PK(l2, h2), od, 0, 0, 0);
    od = __builtin_amdgcn_mfma_f32_32x32x16_bf16(pa3, PK(l3, h3), od, 0, 0, 0);
#undef PK
}

constexpr int AL_V = 0, AL_K = 16384, AL_KP = 32768, AL_WS = 40960, AL_LUT = 43008;

struct AttnArgs {
    const bf16_t* Q; long ldq;
    const bf16_t* K; long ldk;
    const bf16_t* K2; long ldk2;
    const bf16_t* V; long ldv;
    const bf16_t* G; long ldg;
    bf16_t* O; long ldo;
    float* lse; long ldl;
    const float2* cs;
    int i0, L, side, dil;
    const float* bias; int bcol;
    float C;
    float sink2;
};

template <int DQK, bool BAND, bool SINK, bool WLSE, bool ROPEQ>
__device__ __forceinline__ void attn_unit(lds_u8* lds, const AttnArgs& a) {
    constexpr int ND0 = DQK / 16;
    const int tid = pg8::opaque_tid(), wid = tid >> 6, lane = tid & 63, r32 = lane & 31, hi = lane >> 5;
    lds_u8* Vl = lds + AL_V; lds_u8* Kl = lds + AL_K; lds_u8* Kp = lds + AL_KP;
    LAS float* wsf = (LAS float*)(lds + AL_WS) + wid * 64; LAS float* li_l = wsf; LAS float* al_l = wsf + 32;
    LAS float* lut = (LAS float*)(lds + AL_LUT);
    __syncthreads();
    if (BAND) {
        if (tid <= 2 * a.side) { const int rel = tid - a.side; lut[tid] = a.bias[rel_bucket(rel * a.dil) * 20 + a.bcol] * LOG2E; }
    }
    const int qi = a.i0 + wid * 32 + r32;
    bf16x8 qr[ND0];
    {
        const bf16_t* Qw = a.Q + (long)qi * a.ldq + hi * 8;
#pragma unroll
        for (int d0 = 0; d0 < ND0; ++d0) qr[d0] = *(const bf16x8*)(Qw + d0 * 16);
    }
    if constexpr (ROPEQ) {
#pragma unroll
        for (int dd = 0; dd < 2; ++dd) {
            bf16x8 x1 = qr[8 + dd], x2 = qr[10 + dd];
#pragma unroll
            for (int j = 0; j < 8; ++j) {
                const float2 c = a.cs[qi * 32 + dd * 16 + hi * 8 + j];
                const float f1 = bf2f((bf16_t)x1[j]), f2 = bf2f((bf16_t)x2[j]);
                x1[j] = (short)f2bf(f1 * c.x - f2 * c.y); x2[j] = (short)f2bf(f2 * c.x + f1 * c.y);
            }
            qr[8 + dd] = x1; qr[10 + dd] = x2;
        }
    }
    int t_lo = 0, t_hi = a.L / 64, lo_w = 0, hi_w = 1 << 30;
    if (BAND) {
        t_lo = (a.i0 - a.side) / 64; if (t_lo < 0) t_lo = 0;
        int th = (a.i0 + 256 + a.side) / 64; if (th < t_hi) t_hi = th;
        const int w0 = a.i0 + wid * 32;
        lo_w = (w0 - a.side) >> 6; hi_w = (w0 + 31 + a.side) >> 6;
    }
    const int sr = tid >> 4, sc = (tid & 15) * 8;
    const int vst0 = v_st(sr, sc), vst1 = v_st(32 + sr, sc), kst0 = KSWZ(sr, sc * 2), kst1 = KSWZ(32 + sr, sc * 2);
    const int pr_ = tid >> 3, pc = (tid & 7) * 8, pst = PSWZ(pr_, pc * 2);
    const int vb0 = (int)(unsigned)(size_t)Vl + v_rd_base(lane);
    bf16x8 kA, kB, vA, vB, kP;
#define ALOAD(T) do { const long j0 = (long)(T) * 64; \
        kA = *(const bf16x8*)(a.K + (j0 + sr) * a.ldk + sc); kB = *(const bf16x8*)(a.K + (j0 + 32 + sr) * a.ldk + sc); \
        vA = *(const bf16x8*)(a.V + (j0 + sr) * a.ldv + sc); vB = *(const bf16x8*)(a.V + (j0 + 32 + sr) * a.ldv + sc); \
        if constexpr (DQK == 192) kP = *(const bf16x8*)(a.K2 + (j0 + pr_) * a.ldk2 + pc); } while (0)
    float m_reg = -1e29f, l_reg = 0.f;
    f32x16 o[4];
#pragma unroll
    for (int d = 0; d < 4; ++d)
#pragma unroll
        for (int r = 0; r < 16; ++r) o[d][r] = 0.f;
    ALOAD(t_lo);
    for (int T = t_lo; T < t_hi; ++T) {
        __syncthreads();
        *(LAS bf16x8*)(Kl + kst0) = kA; *(LAS bf16x8*)(Kl + kst1) = kB;
        *(LAS bf16x8*)(Vl + vst0) = vA; *(LAS bf16x8*)(Vl + vst1) = vB;
        if constexpr (DQK == 192) *(LAS bf16x8*)(Kp + pst) = kP;
        if (T + 1 < t_hi) ALOAD(T + 1);
        __syncthreads();
        if (T >= lo_w && T <= hi_w) {
            f32x16 p0, p1;
#pragma unroll
            for (int r = 0; r < 16; ++r) { p0[r] = 0.f; p1[r] = 0.f; }
#pragma unroll
            for (int d0 = 0; d0 < 8; ++d0) { const int cb = (d0 * 16 + hi * 8) * 2;
                const bf16x8 b0 = *(const LAS bf16x8*)(Kl + KSWZ(r32, cb)), b1 = *(const LAS bf16x8*)(Kl + KSWZ(32 + r32, cb));
                p0 = __builtin_amdgcn_mfma_f32_32x32x16_bf16(b0, qr[d0], p0, 0, 0, 0);
                p1 = __builtin_amdgcn_mfma_f32_32x32x16_bf16(b1, qr[d0], p1, 0, 0, 0); }
            if constexpr (DQK == 192) {
#pragma unroll
                for (int d0 = 0; d0 < 4; ++d0) { const int cb = (d0 * 16 + hi * 8) * 2;
                    const bf16x8 b0 = *(const LAS bf16x8*)(Kp + PSWZ(r32, cb)), b1 = *(const LAS bf16x8*)(Kp + PSWZ(32 + r32, cb));
                    p0 = __builtin_amdgcn_mfma_f32_32x32x16_bf16(b0, qr[8 + d0], p0, 0, 0, 0);
                    p1 = __builtin_amdgcn_mfma_f32_32x32x16_bf16(b1, qr[8 + d0], p1, 0, 0, 0); }
            }
            if (BAND) {
                const int base = T * 64 - qi + a.side;
#pragma unroll
                for (int r = 0; r < 16; ++r) {
                    const int i0_ = base + crow(r, hi), i1_ = i0_ + 32;
                    const bool ok0 = (unsigned)i0_ <= (unsigned)(2 * a.side), ok1 = (unsigned)i1_ <= (unsigned)(2 * a.side);
                    const float b0 = lut[ok0 ? i0_ : 0], b1 = lut[ok1 ? i1_ : 0];
                    p0[r] = ok0 ? fmaf(p0[r], a.C, b0) : -1e30f; p1[r] = ok1 ? fmaf(p1[r], a.C, b1) : -1e30f;
                }
            } else {
#pragma unroll
                for (int r = 0; r < 16; ++r) { p0[r] *= a.C; p1[r] *= a.C; }
            }
            float pmax = p0[0];
#pragma unroll
            for (int r = 1; r < 16; ++r) pmax = fmaxf(pmax, p0[r]);
#pragma unroll
            for (int r = 0; r < 16; ++r) pmax = fmaxf(pmax, p1[r]);
            { auto rr = __builtin_amdgcn_permlane32_swap(__float_as_uint(pmax), __float_as_uint(pmax), false, false);
              pmax = fmaxf(__uint_as_float(rr[0]), __uint_as_float(rr[1])); }
            const float mn = fmaxf(m_reg, pmax);
            const float alpha = __builtin_amdgcn_exp2f(m_reg - mn);
            m_reg = mn;
            float ps = 0.f;
#pragma unroll
            for (int r = 0; r < 16; ++r) { p0[r] = __builtin_amdgcn_exp2f(p0[r] - mn); p1[r] = __builtin_amdgcn_exp2f(p1[r] - mn); ps += p0[r] + p1[r]; }
            { auto rr = __builtin_amdgcn_permlane32_swap(__float_as_uint(ps), __float_as_uint(ps), false, false);
              ps = __uint_as_float(rr[0]) + __uint_as_float(rr[1]); }
            l_reg = l_reg * alpha + ps;
            if (__any(alpha < 1.f)) {
                if (hi == 0) al_l[r32] = alpha;
                asm volatile("s_waitcnt lgkmcnt(0)" ::: "memory");
#pragma unroll
                for (int r = 0; r < 16; ++r) { const float al = al_l[crow(r, hi)];
#pragma unroll
                    for (int d = 0; d < 4; ++d) o[d][r] *= al; }
            }
            bf16x8 pa0, pa1, pa2, pa3;
#define PK4(P, BASE, OUT) do { unsigned a0 = cvtpk(P[BASE + 0], P[BASE + 1]), a1 = cvtpk(P[BASE + 2], P[BASE + 3]);   \
    unsigned b0 = cvtpk(P[BASE + 4], P[BASE + 5]), b1 = cvtpk(P[BASE + 6], P[BASE + 7]);                              \
    auto r0 = __builtin_amdgcn_permlane32_swap(a0, b0, false, false); auto r1 = __builtin_amdgcn_permlane32_swap(a1, b1, false, false); \
    u32x4 w = {r0[0], r1[0], r0[1], r1[1]}; OUT = *reinterpret_cast<bf16x8*>(&w); } while (0)
            PK4(p0, 0, pa0); PK4(p0, 8, pa1); PK4(p1, 0, pa2); PK4(p1, 8, pa3);
#undef PK4
            pv_one<0>(o[0], vb0, pa0, pa1, pa2, pa3); pv_one<1>(o[1], vb0, pa0, pa1, pa2, pa3);
            pv_one<2>(o[2], vb0, pa0, pa1, pa2, pa3); pv_one<3>(o[3], vb0, pa0, pa1, pa2, pa3);
        }
    }
#undef ALOAD
    if (SINK) l_reg += __builtin_amdgcn_exp2f(a.sink2 - m_reg);
    if (hi == 0) li_l[r32] = l_reg;
    if (WLSE) { if (hi == 0) a.lse[(long)qi * a.ldl] = (m_reg + __builtin_amdgcn_logf(l_reg)) * LN2; }
    asm volatile("s_waitcnt lgkmcnt(0)" ::: "memory");
    bf16_t gv[16][4];
#pragma unroll
    for (int r = 0; r < 16; ++r) {
        const bf16_t* gp = a.G + (long)(a.i0 + wid * 32 + crow(r, hi)) * a.ldg + r32;
#pragma unroll
        for (int d0 = 0; d0 < 4; ++d0) gv[r][d0] = gp[d0 * 32];
    }
#pragma unroll
    for (int r = 0; r < 16; ++r) {
        const int row = crow(r, hi);
        const float rl = __builtin_amdgcn_rcpf(li_l[row]);
        const long i = a.i0 + wid * 32 + row;
        bf16_t* op = a.O + i * a.ldo + r32;
#pragma unroll
        for (int d0 = 0; d0 < 4; ++d0) {
            const float g = bf2f(gv[r][d0]);
            const float sg = g * __builtin_amdgcn_rcpf(1.0f + __builtin_amdgcn_exp2f(-LOG2E * g));
            op[d0 * 32] = (bf16_t)cvtpk(o[d0][r] * rl * sg, 0.f);
        }
    }
}


constexpr int DL_V = 0, DL_K = 32768, DL_P = 65536, DL_WS = 81920;
template <int DQK>
__device__ __forceinline__ void d_qkt(f32x16& p0, f32x16& p1, const lds_u8* Ks, const lds_u8* Ps, const bf16x8* qr, int r32, int hi) {
#pragma unroll
    for (int r = 0; r < 16; ++r) { p0[r] = 0.f; p1[r] = 0.f; }
#pragma unroll
    for (int d0 = 0; d0 < 8; ++d0) { const int cb = (d0 * 16 + hi * 8) * 2;
        const bf16x8 b0 = *(const LAS bf16x8*)(Ks + KSWZ(r32, cb)), b1 = *(const LAS bf16x8*)(Ks + KSWZ(32 + r32, cb));
        p0 = __builtin_amdgcn_mfma_f32_32x32x16_bf16(b0, qr[d0], p0, 0, 0, 0);
        p1 = __builtin_amdgcn_mfma_f32_32x32x16_bf16(b1, qr[d0], p1, 0, 0, 0); }
    if constexpr (DQK == 192) {
#pragma unroll
        for (int d0 = 0; d0 < 4; ++d0) { const int cb = (d0 * 16 + hi * 8) * 2;
            const bf16x8 b0 = *(const LAS bf16x8*)(Ps + PSWZ(r32, cb)), b1 = *(const LAS bf16x8*)(Ps + PSWZ(32 + r32, cb));
            p0 = __builtin_amdgcn_mfma_f32_32x32x16_bf16(b0, qr[8 + d0], p0, 0, 0, 0);
            p1 = __builtin_amdgcn_mfma_f32_32x32x16_bf16(b1, qr[8 + d0], p1, 0, 0, 0); }
    }
}
__device__ __forceinline__ void d_partialSM(f32x16& p0, f32x16& p1, float& m_reg, float& mn, float& alpha, const float C) {
    float pmax = p0[0];
#pragma unroll
    for (int r = 1; r < 16; ++r) pmax = fmaxf(pmax, p0[r]);
#pragma unroll
    for (int r = 0; r < 16; ++r) pmax = fmaxf(pmax, p1[r]);
    { auto rr = __builtin_amdgcn_permlane32_swap(__float_as_uint(pmax), __float_as_uint(pmax), false, false);
      pmax = fmaxf(__uint_as_float(rr[0]), __uint_as_float(rr[1])); }
    if (__builtin_expect(__all((pmax - m_reg) * C <= 8.0f * LOG2E), 1)) { mn = m_reg; alpha = 1.f; }
    else { mn = fmaxf(m_reg, pmax); alpha = __builtin_amdgcn_exp2f((m_reg - mn) * C); m_reg = mn; }
    const float mnC = -mn * C;
#pragma unroll
    for (int r = 0; r < 16; ++r) p0[r] = fmaf(p0[r], C, mnC);
#pragma unroll
    for (int r = 0; r < 16; ++r) p1[r] = fmaf(p1[r], C, mnC);
#pragma unroll
    for (int r = 0; r < 16; ++r) p0[r] = __builtin_amdgcn_exp2f(p0[r]);
}
__device__ __forceinline__ void d_finishSM(f32x16& p0, f32x16& p1, float alpha, float& l_reg, bf16x8& pa0, bf16x8& pa1, bf16x8& pa2, bf16x8& pa3) {
#pragma unroll
    for (int r = 0; r < 16; ++r) p1[r] = __builtin_amdgcn_exp2f(p1[r]);
    float ps = 0;
#pragma unroll
    for (int r = 0; r < 16; ++r) ps += p0[r];
#pragma unroll
    for (int r = 0; r < 16; ++r) ps += p1[r];
    { auto rr = __builtin_amdgcn_permlane32_swap(__float_as_uint(ps), __float_as_uint(ps), false, false);
      ps = __uint_as_float(rr[0]) + __uint_as_float(rr[1]); }
    l_reg = l_reg * alpha + ps;
#define PK4(P, BASE, OUT) do { unsigned a0 = cvtpk(P[BASE + 0], P[BASE + 1]), a1 = cvtpk(P[BASE + 2], P[BASE + 3]);   \
    unsigned b0 = cvtpk(P[BASE + 4], P[BASE + 5]), b1 = cvtpk(P[BASE + 6], P[BASE + 7]);                              \
    auto r0 = __builtin_amdgcn_permlane32_swap(a0, b0, false, false); auto r1 = __builtin_amdgcn_permlane32_swap(a1, b1, false, false); \
    u32x4 w = {r0[0], r1[0], r0[1], r1[1]}; OUT = *reinterpret_cast<bf16x8*>(&w); } while (0)
    PK4(p0, 0, pa0); PK4(p0, 8, pa1); PK4(p1, 0, pa2); PK4(p1, 8, pa3);
#undef PK4
}
__device__ __forceinline__ void d_pv(f32x16* o, int vb, bf16x8 pa0, bf16x8 pa1, bf16x8 pa2, bf16x8 pa3) {
    pv_one<0>(o[0], vb, pa0, pa1, pa2, pa3); pv_one<1>(o[1], vb, pa0, pa1, pa2, pa3); pv_one<2>(o[2], vb, pa0, pa1, pa2, pa3); pv_one<3>(o[3], vb, pa0, pa1, pa2, pa3);
}
#define SBAR() __builtin_amdgcn_sched_barrier(0)

template <int DQK, bool ROPEQ, int SDEPTH>
__device__ __forceinline__ void attn_dense_unit(lds_u8* lds, const AttnArgs& a) {
    constexpr int ND0 = DQK / 16;
    const int tid = pg8::opaque_tid(), wid = tid >> 6, lane = tid & 63, r32 = lane & 31, hi = lane >> 5;
    lds_u8* V_lds = lds + DL_V; lds_u8* K_lds = lds + DL_K; lds_u8* P_lds = lds + DL_P;
    LAS float* wsf = (LAS float*)(lds + DL_WS) + wid * 64; LAS float* li_l = wsf; LAS float* al_l = wsf + 32;
    const float C = a.C;
    __syncthreads();
    const int qi = a.i0 + wid * 32 + r32;
    float m_reg = -1e30f, l_reg = 0.f;
    f32x16 o[4];
#pragma unroll
    for (int d = 0; d < 4; ++d)
#pragma unroll
        for (int r = 0; r < 16; ++r) o[d][r] = 0.f;
    bf16x8 qr[ND0];
    {
        const bf16_t* Qw = a.Q + (long)qi * a.ldq + hi * 8;
#pragma unroll
        for (int d0 = 0; d0 < ND0; ++d0) qr[d0] = *(const bf16x8*)(Qw + d0 * 16);
    }
    if constexpr (ROPEQ) {
#pragma unroll
        for (int dd = 0; dd < 2; ++dd) {
            bf16x8 x1 = qr[8 + dd], x2 = qr[10 + dd];
#pragma unroll
            for (int j = 0; j < 8; ++j) {
                const float2 c = a.cs[qi * 32 + dd * 16 + hi * 8 + j];
                const float f1 = bf2f((bf16_t)x1[j]), f2 = bf2f((bf16_t)x2[j]);
                x1[j] = (short)f2bf(f1 * c.x - f2 * c.y); x2[j] = (short)f2bf(f2 * c.x + f1 * c.y);
            }
            qr[8 + dd] = x1; qr[10 + dd] = x2;
        }
    }
    const int sr = tid >> 4, sc = (tid & 15) * 8, vst0 = v_st(sr, sc), vst1 = v_st(32 + sr, sc), kst0 = KSWZ(sr, sc * 2), kst1 = KSWZ(32 + sr, sc * 2);
    const int pr_ = tid >> 3, pc = (tid & 7) * 8, pst = PSWZ(pr_, pc * 2);
    const int vb0 = (int)(unsigned)(size_t)V_lds + v_rd_base(lane);
    struct { bf16x8 vs0, vs1, ks0, ks1, kp; } sr_[SDEPTH];
#define SLOAD(i, k0) do { sr_[i].vs0 = *(const bf16x8*)(a.V + (long)((k0) + sr) * a.ldv + sc); sr_[i].vs1 = *(const bf16x8*)(a.V + (long)((k0) + 32 + sr) * a.ldv + sc); \
    sr_[i].ks0 = *(const bf16x8*)(a.K + (long)((k0) + sr) * a.ldk + sc); sr_[i].ks1 = *(const bf16x8*)(a.K + (long)((k0) + 32 + sr) * a.ldk + sc); \
    if constexpr (DQK == 192) sr_[i].kp = *(const bf16x8*)(a.K2 + (long)((k0) + pr_) * a.ldk2 + pc); } while (0)
#define SWRITE(b, i) do { *(LAS bf16x8*)(V_lds + (b) * 16384 + vst0) = sr_[i].vs0; *(LAS bf16x8*)(V_lds + (b) * 16384 + vst1) = sr_[i].vs1; \
    *(LAS bf16x8*)(K_lds + (b) * 16384 + kst0) = sr_[i].ks0; *(LAS bf16x8*)(K_lds + (b) * 16384 + kst1) = sr_[i].ks1; \
    if constexpr (DQK == 192) *(LAS bf16x8*)(P_lds + (b) * 8192 + pst) = sr_[i].kp; } while (0)
#define SWAIT() do { if constexpr (SDEPTH == 2) { if constexpr (DQK == 192) asm volatile("s_waitcnt vmcnt(5)" ::: "memory"); else asm volatile("s_waitcnt vmcnt(4)" ::: "memory"); } \
    else asm volatile("s_waitcnt vmcnt(0)" ::: "memory"); } while (0)
#define RESC(al) do { if (__any((al) < 1.f)) { if (hi == 0) al_l[r32] = (al); asm volatile("s_waitcnt lgkmcnt(0)" ::: "memory"); \
    _Pragma("unroll") for (int r = 0; r < 16; ++r) { const float s_ = al_l[crow(r, hi)]; _Pragma("unroll") for (int d = 0; d < 4; ++d) o[d][r] *= s_; } } } while (0)
    f32x16 pA0, pA1, pB0, pB1; float mnA, mnB, alA, alB; bf16x8 pa0, pa1, pa2, pa3; const int NT = a.L / 64;
    constexpr int SE = 0, SO = SDEPTH - 1;
    SLOAD(SE, 0); asm volatile("s_waitcnt vmcnt(0)" ::: "memory"); SWRITE(0, SE); __syncthreads();
    d_qkt<DQK>(pA0, pA1, K_lds, P_lds, qr, r32, hi); d_partialSM(pA0, pA1, m_reg, mnA, alA, C);
    SLOAD(SO, 64); if constexpr (SDEPTH == 2) { if (2 < NT) SLOAD(SE, 128); }
    SWAIT(); SWRITE(1, SO); __syncthreads();
    for (int j = 1; j + 1 < NT; j += 2) {
        SBAR(); d_qkt<DQK>(pB0, pB1, K_lds + 16384, P_lds + 8192, qr, r32, hi);
        d_finishSM(pA0, pA1, alA, l_reg, pa0, pa1, pa2, pa3); SBAR();
        SLOAD(SO, (j + SDEPTH) * 64); SBAR();
        d_pv(o, vb0, pa0, pa1, pa2, pa3); d_partialSM(pB0, pB1, m_reg, mnB, alB, C);
        __syncthreads(); SWAIT(); SWRITE(0, SE);
        RESC(alB); __syncthreads();
        SBAR(); d_qkt<DQK>(pA0, pA1, K_lds, P_lds, qr, r32, hi);
        d_finishSM(pB0, pB1, alB, l_reg, pa0, pa1, pa2, pa3); SBAR();
        if (SDEPTH == 1 || j + 3 < NT) SLOAD(SE, (j + 1 + SDEPTH) * 64); SBAR();
        d_pv(o, vb0 + 16384, pa0, pa1, pa2, pa3); d_partialSM(pA0, pA1, m_reg, mnA, alA, C);
        __syncthreads(); SWAIT(); SWRITE(1, SO);
        RESC(alA); __syncthreads();
    }
    SBAR(); d_qkt<DQK>(pB0, pB1, K_lds + 16384, P_lds + 8192, qr, r32, hi);
    d_finishSM(pA0, pA1, alA, l_reg, pa0, pa1, pa2, pa3); SBAR();
    d_pv(o, vb0, pa0, pa1, pa2, pa3); d_partialSM(pB0, pB1, m_reg, mnB, alB, C);
    __syncthreads(); RESC(alB);
    d_finishSM(pB0, pB1, alB, l_reg, pa0, pa1, pa2, pa3); SBAR();
    d_pv(o, vb0 + 16384, pa0, pa1, pa2, pa3);
#undef SLOAD
#undef SWRITE
#undef SWAIT
#undef RESC
    if (hi == 0) li_l[r32] = l_reg;
    asm volatile("s_waitcnt lgkmcnt(0)" ::: "memory");
    bf16_t gv[16][4];
#pragma unroll
    for (int r = 0; r < 16; ++r) {
        const bf16_t* gp = a.G + (long)(a.i0 + wid * 32 + crow(r, hi)) * a.ldg + r32;
#pragma unroll
        for (int d0 = 0; d0 < 4; ++d0) gv[r][d0] = gp[d0 * 32];
    }
#pragma unroll
    for (int r = 0; r < 16; ++r) {
        const int row = crow(r, hi);
        const float rl = __builtin_amdgcn_rcpf(li_l[row]);
        const long i = a.i0 + wid * 32 + row;
        bf16_t* op = a.O + i * a.ldo + r32;
#pragma unroll
        for (int d0 = 0; d0 < 4; ++d0) {
            const float g = bf2f(gv[r][d0]);
            const float sg = g * __builtin_amdgcn_rcpf(1.0f + __builtin_amdgcn_exp2f(-LOG2E * g));
            op[d0 * 32] = (bf16_t)cvtpk(o[d0][r] * rl * sg, 0.f);
        }
    }
}


constexpr int D3_V = 0, D3_K = 49152, D3_P = 98304, D3_WS = 122880;
template <int DQK, bool ROPEQ>
__device__ __forceinline__ void attn_dense_unit3(lds_u8* lds, const AttnArgs& a) {
    constexpr int ND0 = DQK / 16;
    const int tid = pg8::opaque_tid(), wid = tid >> 6, lane = tid & 63, r32 = lane & 31, hi = lane >> 5;
    lds_u8* V_lds = lds + D3_V; lds_u8* K_lds = lds + D3_K; lds_u8* P_lds = lds + D3_P;
    LAS float* wsf = (LAS float*)(lds + D3_WS) + wid * 64; LAS float* li_l = wsf; LAS float* al_l = wsf + 32;
    const float C = a.C;
    __syncthreads();
    const int qi = a.i0 + wid * 32 + r32;
    float m_reg = -1e30f, l_reg = 0.f;
    f32x16 o[4];
#pragma unroll
    for (int d = 0; d < 4; ++d)
#pragma unroll
        for (int r = 0; r < 16; ++r) o[d][r] = 0.f;
    bf16x8 qr[ND0];
    {
        const bf16_t* Qw = a.Q + (long)qi * a.ldq + hi * 8;
#pragma unroll
        for (int d0 = 0; d0 < ND0; ++d0) qr[d0] = *(const bf16x8*)(Qw + d0 * 16);
    }
    if constexpr (ROPEQ) {
#pragma unroll
        for (int dd = 0; dd < 2; ++dd) {
            bf16x8 x1 = qr[8 + dd], x2 = qr[10 + dd];
#pragma unroll
            for (int j = 0; j < 8; ++j) {
                const float2 c = a.cs[qi * 32 + dd * 16 + hi * 8 + j];
                const float f1 = bf2f((bf16_t)x1[j]), f2 = bf2f((bf16_t)x2[j]);
                x1[j] = (short)f2bf(f1 * c.x - f2 * c.y); x2[j] = (short)f2bf(f2 * c.x + f1 * c.y);
            }
            qr[8 + dd] = x1; qr[10 + dd] = x2;
        }
    }
    const int sr = tid >> 4, sc = (tid & 15) * 8, vst0 = v_st(sr, sc), vst1 = v_st(32 + sr, sc), kst0 = KSWZ(sr, sc * 2), kst1 = KSWZ(32 + sr, sc * 2);
    const int pr_ = tid >> 3, pc = (tid & 7) * 8, pst = PSWZ(pr_, pc * 2);
    const int vb0 = (int)(unsigned)(size_t)V_lds + v_rd_base(lane);
    bf16x8 s_vs0, s_vs1, s_ks0, s_ks1, s_kp;
#define SLOAD(k0) do { s_vs0 = *(const bf16x8*)(a.V + (long)((k0) + sr) * a.ldv + sc); s_vs1 = *(const bf16x8*)(a.V + (long)((k0) + 32 + sr) * a.ldv + sc); \
    s_ks0 = *(const bf16x8*)(a.K + (long)((k0) + sr) * a.ldk + sc); s_ks1 = *(const bf16x8*)(a.K + (long)((k0) + 32 + sr) * a.ldk + sc); \
    if constexpr (DQK == 192) s_kp = *(const bf16x8*)(a.K2 + (long)((k0) + pr_) * a.ldk2 + pc); } while (0)
#define SWRITE(b) do { *(LAS bf16x8*)(V_lds + (b) * 16384 + vst0) = s_vs0; *(LAS bf16x8*)(V_lds + (b) * 16384 + vst1) = s_vs1; \
    *(LAS bf16x8*)(K_lds + (b) * 16384 + kst0) = s_ks0; *(LAS bf16x8*)(K_lds + (b) * 16384 + kst1) = s_ks1; \
    if constexpr (DQK == 192) *(LAS bf16x8*)(P_lds + (b) * 8192 + pst) = s_kp; } while (0)
#define RESC(al) do { if (__any((al) < 1.f)) { if (hi == 0) al_l[r32] = (al); asm volatile("s_waitcnt lgkmcnt(0)" ::: "memory"); \
    _Pragma("unroll") for (int r = 0; r < 16; ++r) { const float s_ = al_l[crow(r, hi)]; _Pragma("unroll") for (int d = 0; d < 4; ++d) o[d][r] *= s_; } } } while (0)
#define ROT() do { bv = bq; bq = bw; bw = (bw == 2) ? 0 : bw + 1; } while (0)
    f32x16 pA0, pA1, pB0, pB1; float mnA, mnB, alA, alB; bf16x8 pa0, pa1, pa2, pa3; const int NT = a.L / 64;
    SLOAD(0); SWRITE(0); SLOAD(64); SWRITE(1); SLOAD(128); __syncthreads();
    d_qkt<DQK>(pA0, pA1, K_lds, P_lds, qr, r32, hi); d_partialSM(pA0, pA1, m_reg, mnA, alA, C);
    int bq = 1, bv = 0, bw = 2;
    for (int j = 1; j + 1 < NT; j += 2) {
        SBAR(); d_qkt<DQK>(pB0, pB1, K_lds + bq * 16384, P_lds + bq * 8192, qr, r32, hi);
        d_finishSM(pA0, pA1, alA, l_reg, pa0, pa1, pa2, pa3); SBAR();
        d_pv(o, vb0 + bv * 16384, pa0, pa1, pa2, pa3); d_partialSM(pB0, pB1, m_reg, mnB, alB, C);
        SWRITE(bw);
        if (j + 2 < NT) SLOAD((j + 2) * 64);
        RESC(alB); __syncthreads(); ROT();
        SBAR(); d_qkt<DQK>(pA0, pA1, K_lds + bq * 16384, P_lds + bq * 8192, qr, r32, hi);
        d_finishSM(pB0, pB1, alB, l_reg, pa0, pa1, pa2, pa3); SBAR();
        d_pv(o, vb0 + bv * 16384, pa0, pa1, pa2, pa3); d_partialSM(pA0, pA1, m_reg, mnA, alA, C);
        if (j + 2 < NT) SWRITE(bw);
        if (j + 3 < NT) SLOAD((j + 3) * 64);
        RESC(alA); __syncthreads(); ROT();
    }
    SBAR(); d_qkt<DQK>(pB0, pB1, K_lds + bq * 16384, P_lds + bq * 8192, qr, r32, hi);
    d_finishSM(pA0, pA1, alA, l_reg, pa0, pa1, pa2, pa3); SBAR();
    d_pv(o, vb0 + bv * 16384, pa0, pa1, pa2, pa3); d_partialSM(pB0, pB1, m_reg, mnB, alB, C);
    RESC(alB);
    d_finishSM(pB0, pB1, alB, l_reg, pa0, pa1, pa2, pa3); SBAR();
    d_pv(o, vb0 + bq * 16384, pa0, pa1, pa2, pa3);
#undef SLOAD
#undef SWRITE
#undef RESC
#undef ROT
    if (hi == 0) li_l[r32] = l_reg;
    asm volatile("s_waitcnt lgkmcnt(0)" ::: "memory");
    bf16_t gv[16][4];
#pragma unroll
    for (int r = 0; r < 16; ++r) {
        const bf16_t* gp = a.G + (long)(a.i0 + wid * 32 + crow(r, hi)) * a.ldg + r32;
#pragma unroll
        for (int d0 = 0; d0 < 4; ++d0) gv[r][d0] = gp[d0 * 32];
    }
#pragma unroll
    for (int r = 0; r < 16; ++r) {
        const int row = crow(r, hi);
        const float rl = __builtin_amdgcn_rcpf(li_l[row]);
        const long i = a.i0 + wid * 32 + row;
        bf16_t* op = a.O + i * a.ldo + r32;
#pragma unroll
        for (int d0 = 0; d0 < 4; ++d0) {
            const float g = bf2f(gv[r][d0]);
            const float sg = g * __builtin_amdgcn_rcpf(1.0f + __builtin_amdgcn_exp2f(-LOG2E * g));
            op[d0 * 32] = (bf16_t)cvtpk(o[d0][r] * rl * sg, 0.f);
        }
    }
}

constexpr int BL_WS = 131072, BL_LUT = 133120, BL_LUTSTRIDE = 260;
constexpr int BL_LUT2 = 65536, BL_LUT2MARGIN = 320, BL_LUT2STRIDE = 960;
struct BandArgs {
    const bf16_t* Q; long ldq;
    const bf16_t* K; const bf16_t* V; long ldk;
    const bf16_t* G; long ldg; bf16_t* O; long ldo;
    float* lse; long ldl;
    const float* bias; const float* sinks;
    int i0, L, side, dil, nt;
    float C;
};
template <int NH, bool SINK, bool WLSE, int PROBE = 0>
__device__ __forceinline__ void attn_band_unit(lds_u8* lds, const BandArgs& a) {
    constexpr int WPH = 8 / NH;
    const int tid = pg8::opaque_tid(), wid = tid >> 6, lane = tid & 63, r32 = lane & 31, hi = lane >> 5;
    const int hw = wid / WPH, rb = wid % WPH;
    LAS float* wsf = (LAS float*)(lds + BL_WS) + wid * 64; LAS float* li_l = wsf; LAS float* al_l = wsf + 32;
    LAS float* lut = (LAS float*)(lds + BL_LUT2) + hw * BL_LUT2STRIDE + BL_LUT2MARGIN;
    const int side = a.side, nlut = 2 * side + 1;
    __syncthreads();
    const int qi = a.i0 + rb * 32 + r32;
    bf16x8 qr[8];
    {
        const bf16_t* Qw = a.Q + hw * 128 + (long)qi * a.ldq + hi * 8;
#pragma unroll
        for (int d0 = 0; d0 < 8; ++d0) qr[d0] = *(const bf16x8*)(Qw + d0 * 16);
    }
    const int t_lo = (a.i0 >= side) ? 0 : (side - a.i0) / 64;
    int t_hi = (a.L - a.i0 + side) / 64; if (t_hi > a.nt) t_hi = a.nt;
    const int lo_w = rb >> 1, hi_w = (rb * 32 + 31 + 2 * side) >> 6;
    const int sr = tid >> 4, sc = (tid & 15) * 8;
    const int vst0 = v_st(sr, sc), vst1 = v_st(32 + sr, sc), kst0 = KSWZ(sr, sc * 2), kst1 = KSWZ(32 + sr, sc * 2);
    const int vbase = (int)(unsigned)(size_t)(lds + 16384) + v_rd_base(lane);
    constexpr int GT = 2;
    bf16x8 st[GT][4];
#define BLOAD(G0) do { _Pragma("unroll") for (int tt = 0; tt < GT; ++tt) { int T_ = (G0) + tt; if (T_ < t_lo) T_ = t_lo; if (T_ > t_hi - 1) T_ = t_hi - 1; \
            const long kb_ = (long)(a.i0 - side + 64 * T_); \
            st[tt][0] = *(const bf16x8*)(a.K + (kb_ + sr) * a.ldk + sc); st[tt][1] = *(const bf16x8*)(a.K + (kb_ + 32 + sr) * a.ldk + sc); \
            st[tt][2] = *(const bf16x8*)(a.V + (kb_ + sr) * a.ldk + sc); st[tt][3] = *(const bf16x8*)(a.V + (kb_ + 32 + sr) * a.ldk + sc); } } while (0)
    float m_reg = -1e29f, l_reg = 0.f;
    f32x16 o[4];
#pragma unroll
    for (int d = 0; d < 4; ++d)
#pragma unroll
        for (int r = 0; r < 16; ++r) o[d][r] = 0.f;
    const int g_lo = (t_lo / GT) * GT;
    BLOAD(g_lo);
    for (int idx = tid; idx < NH * nlut; idx += 512) { const int h = idx / nlut, e = idx - h * nlut;
        ((LAS float*)(lds + BL_LUT2))[h * BL_LUT2STRIDE + BL_LUT2MARGIN + e] = a.bias[rel_bucket((e - side) * a.dil) * 20 + h] * LOG2E; }
    for (int G0 = g_lo; G0 < t_hi; G0 += GT) {
        __syncthreads();
#pragma unroll
        for (int tt = 0; tt < GT; ++tt) {
            *(LAS bf16x8*)(lds + tt * 32768 + kst0) = st[tt][0]; *(LAS bf16x8*)(lds + tt * 32768 + kst1) = st[tt][1];
            *(LAS bf16x8*)(lds + tt * 32768 + 16384 + vst0) = st[tt][2]; *(LAS bf16x8*)(lds + tt * 32768 + 16384 + vst1) = st[tt][3];
        }
        if (G0 + GT < t_hi) BLOAD(G0 + GT);
        __syncthreads();
#pragma unroll 1
        for (int tt = 0; tt < GT; ++tt) {
            const int T = G0 + tt;
            if (T < t_lo || T >= t_hi || T < lo_w || T > hi_w) continue;
            if (PROBE >= 2) { l_reg += ((const LAS float*)(lds + tt * 32768))[tid]; continue; }
            const lds_u8* Kl = lds + tt * 32768; const int vb0 = vbase + tt * 32768;
            f32x16 p0, p1;
#pragma unroll
            for (int r = 0; r < 16; ++r) { p0[r] = 0.f; p1[r] = 0.f; }
#pragma unroll
            for (int d0 = 0; d0 < 8; ++d0) { const int cb = (d0 * 16 + hi * 8) * 2;
                const bf16x8 b0 = *(const LAS bf16x8*)(Kl + KSWZ(r32, cb)), b1 = *(const LAS bf16x8*)(Kl + KSWZ(32 + r32, cb));
                p0 = __builtin_amdgcn_mfma_f32_32x32x16_bf16(b0, qr[d0], p0, 0, 0, 0);
                p1 = __builtin_amdgcn_mfma_f32_32x32x16_bf16(b1, qr[d0], p1, 0, 0, 0); }
            const int base = a.i0 + 64 * T - qi;
            const LAS float* lrow = lut + base + 4 * hi;
            const int wlo = 64 * T - rb * 32 - 31, whi = 64 * T - rb * 32 + 63;
            if (wlo >= 0 && whi <= 2 * side) {
#pragma unroll
                for (int r = 0; r < 16; ++r) { const int c_ = (r & 3) + 8 * (r >> 2);
                    p0[r] = fmaf(p0[r], a.C, lrow[c_]); p1[r] = fmaf(p1[r], a.C, lrow[c_ + 32]); }
            } else {
                const int b0i = base + 4 * hi;
#pragma unroll
                for (int r = 0; r < 16; ++r) { const int c_ = (r & 3) + 8 * (r >> 2);
                    const bool ok0 = (unsigned)(b0i + c_) <= (unsigned)(2 * side), ok1 = (unsigned)(b0i + c_ + 32) <= (unsigned)(2 * side);
                    const float v0 = fmaf(p0[r], a.C, lrow[c_]), v1 = fmaf(p1[r], a.C, lrow[c_ + 32]);
                    p0[r] = ok0 ? v0 : -1e30f; p1[r] = ok1 ? v1 : -1e30f; }
            }
            float pmax = p0[0];
#pragma unroll
            for (int r = 1; r < 16; ++r) pmax = fmaxf(pmax, p0[r]);
#pragma unroll
            for (int r = 0; r < 16; ++r) pmax = fmaxf(pmax, p1[r]);
            { auto rr = __builtin_amdgcn_permlane32_swap(__float_as_uint(pmax), __float_as_uint(pmax), false, false);
              pmax = fmaxf(__uint_as_float(rr[0]), __uint_as_float(rr[1])); }
            const float mn = fmaxf(m_reg, pmax);
            const float alpha = __builtin_amdgcn_exp2f(m_reg - mn);
            m_reg = mn;
            float ps = 0.f;
#pragma unroll
            for (int r = 0; r < 16; ++r) { p0[r] = __builtin_amdgcn_exp2f(p0[r] - mn); p1[r] = __builtin_amdgcn_exp2f(p1[r] - mn); ps += p0[r] + p1[r]; }
            { auto rr = __builtin_amdgcn_permlane32_swap(__float_as_uint(ps), __float_as_uint(ps), false, false);
              ps = __uint_as_float(rr[0]) + __uint_as_float(rr[1]); }
            l_reg = l_reg * alpha + ps;
            if (__any(alpha < 1.f)) {
                if (hi == 0) al_l[r32] = alpha;
                asm volatile("s_waitcnt lgkmcnt(0)" ::: "memory");
#pragma unroll
                for (int r = 0; r < 16; ++r) { const float al = al_l[crow(r, hi)];
#pragma unroll
                    for (int d = 0; d < 4; ++d) o[d][r] *= al; }
            }
            bf16x8 pa0, pa1, pa2, pa3;
#define PK4(P, BASE, OUT) do { unsigned a0 = cvtpk(P[BASE + 0], P[BASE + 1]), a1 = cvtpk(P[BASE + 2], P[BASE + 3]);   \
    unsigned b0 = cvtpk(P[BASE + 4], P[BASE + 5]), b1 = cvtpk(P[BASE + 6], P[BASE + 7]);                              \
    auto r0 = __builtin_amdgcn_permlane32_swap(a0, b0, false, false); auto r1 = __builtin_amdgcn_permlane32_swap(a1, b1, false, false); \
    u32x4 w = {r0[0], r1[0], r0[1], r1[1]}; OUT = *reinterpret_cast<bf16x8*>(&w); } while (0)
            PK4(p0, 0, pa0); PK4(p0, 8, pa1); PK4(p1, 0, pa2); PK4(p1, 8, pa3);
#undef PK4
            pv_one<0>(o[0], vb0, pa0, pa1, pa2, pa3); pv_one<1>(o[1], vb0, pa0, pa1, pa2, pa3);
            pv_one<2>(o[2], vb0, pa0, pa1, pa2, pa3); pv_one<3>(o[3], vb0, pa0, pa1, pa2, pa3);
        }
    }
#undef BLOAD
    if (PROBE >= 1) { float acc_ = l_reg + m_reg; for (int d = 0; d < 4; ++d) for (int r = 0; r < 16; ++r) acc_ += o[d][r]; if (acc_ == 12345.678f) a.O[tid] = 0; return; }
    if (SINK) l_reg += __builtin_amdgcn_exp2f(a.sinks[hw] * LOG2E - m_reg);
    if (hi == 0) li_l[r32] = l_reg;
    if (WLSE) { if (hi == 0) a.lse[hw + (long)qi * a.ldl] = (m_reg + __builtin_amdgcn_logf(l_reg)) * LN2; }
    asm volatile("s_waitcnt lgkmcnt(0)" ::: "memory");
    bf16_t gv[16][4];
#pragma unroll
    for (int r = 0; r < 16; ++r) {
        const bf16_t* gp = a.G + hw * 128 + (long)(a.i0 + rb * 32 + crow(r, hi)) * a.ldg + r32;
#pragma unroll
        for (int d0 = 0; d0 < 4; ++d0) gv[r][d0] = gp[d0 * 32];
    }
#pragma unroll
    for (int r = 0; r < 16; ++r) {
        const int row = crow(r, hi);
        const float rl = __builtin_amdgcn_rcpf(li_l[row]);
        const long i = a.i0 + rb * 32 + row;
        bf16_t* op = a.O + hw * 128 + i * a.ldo + r32;
#pragma unroll
        for (int d0 = 0; d0 < 4; ++d0) {
            const float g = bf2f(gv[r][d0]);
            const float sg = g * __builtin_amdgcn_rcpf(1.0f + __builtin_amdgcn_exp2f(-LOG2E * g));
            op[d0 * 32] = (bf16_t)cvtpk(o[d0][r] * rl * sg, 0.f);
        }
    }
}

__device__ __forceinline__ void attn_phase(lds_u8* lds, const Params& p, int layer, int wg, int nwg) {
    unsigned char* ws = p.ws;
    const bf16_t* proj = (const bf16_t*)(ws + WS_PROJ);
    bf16_t* mixed = (bf16_t*)(ws + WS_MIXED);
    const float2* cs = (const float2*)(ws + WS_CS);
    constexpr int NA = 256, NC = 256, ND = 256, NBU = 384;
    for (int rep = 0; rep < REP_BAND; ++rep)
    for (int it = (rep == 0 ? wg : NA + NC + wg); it < NA + NC + ND + NBU; it += nwg) {
        AttnArgs a; a.lse = nullptr; a.ldl = 0; a.cs = cs; a.side = 0; a.dil = 1; a.bias = p.rel_bias; a.bcol = 0; a.sink2 = 0.f; a.K2 = nullptr; a.ldk2 = 0; a.L = SEQ;
        if (it < NA) {
            #ifdef LINEAR_MAP
            const int c = it, bh = c >> 4, qb = c & 15, b = bh >> 3, h = bh & 7;
#else
            const int c = it, xcd = c & 7, slot = c >> 3, bh = xcd * 2 + (slot >> 4), qb = slot & 15, b = bh >> 3, h = bh & 7;
#endif
            const size_t t0 = (size_t)b * SEQ;
            const bf16_t* qraw = (const bf16_t*)(ws + WS_QRAW); const bf16_t* kvraw = (const bf16_t*)(ws + WS_KVRAW); const bf16_t* kpe = (const bf16_t*)(ws + WS_KPE);
            a.Q = qraw + t0 * 1536 + h * 192; a.ldq = 1536;
            a.K = kvraw + t0 * 2048 + h * 256; a.ldk = 2048; a.K2 = kpe + t0 * 64; a.ldk2 = 64;
            a.V = kvraw + t0 * 2048 + h * 256 + 128; a.ldv = 2048;
            a.G = proj + t0 * NINP + C_GATE + MX_A + h * 128; a.ldg = NINP;
            a.O = mixed + t0 * MIXW + MX_A + h * 128; a.ldo = MIXW;
            a.i0 = qb * 256; a.C = 0.07216878364870322f * LOG2E;
#ifdef SIMPLE_DENSE
            attn_unit<192, false, false, false, true>(lds, a);
#else
            #ifndef DENSE3BUF
            for (int rep = 0; rep < REP_A; ++rep) attn_dense_unit<192, true, 1>(lds, a);
#else
            for (int rep = 0; rep < REP_A; ++rep) attn_dense_unit3<192, true>(lds, a);
#endif
#endif
        } else if (it < NA + NC) {
            #ifdef LINEAR_MAP
            const int c = it - NA, pair = c >> 4, qb = c & 15, b = pair >> 3, hq = pair & 7, hk = hq >> 2;
#else
            const int c = it - NA, xcd = c & 7, slot = c >> 3, pair = xcd * 2 + (slot >> 4), qb = slot & 15, b = pair >> 3, hq = pair & 7, hk = hq >> 2;
#endif
            const size_t t0 = (size_t)b * SEQ;
            const bf16_t* qc = (const bf16_t*)(ws + WS_QC); const bf16_t* kc = (const bf16_t*)(ws + WS_KC);
            a.Q = qc + t0 * 1024 + hq * 128; a.ldq = 1024;
            a.K = kc + t0 * 256 + hk * 128; a.ldk = 256;
            a.V = proj + t0 * NINP + C_CV + hk * 128; a.ldv = NINP;
            a.G = proj + t0 * NINP + C_GATE + MX_C + hq * 128; a.ldg = NINP;
            a.O = mixed + t0 * MIXW + MX_C + hq * 128; a.ldo = MIXW;
            a.i0 = qb * 256; a.C = 0.08838834764831845f * LOG2E;
#ifdef SIMPLE_DENSE
            attn_unit<128, false, false, false, false>(lds, a);
#else
            #ifndef DENSE3BUF
            for (int rep = 0; rep < REP_C; ++rep) attn_dense_unit<128, false, 2>(lds, a);
#else
            for (int rep = 0; rep < REP_C; ++rep) attn_dense_unit3<128, false>(lds, a);
#endif
#endif
        } else if (it < NA + NC + ND) {
            const int c = it - NA - NC, blk = c & 63, hk = (c >> 6) & 1, b = c >> 7;
            const size_t t0 = (size_t)b * SEQ;
            BandArgs d;
            d.Q = proj + t0 * NINP + C_DQ + hk * 512; d.ldq = NINP;
            d.K = proj + t0 * NINP + C_DK + hk * 128; d.V = proj + t0 * NINP + C_DV + hk * 128; d.ldk = NINP;
            d.G = proj + t0 * NINP + C_GATE + MX_D + hk * 512; d.ldg = NINP;
            d.O = mixed + t0 * MIXW + MX_D + hk * 512; d.ldo = MIXW;
            d.lse = nullptr; d.ldl = 0; d.bias = p.rel_bias + 12 + hk * 4; d.sinks = p.sinks + layer * 8 + hk * 4;
            d.i0 = blk * 64; d.L = SEQ; d.side = 128; d.dil = 1; d.nt = 5; d.C = 0.08838834764831845f * LOG2E;
#if defined(PROBE_D)
            attn_band_unit<4, true, false, PROBE_D>(lds, d);
#endif
            for (int rep2 = 0; rep2 < REP_D; ++rep2) attn_band_unit<4, true, false>(lds, d);
        } else {
            const int c = it - NA - NC - ND, u = c & 15, hh = (c >> 4) & 3, j = (c >> 6) % 3, b = c / 192;
            const int dil = (j == 0) ? 1 : (j == 1 ? 4 : 16), L = SEQ / dil, nblk = L / 256, r = u / nblk, qb = u % nblk;
            const size_t t0 = (size_t)b * SEQ + r; const int head = j * 4 + hh;
            BandArgs d;
            d.Q = proj + t0 * NINP + C_BQ + head * 128; d.ldq = (long)dil * NINP;
            d.K = proj + t0 * NINP + C_BK + head * 128; d.V = proj + t0 * NINP + C_BV + head * 128; d.ldk = (long)dil * NINP;
            d.G = proj + t0 * NINP + C_GATE + MX_B + head * 128; d.ldg = (long)dil * NINP;
            d.O = mixed + t0 * MIXW + MX_B + head * 128; d.ldo = (long)dil * MIXW;
            d.lse = (float*)(ws + WS_LSE) + ((size_t)j * MTOK + t0) * 4 + hh; d.ldl = (long)dil * 4;
            d.bias = p.rel_bias + head; d.sinks = nullptr;
            d.i0 = qb * 256; d.L = L; d.side = 64; d.dil = dil; d.nt = 6; d.C = 0.08838834764831845f * LOG2E;
            for (int rep2 = 0; rep2 < REP_B; ++rep2) attn_band_unit<1, false, true>(lds, d);
        }
    }
}

#define XB_TMO      128
#define XB_XCNT(j)  (256  + 64 * (j))
#define XB_XSUB(j)  (1280 + 64 * (j))
#define XB_XGEN(j)  (2304 + 64 * (j))
#define XB_TOP      3328
#define XB_TOPGEN   3392
#define XCD_BAR_WORDS 3456
#define XB_SPIN_CAP (1u << 18)

__device__ __forceinline__ unsigned xb_ld(unsigned* p)              { return __hip_atomic_load(p, __ATOMIC_RELAXED, __HIP_MEMORY_SCOPE_AGENT); }
__device__ __forceinline__ unsigned xb_add(unsigned* p, unsigned v) { return __hip_atomic_fetch_add(p, v, __ATOMIC_RELAXED, __HIP_MEMORY_SCOPE_AGENT); }
__device__ __forceinline__ unsigned xb_xcc_id() { return (unsigned)__builtin_amdgcn_s_getreg((3 << 11) | 20) & 0xFu; }
#define XB_SPIN(cond, bar) do { unsigned _sp = 0; while (cond) { __builtin_amdgcn_s_sleep(1); \
    if ((++_sp & 255u) == 0u) { if (xb_ld(&(bar)[XB_TMO])) break; if (_sp > XB_SPIN_CAP) { atomicAdd(&(bar)[XB_TMO], 1u); break; } } } } while (0)

struct XcdBarrier {
    unsigned* bar; unsigned x;
    volatile LAS unsigned* st;
};

__device__ __forceinline__ XcdBarrier xcd_barrier_post(unsigned* bar, volatile LAS unsigned* st) {
    XcdBarrier b; b.bar = bar; b.x = xb_xcc_id(); b.st = st;
    if (threadIdx.x == 0) (void)xb_add(&bar[XB_XCNT(b.x)], 1u);
    return b;
}
__device__ __forceinline__ void xcd_barrier_complete(unsigned* bar, unsigned x, unsigned& nloc, unsigned& nx) {
    const unsigned G = gridDim.x * gridDim.y * gridDim.z;
    unsigned sum, cnt, mine, sp = 0u;
    for (;;) {
        sum = 0u; cnt = 0u; mine = 0u;
#pragma unroll
        for (unsigned j = 0; j < 16; ++j) { const unsigned c = xb_ld(&bar[XB_XCNT(j)]); sum += c; cnt += (c > 0u) ? 1u : 0u; mine = (j == x) ? c : mine; }
        if (sum == G) break;
        __builtin_amdgcn_s_sleep(1);
        if ((++sp & 255u) == 0u) { if (xb_ld(&bar[XB_TMO])) break; if (sp > XB_SPIN_CAP) { atomicAdd(&bar[XB_TMO], 1u); break; } }
    }
    nloc = mine > 0u ? mine : 1u; nx = cnt > 0u ? cnt : 1u;
}

__device__ __forceinline__ void xcd_barrier(const XcdBarrier& b) {
    asm volatile("s_waitcnt vmcnt(0)" ::: "memory");
    __syncthreads();
    if (threadIdx.x == 0) {
        unsigned* bar = b.bar;
        __builtin_amdgcn_s_waitcnt(0);
        unsigned nloc = b.st[0], nx = b.st[1];
        if (nloc == 0u) { xcd_barrier_complete(bar, b.x, nloc, nx); b.st[0] = nloc; b.st[1] = nx; }
        const unsigned old = xb_add(&bar[XB_XSUB(b.x)], 1u);
        const unsigned gen = old / nloc;
        if (old + 1u == (gen + 1u) * nloc) {
            __builtin_amdgcn_fence(__ATOMIC_RELEASE, "agent");
            asm volatile("s_waitcnt vmcnt(0)" ::: "memory");
            const unsigned og = xb_add(&bar[XB_TOP], 1u);
            const unsigned tg = og / nx;
            if (og + 1u == (tg + 1u) * nx) xb_add(&bar[XB_TOPGEN], 1u);
            else XB_SPIN(xb_ld(&bar[XB_TOPGEN]) == tg, bar);
            __builtin_amdgcn_fence(__ATOMIC_ACQUIRE, "agent");
            xb_add(&bar[XB_XGEN(b.x)], 1u);
            asm volatile("s_waitcnt vmcnt(0)" ::: "memory");
        } else {
            XB_SPIN(xb_ld(&bar[XB_XGEN(b.x)]) == gen, bar);
            __builtin_amdgcn_fence(__ATOMIC_ACQUIRE, "agent");
            asm volatile("s_waitcnt vmcnt(0)" ::: "memory");
        }
    }
    __syncthreads();
}

__global__ void __launch_bounds__(512) hymba_fwd(Params p0) {
    extern __shared__ __attribute__((aligned(16))) unsigned char shm[];
    lds_u8* lds = (lds_u8*)shm;
    cg::grid_group grid = cg::this_grid();
    const int wg0 = blockIdx.x, nwg0 = gridDim.x;
    const int lo = p0.ph_lo, hi = p0.ph_hi;
    if (lo < 0) grid.sync();
    volatile LAS unsigned* bst = (volatile LAS unsigned*)(lds + LDS_BYTES - 256);
    if (threadIdx.x == 0) { bst[0] = 0u; bst[1] = 0u; }
    __syncthreads();
    XcdBarrier xbar = xcd_barrier_post((unsigned*)(p0.ws + WS_BAR), bst);
    int ph = 0;
#define PH_BEGIN if (lo <= ph && ph < hi) { auto kp4 = (__attribute__((address_space(4))) const char*)__builtin_amdgcn_kernarg_segment_ptr(); asm volatile("" : "+s"(kp4)); \
    const Params& p = *(const Params*)kp4; unsigned char* ws = p.ws; int wg = wg0, nwg = nwg0; asm volatile("" : "+s"(wg), "+s"(nwg)); \
    bf16_t* WinT = (bf16_t*)(ws + WS_WIN); bf16_t* WoutT = (bf16_t*)(ws + WS_WOUT); bf16_t* WuqT = (bf16_t*)(ws + WS_WUQ); bf16_t* WukvT = (bf16_t*)(ws + WS_WUKV); \
    bf16_t* H = (bf16_t*)(ws + WS_H); bf16_t* PROJ = (bf16_t*)(ws + WS_PROJ); float* X1 = (float*)(ws + WS_X1); \
    bf16_t* QAN = (bf16_t*)(ws + WS_QAN); bf16_t* KVAN = (bf16_t*)(ws + WS_KVAN); bf16_t* KPE = (bf16_t*)(ws + WS_KPE); \
    bf16_t* QRAW = (bf16_t*)(ws + WS_QRAW); bf16_t* KVRAW = (bf16_t*)(ws + WS_KVRAW); bf16_t* QC = (bf16_t*)(ws + WS_QC); bf16_t* KC = (bf16_t*)(ws + WS_KC); \
    bf16_t* MIXED = (bf16_t*)(ws + WS_MIXED); bf16_t* DELTA = (bf16_t*)(ws + WS_DELTA); (void)DELTA; float* LSE = (float*)(ws + WS_LSE); float2* CS = (float2*)(ws + WS_CS); \
    (void)WinT; (void)WoutT; (void)WuqT; (void)WukvT; (void)H; (void)PROJ; (void)X1; (void)QAN; (void)KVAN; (void)KPE; (void)QRAW; (void)KVRAW; (void)QC; (void)KC; (void)MIXED; (void)LSE; (void)CS;
#define PH_END } if (lo <= ph && ph + 1 < hi) xcd_barrier(xbar); ++ph;

    PH_BEGIN
        for (int l = 1; l >= 0; --l) {
            cvt_transpose(p.w_out + (size_t)l * MIXW * DM, WoutT + (size_t)l * DM * MIXW, MIXW, DM, DM, lds, wg, nwg);
            cvt_transpose(p.w_ukv + (size_t)l * 512 * 2048, WukvT + (size_t)l * 2048 * 512, 512, 2048, 2048, lds, wg, nwg);
            cvt_transpose(p.w_uq + (size_t)l * 768 * 1536, WuqT + (size_t)l * 1536 * 768, 768, 1536, 1536, lds, wg, nwg);
            cvt_transpose(p.w_in + (size_t)l * DM * NIN, WinT + (size_t)l * NINP * DM, DM, NIN, NINP, lds, wg, nwg);
        }
        build_cs(CS, wg, nwg);
        rmsnorm_rows<0, true>(p.x, nullptr, nullptr, p.g_attn, H, nullptr, wg, nwg);
    PH_END

#pragma unroll 1
    for (int l = 0; l < 2; ++l) {
        if (l > 0) {
            PH_BEGIN
                rmsnorm_rows<1, true>(p.x, DELTA, nullptr, p.g_attn + (size_t)l * DM, H, nullptr, wg, nwg);
            PH_END
        }
        PH_BEGIN
#ifndef NO_GEMM
            pg8::Gemm g{H, WinT + (size_t)l * NINP * DM, MTOK, NINP, DM}; pg8::RevColOrder S; S.init(MTOK, NINP, nwg, wg);
            pg8::EpiBf16P E{PROJ, NINP};
            for (int rep = 0; rep < REP_GEMM; ++rep)
            pg8::gemm_phase<pg8::EpiBf16P, pg8::RevColOrder, GEMM_ALIGN, GEMM_SP2>(lds, g, S, E);
            if (CVT_P0_LAYERS == 1 && l == 0 && nwg == 256 && wg >= 192)
                cvt_transpose(p.w_in + (size_t)DM * NIN, WinT + (size_t)NINP * DM, DM, NIN, NINP, lds, wg - 192, 64);
#endif
        PH_END
        PH_BEGIN
            for (int rep = 0; rep < REP_MISC; ++rep) prep_tokens(PROJ, p.g_qa + l * 768, p.g_kva + l * 512, p.g_qn + l * 128, p.g_kn + l * 128, CS, QAN, KVAN, KPE, QC, KC, (bf16_t*)(ws + WS_DKV), wg, nwg);
        PH_END
        PH_BEGIN
#ifndef NO_GEMM
            for (int rep = 0; rep < REP_UP; ++rep) {
            { pg8::Gemm g{QAN, WuqT + (size_t)l * 1536 * 768, MTOK, 1536, 768}; pg8::StaticOrder S; S.init(MTOK, 1536, nwg, wg);
              pg8::EpiBf16P E{QRAW, 1536};
              pg8::gemm_phase<pg8::EpiBf16P, pg8::StaticOrder, GEMM_ALIGN, GEMM_SP2>(lds, g, S, E); }
            { pg8::Gemm g{KVAN, WukvT + (size_t)l * 2048 * 512, MTOK, 2048, 512}; pg8::StaticOrder S; S.init(MTOK, 2048, nwg, nwg - 1 - wg);
              pg8::EpiBf16P E{KVRAW, 2048};
              pg8::gemm_phase<pg8::EpiBf16P, pg8::StaticOrder, GEMM_ALIGN, GEMM_SP2>(lds, g, S, E); }
            }
#endif
        PH_END
        PH_BEGIN
#ifndef NO_ATTN
            for (int rep = 0; rep < REP_ATTN; ++rep) attn_phase(lds, p, l, wg, nwg);
            if ((CVT_P0_LAYERS == 1 || HIDE_TAIL) && l == 0 && nwg == 256 && wg >= 128) {
                cvt_transpose(p.w_out + (size_t)MIXW * DM, WoutT + (size_t)DM * MIXW, MIXW, DM, DM, lds, wg - 128, 128);
                cvt_transpose(p.w_uq + (size_t)768 * 1536, WuqT + (size_t)1536 * 768, 768, 1536, 1536, lds, wg - 128, 128);
                cvt_transpose(p.w_ukv + (size_t)512 * 2048, WukvT + (size_t)2048 * 512, 512, 2048, 2048, lds, wg - 128, 128);
            }
#endif
        PH_END
        PH_BEGIN
            fixup_b(MIXED, LSE, wg, nwg);
        PH_END
        PH_BEGIN
#ifndef NO_GEMM
            pg8::Gemm g{MIXED, WoutT + (size_t)l * DM * MIXW, MTOK, DM, MIXW}; pg8::StaticOrder S; S.init(MTOK, DM, nwg, wg);
            pg8::EpiBf16P E{DELTA + (size_t)l * MTOK * DM, DM};
            for (int rep = 0; rep < REP_OUT; ++rep)
            pg8::gemm_phase<pg8::EpiBf16P, pg8::StaticOrder, GEMM_ALIGN, GEMM_SP2>(lds, g, S, E);
#endif
        PH_END
    }
    for (int rep = 0; rep < REP_SYNC; ++rep) xcd_barrier(xbar);
    PH_BEGIN
        rmsnorm_rows<2, false>(p.x, DELTA, DELTA + (size_t)MTOK * DM, p.g_final, nullptr, p.out, wg, nwg);
    PH_END
#undef PH_BEGIN
#undef PH_END
}

constexpr int N_PHASES = 15;

extern "C" void kernel_launch(void* const* d_in, const int* in_sizes, int n_in, void* d_out, int out_size, void* d_ws, size_t ws_size, hipStream_t stream) {
    static int grid_blocks = 0;
    if (grid_blocks == 0) {
        if (n_in != 13 || ws_size < WS_END || out_size != MTOK * DM) { fprintf(stderr, "kernel_launch: unexpected shapes (n_in %d, out %d, ws %zu, need %zu)\n", n_in, out_size, ws_size, (size_t)WS_END); grid_blocks = -1; return; }
        int dev = 0, cus = 0, per_cu = 0;
        hipGetDevice(&dev);
        hipDeviceGetAttribute(&cus, hipDeviceAttributeMultiprocessorCount, dev);
        if (hipFuncSetAttribute((const void*)hymba_fwd, hipFuncAttributeMaxDynamicSharedMemorySize, LDS_BYTES) != hipSuccess) { fprintf(stderr, "kernel_launch: hipFuncSetAttribute failed\n"); grid_blocks = -1; return; }
        if (hipOccupancyMaxActiveBlocksPerMultiprocessor(&per_cu, (const void*)hymba_fwd, 512, LDS_BYTES) != hipSuccess || per_cu < 1) { fprintf(stderr, "kernel_launch: occupancy query gave %d\n", per_cu); per_cu = 1; }
        (void)hipGetLastError();
        grid_blocks = cus * 1;
        fprintf(stderr, "kernel_launch: cus %d per_cu %d grid %d\n", cus, per_cu, grid_blocks);
    }
    if (grid_blocks < 0) return;
    Params p{};
    p.x = (const float*)d_in[0]; p.g_attn = (const float*)d_in[1]; p.w_in = (const float*)d_in[2]; p.g_qa = (const float*)d_in[3]; p.g_kva = (const float*)d_in[4];
    p.w_uq = (const float*)d_in[5]; p.w_ukv = (const float*)d_in[6]; p.g_qn = (const float*)d_in[7]; p.g_kn = (const float*)d_in[8]; p.sinks = (const float*)d_in[9];
    p.w_out = (const float*)d_in[10]; p.rel_bias = (const float*)d_in[11]; p.g_final = (const float*)d_in[12];
    p.out = (float*)d_out; p.ws = (unsigned char*)d_ws;
#if defined(MULTI_LAUNCH)
    for (int k = 0; k < N_PHASES; ++k) { p.ph_lo = k; p.ph_hi = k + 1; hipLaunchKernelGGL(hymba_fwd, dim3(grid_blocks), dim3(512), LDS_BYTES, stream, p); }
#else
    p.ph_lo = 0; p.ph_hi = N_PHASES;
    if (hipMemsetAsync((char*)d_ws + WS_BAR, 0, 3456 * 4, stream) != hipSuccess) { fprintf(stderr, "kernel_launch: memset of the barrier words failed\n"); return; }
    void* args[] = {&p};
    hipError_t e = hipLaunchCooperativeKernel((const void*)hymba_fwd, dim3(grid_blocks), dim3(512), args, LDS_BYTES, stream);
    if (e != hipSuccess) fprintf(stderr, "cooperative launch failed: %s (grid %d)\n", hipGetErrorString(e), grid_blocks);
#endif
}
```

```cpp
#include <hip/hip_runtime.h>
#include <hip/hip_cooperative_groups.h>
#include <cstdio>
namespace cg = cooperative_groups;
namespace pg8 {
#define PG8_LAS __attribute__((address_space(3)))
typedef unsigned short bf16_t;
__device__ __forceinline__ int opaque_tid() { int t = threadIdx.x; asm volatile("" : "+v"(t)); return t; }
typedef short bf16x8 __attribute__((ext_vector_type(8)));
typedef float f32x4 __attribute__((ext_vector_type(4)));
typedef unsigned u32x4 __attribute__((ext_vector_type(4)));
constexpr int BM = 256, BK = 64, HALF = 128, HTB = HALF * BK * 2  , STAGE_BYTES = 8 * HTB, NXCD = 8, WGM = 8;

__host__ __device__ __forceinline__ int lds_byte(int r, int c) { const int st = (r >> 4) * 2 + (c >> 5), rr = r & 15, cc = c & 31, ob = rr * 64 + cc * 2; return st * 1024 + (ob ^ (((ob >> 9) & 1) << 5)); }
__host__ __device__ __forceinline__ void stage_rc(int b, int& R, int& C) { const int st = b / 1024, sb = b % 1024, swz = sb ^ (((sb >> 9) & 1) << 5); R = (st >> 1) * 16 + swz / 64; C = (st & 1) * 32 + (swz % 64) / 2; }
__host__ __device__ __forceinline__ int perm32(int rho) { const int n = rho >> 4, i = rho & 15; return 8 * (i >> 2) + 4 * n + (i & 3); }

struct Unit { int pm, pn; };
struct Gemm { const bf16_t* A; const bf16_t* Bt; int M, N, K; };
struct StaticOrder {
    int nM, nN, nwg, G, c;
    __host__ __device__ void init(int M, int N, int G_, int c_) { nM = M / BM; nN = N / BM; nwg = nM * nN; G = G_; c = c_; }
    __host__ __device__ bool next(int i, Unit& u) const {
        const long L = (long)i * G + c; if (L >= nwg) return false;
        int wgid = (int)L; { const int q = nwg / NXCD, r = nwg % NXCD, xcd = wgid % NXCD, off = wgid / NXCD; wgid = (xcd < r ? xcd * (q + 1) : r * (q + 1) + (xcd - r) * q) + off; }
        const int nig = WGM * nN, gid = wgid / nig, fm = gid * WGM, gsz = (nM - fm) < WGM ? (nM - fm) : WGM;
        u.pm = fm + ((wgid % nig) % gsz); u.pn = (wgid % nig) / gsz; return true;
    }
    __device__ __forceinline__ void a_ready(const Unit&) const {}
    __device__ __forceinline__ void done(const Unit&) const {}
};
struct RevColOrder : StaticOrder {
    __host__ __device__ bool next(int i, Unit& u) const { const bool r = StaticOrder::next(i, u); if (r) u.pn = nN - 1 - u.pn; return r; }
};
__device__ __forceinline__ unsigned cvt_pk_bf16(float lo, float hi) { unsigned r; asm volatile("v_cvt_pk_bf16_f32 %0, %1, %2" : "=v"(r) : "v"(lo), "v"(hi)); return r; }
typedef float f32x2 __attribute__((ext_vector_type(2)));
struct EpiBf16P {
    static constexpr bool PERM = true, AFTER_DRAIN = false;
    bf16_t* O; int ldc;
    __device__ __forceinline__ void operator()(const f32x4 (&acc)[2][2][4][2], const Unit& u, int wr, int wc, int fr, int fq) const {
        const int row0 = u.pm * BM + wr * 64 + fr; const int col0 = u.pn * BM + wc * 32 + 8 * fq;
#pragma unroll
        for (int ai = 0; ai < 2; ++ai)
#pragma unroll
            for (int m = 0; m < 4; ++m) { bf16_t* rowp = O + (size_t)(row0 + ai * HALF + m * 16) * ldc + col0;
#pragma unroll
                for (int bj = 0; bj < 2; ++bj) { const f32x4 v0 = acc[ai][bj][m][0], v1 = acc[ai][bj][m][1];
                    u32x4 w; w.x = cvt_pk_bf16(v0[0], v0[1]); w.y = cvt_pk_bf16(v0[2], v0[3]); w.z = cvt_pk_bf16(v1[0], v1[1]); w.w = cvt_pk_bf16(v1[2], v1[3]);
                    *(u32x4*)(rowp + bj * HALF) = w; } }
    }
};
struct EpiResF32 {
    static constexpr bool PERM = false, AFTER_DRAIN = false;
    const float* base; float* out; int ldc;
    __device__ __forceinline__ void operator()(const f32x4 (&acc)[2][2][4][2], const Unit& u, int wr, int wc, int fr, int fq) const {
        const int row0 = u.pm * BM + wr * 64 + fr, col0 = u.pn * BM + wc * 32 + 4 * fq;
#pragma unroll
        for (int ai = 0; ai < 2; ++ai)
#pragma unroll
            for (int m = 0; m < 4; ++m) { const size_t off = (size_t)(row0 + ai * HALF + m * 16) * ldc + col0;
#pragma unroll
                for (int bj = 0; bj < 2; ++bj)
#pragma unroll
                    for (int n = 0; n < 2; ++n) { const f32x4 b = *(const f32x4*)(base + off + bj * HALF + n * 16); *(f32x4*)(out + off + bj * HALF + n * 16) = acc[ai][bj][m][n] + b; } }
    }
};
template <class Epi, class Sched, bool ALIGN_EPI = false, bool SP2 = false>
__device__ __forceinline__ void gemm_phase(PG8_LAS unsigned char* lds, const Gemm g, const Sched& S, const Epi& E) {
    const int tid = opaque_tid(), wid = __builtin_amdgcn_readfirstlane(tid >> 6), lane = tid & 63, wr = wid >> 2, wc = wid & 3, fr = lane & 15, fq = lane >> 4;
    const int K = g.K, nt = K / BK;
    unsigned voffA[2], voffB[2];
#pragma unroll
    for (int i = 0; i < 2; ++i) { int R, C; stage_rc(tid * 16 + i * 8192, R, C); const int Rb = Epi::PERM ? ((R & ~31) + perm32(R & 31)) : R;
        voffA[i] = (unsigned)(R * K + C) * 2u; voffB[i] = (unsigned)(Rb * K + C) * 2u; }
    const size_t kstep = (size_t)(BK * 2);
    const size_t hstep = (size_t)HALF * K * 2;
    const size_t tstep = 2 * hstep;
    const unsigned ldsw = (unsigned)wid * 1024u;
    const int aoff = lds_byte(wr * 64 + fr, fq * 8), boff = lds_byte(wc * 32 + fr, fq * 8);
#define PG8_SA(b, h) (((b) * 2 + (h)) * HTB)
#define PG8_SB(b, h) ((4 + (b) * 2 + (h)) * HTB)
#define PG8_STAGE(bufoff, gbase, voff) do { _Pragma("unroll") for (int _i = 0; _i < 2; ++_i) \
        __builtin_amdgcn_global_load_lds((const unsigned*)((const char*)(gbase) + (voff)[_i]), (PG8_LAS unsigned*)(lds + (bufoff) + ldsw + _i * 8192), 16, 0, 0); } while (0)
#define PG8_LDA(dst, b, h) do { _Pragma("unroll") for (int m = 0; m < 4; ++m) _Pragma("unroll") for (int k = 0; k < 2; ++k) dst[m][k] = *(const PG8_LAS bf16x8*)(lds + PG8_SA(b, h) + aoff + m * 2048 + k * 1024); } while (0)
#define PG8_LDB(dst, b, h) do { _Pragma("unroll") for (int n = 0; n < 2; ++n) _Pragma("unroll") for (int k = 0; k < 2; ++k) dst[n][k] = *(const PG8_LAS bf16x8*)(lds + PG8_SB(b, h) + boff + n * 2048 + k * 1024); } while (0)
#define PG8_MMA(ai, bj, At, Bt) do { __builtin_amdgcn_s_setprio(1); _Pragma("unroll") for (int m = 0; m < 4; ++m) _Pragma("unroll") for (int n = 0; n < 2; ++n) _Pragma("unroll") for (int k = 0; k < 2; ++k) \
        acc[ai][bj][m][n] = __builtin_amdgcn_mfma_f32_16x16x32_bf16(Bt[n][k], At[m][k], acc[ai][bj][m][n], 0, 0, 0); __builtin_amdgcn_s_setprio(0); } while (0)
#define PG8_WAIT_V(n) asm volatile("s_waitcnt vmcnt(" #n ")" ::: "memory")
#define PG8_WAIT_L(n) asm volatile("s_waitcnt lgkmcnt(" #n ")" ::: "memory")
#define PG8_BAR __builtin_amdgcn_s_barrier()
#define PG8_SCHED __builtin_amdgcn_sched_barrier(0)
    Unit cur, nxt; int ui = 0;
    if (!S.next(0, cur)) return;
    f32x4 acc[2][2][4][2];
#pragma unroll
    for (int a = 0; a < 2; ++a)
#pragma unroll
        for (int b = 0; b < 2; ++b)
#pragma unroll
            for (int m = 0; m < 4; ++m)
#pragma unroll
                for (int n = 0; n < 2; ++n) acc[a][b][m][n] = (f32x4){0.f, 0.f, 0.f, 0.f};
    bf16x8 At[4][2], B0[2][2], B1[2][2];
    const char* cA = (const char*)g.A + (size_t)cur.pm * tstep; const char* cB = (const char*)g.Bt + (size_t)cur.pn * tstep;
    S.a_ready(cur);
    if constexpr (SP2) {
        PG8_STAGE(PG8_SB(0, 0), cB, voffB); PG8_STAGE(PG8_SB(0, 1), cB + hstep, voffB); PG8_STAGE(PG8_SA(0, 0), cA, voffA); PG8_STAGE(PG8_SA(0, 1), cA + hstep, voffA);
        if (wr == 1) PG8_BAR;
        PG8_WAIT_V(2); PG8_BAR;
        PG8_STAGE(PG8_SB(1, 0), cB + kstep, voffB); PG8_STAGE(PG8_SA(1, 0), cA + kstep, voffA); PG8_STAGE(PG8_SB(1, 1), cB + hstep + kstep, voffB);
        PG8_WAIT_V(6); PG8_BAR;
    } else {
        PG8_STAGE(PG8_SB(0, 0), cB, voffB); PG8_STAGE(PG8_SA(0, 0), cA, voffA); PG8_STAGE(PG8_SB(0, 1), cB + hstep, voffB); PG8_STAGE(PG8_SA(0, 1), cA + hstep, voffA);
        if (wr == 1) PG8_BAR;
        PG8_WAIT_V(4); PG8_BAR;
        PG8_STAGE(PG8_SB(1, 0), cB + kstep, voffB); PG8_STAGE(PG8_SA(1, 0), cA + kstep, voffA); PG8_STAGE(PG8_SB(1, 1), cB + hstep + kstep, voffB);
        PG8_WAIT_V(6); PG8_BAR;
    }
    for (;;) {
        const bool has_next = S.next(ui + 1, nxt);
        const char* nA = has_next ? (const char*)g.A + (size_t)nxt.pm * tstep : cA; const char* nB = has_next ? (const char*)g.Bt + (size_t)nxt.pn * tstep : cB;
        for (int t = 0; t < nt; t += 2) {
            const bool last = (t == nt - 2);
            const char* a1 = cA + (size_t)(t + 1) * kstep;
            const char* a2 = last ? nA : cA + (size_t)(t + 2) * kstep; const char* b2 = last ? nB : cB + (size_t)(t + 2) * kstep;
            const char* a3 = a2 + kstep; const char* b3 = b2 + kstep;
            if (last && has_next) S.a_ready(nxt);
            if constexpr (SP2) {
            PG8_LDB(B0, 0, 0); PG8_LDB(B1, 0, 1); PG8_SCHED; PG8_LDA(At, 0, 0); PG8_STAGE(PG8_SA(1, 1), a1 + hstep, voffA);
            PG8_WAIT_V(8); PG8_WAIT_L(0); PG8_BAR; PG8_MMA(0, 0, At, B0); PG8_MMA(0, 1, At, B1); PG8_BAR; PG8_SCHED;
            PG8_LDA(At, 0, 1); PG8_STAGE(PG8_SB(0, 0), b2, voffB); PG8_STAGE(PG8_SB(0, 1), b2 + hstep, voffB); PG8_STAGE(PG8_SA(0, 0), a2, voffA);
            PG8_WAIT_V(8); PG8_WAIT_L(0); PG8_BAR; PG8_MMA(1, 0, At, B0); PG8_MMA(1, 1, At, B1); PG8_BAR; PG8_SCHED;
            PG8_LDB(B0, 1, 0); PG8_LDB(B1, 1, 1); PG8_SCHED; PG8_LDA(At, 1, 0); PG8_STAGE(PG8_SA(0, 1), a2 + hstep, voffA);
            PG8_WAIT_V(8); PG8_WAIT_L(0); PG8_BAR; PG8_MMA(0, 0, At, B0); PG8_MMA(0, 1, At, B1); PG8_BAR; PG8_SCHED;
            PG8_LDA(At, 1, 1); PG8_STAGE(PG8_SB(1, 0), b3, voffB); PG8_STAGE(PG8_SB(1, 1), b3 + hstep, voffB); PG8_STAGE(PG8_SA(1, 0), a3, voffA);
            PG8_WAIT_V(8); PG8_WAIT_L(0); PG8_BAR; PG8_MMA(1, 0, At, B0); PG8_MMA(1, 1, At, B1); PG8_BAR; PG8_SCHED;
            } else {
            PG8_LDB(B0, 0, 0); PG8_SCHED; PG8_LDA(At, 0, 0); PG8_STAGE(PG8_SA(1, 1), a1 + hstep, voffA);
            PG8_WAIT_L(8); PG8_BAR; PG8_WAIT_L(0); PG8_MMA(0, 0, At, B0); PG8_BAR; PG8_SCHED;
            PG8_LDB(B1, 0, 1); PG8_STAGE(PG8_SB(0, 0), b2, voffB);
            PG8_BAR; PG8_WAIT_L(0); PG8_MMA(0, 1, At, B1); PG8_BAR;
            PG8_LDA(At, 0, 1); PG8_STAGE(PG8_SA(0, 0), a2, voffA);
            PG8_BAR; PG8_WAIT_L(0); PG8_MMA(1, 0, At, B0); PG8_BAR; PG8_SCHED;
            PG8_STAGE(PG8_SB(0, 1), b2 + hstep, voffB);
            PG8_WAIT_V(6); PG8_BAR; PG8_MMA(1, 1, At, B1); PG8_BAR;
            PG8_LDB(B0, 1, 0); PG8_SCHED; PG8_LDA(At, 1, 0); PG8_STAGE(PG8_SA(0, 1), a2 + hstep, voffA);
            PG8_WAIT_L(8); PG8_BAR; PG8_WAIT_L(0); PG8_MMA(0, 0, At, B0); PG8_BAR; PG8_SCHED;
            PG8_LDB(B1, 1, 1); PG8_STAGE(PG8_SB(1, 0), b3, voffB);
            PG8_BAR; PG8_WAIT_L(0); PG8_MMA(0, 1, At, B1); PG8_BAR;
            PG8_LDA(At, 1, 1); PG8_STAGE(PG8_SA(1, 0), a3, voffA);
            PG8_BAR; PG8_WAIT_L(0); PG8_MMA(1, 0, At, B0); PG8_BAR; PG8_SCHED;
            PG8_STAGE(PG8_SB(1, 1), b3 + hstep, voffB);
            PG8_WAIT_V(6); PG8_BAR; PG8_MMA(1, 1, At, B1); PG8_BAR;
            }
        }
        if constexpr (ALIGN_EPI) { if (wr == 0) PG8_BAR; }
        if constexpr (!Epi::AFTER_DRAIN) { E(acc, cur, wr, wc, fr, fq); S.done(cur); }
        if (!has_next) break;
#pragma unroll
        for (int a = 0; a < 2; ++a)
#pragma unroll
            for (int b = 0; b < 2; ++b)
#pragma unroll
                for (int m = 0; m < 4; ++m)
#pragma unroll
                    for (int n = 0; n < 2; ++n) acc[a][b][m][n] = (f32x4){0.f, 0.f, 0.f, 0.f};
        cur = nxt; cA = nA; cB = nB; ++ui;
        if constexpr (ALIGN_EPI) { if (wr == 1) PG8_BAR; }
    }
    PG8_WAIT_V(0);
    if constexpr (!ALIGN_EPI) { if (wr == 0) PG8_BAR; }
    PG8_BAR;
    if constexpr (Epi::AFTER_DRAIN) { E.fused(acc, cur, wr, wc, fr, fq, lds, wid, lane); S.done(cur); }
#undef PG8_SA
#undef PG8_SB
#undef PG8_STAGE
#undef PG8_LDA
#undef PG8_LDB
#undef PG8_MMA
#undef PG8_WAIT_V
#undef PG8_WAIT_L
#undef PG8_BAR
#undef PG8_SCHED
}
}

typedef pg8::bf16_t bf16_t;
typedef pg8::bf16x8 bf16x8;
typedef pg8::f32x4 f32x4;
typedef pg8::u32x4 u32x4;
typedef short s16x4 __attribute__((ext_vector_type(4)));
typedef float f32x16 __attribute__((ext_vector_type(16)));
typedef unsigned u32x2 __attribute__((ext_vector_type(2)));
#define LAS __attribute__((address_space(3)))
typedef LAS unsigned char lds_u8;

constexpr int SEQ = 4096, NBATCH = 2, MTOK = 8192, DM = 4096, NIN = 13632, NINP = 13824, MIXW = 4608;
constexpr int C_ACQ = 0, C_ACKV = 768, C_KPE = 1280, C_BQ = 1344, C_BK = 2880, C_BV = 4416, C_CQ = 5952, C_CK = 6976, C_CV = 7232,
              C_DQ = 7488, C_DK = 8512, C_DV = 8768, C_GATE = 9024;
constexpr int MX_A = 0, MX_B = 1024, MX_C = 2560, MX_D = 3584;
constexpr float EPS = 1e-6f;
constexpr float LOG2E = 1.4426950408889634f, LN2 = 0.6931471805599453f;

constexpr size_t AL(size_t x) { return (x + 255) / 256 * 256; }
constexpr size_t WS_WIN   = 0;
constexpr size_t WS_WOUT  = WS_WIN   + AL((size_t)2 * NINP * DM * 2);
constexpr size_t WS_WUQ   = WS_WOUT  + AL((size_t)2 * DM * MIXW * 2);
constexpr size_t WS_WUKV  = WS_WUQ   + AL((size_t)2 * 1536 * 768 * 2);
constexpr size_t WS_H     = WS_WUKV  + AL((size_t)2 * 2048 * 512 * 2);
constexpr size_t WS_PROJ  = WS_H     + AL((size_t)MTOK * DM * 2);
constexpr size_t WS_X1    = WS_PROJ  + AL((size_t)MTOK * NINP * 2);
constexpr size_t WS_QAN   = WS_X1    + AL((size_t)MTOK * DM * 4);
constexpr size_t WS_KVAN  = WS_QAN   + AL((size_t)MTOK * 768 * 2);
constexpr size_t WS_KPE   = WS_KVAN  + AL((size_t)MTOK * 512 * 2);
constexpr size_t WS_QRAW  = WS_KPE   + AL((size_t)MTOK * 64 * 2);
constexpr size_t WS_KVRAW = WS_QRAW  + AL((size_t)MTOK * 1536 * 2);
constexpr size_t WS_QC    = WS_KVRAW + AL((size_t)MTOK * 2048 * 2);
constexpr size_t WS_KC    = WS_QC    + AL((size_t)MTOK * 1024 * 2);
constexpr size_t WS_MIXED = WS_KC    + AL((size_t)MTOK * 256 * 2);
constexpr size_t WS_LSE   = WS_MIXED + AL((size_t)MTOK * MIXW * 2);
constexpr size_t WS_CS    = WS_LSE   + AL((size_t)3 * MTOK * 4 * 4);
constexpr size_t WS_DELTA = WS_CS    + AL((size_t)SEQ * 32 * 8);
constexpr size_t WS_DKV   = WS_DELTA + AL((size_t)2 * MTOK * DM * 2);
constexpr size_t WS_BAR   = WS_DKV   + AL((size_t)MTOK * 512 * 2);
constexpr size_t WS_END   = WS_BAR   + AL((size_t)3456 * 4);

constexpr int LDS_BYTES = 141312;

#ifndef REP_GEMM
#define REP_GEMM 1
#endif
#ifndef REP_OUT
#define REP_OUT 1
#endif
#ifndef REP_UP
#define REP_UP 1
#endif
#ifndef REP_SYNC
#define REP_SYNC 0
#endif
#ifndef REP_BAND
#define REP_BAND 1
#endif
#ifndef REP_A
#define REP_A 1
#endif
#ifndef REP_C
#define REP_C 1
#endif
#ifndef HIDE_TAIL
#define HIDE_TAIL 0
#endif
#ifndef CVT_P0_LAYERS
#define CVT_P0_LAYERS 2
#endif
#ifndef GEMM_ALIGN
#define GEMM_ALIGN true
#endif
#ifndef GEMM_SP2
#define GEMM_SP2 true
#endif
#ifndef REP_D
#define REP_D 1
#endif
#ifndef REP_B
#define REP_B 1
#endif
#ifndef REP_ATTN
#define REP_ATTN 1
#endif
#ifndef REP_CVT
#define REP_CVT 1
#endif
#ifndef REP_MISC
#define REP_MISC 1
#endif
struct Params {
    const float *x, *g_attn, *w_in, *g_qa, *g_kva, *w_uq, *w_ukv, *g_qn, *g_kn, *sinks, *w_out, *rel_bias, *g_final;
    float* out; unsigned char* ws; int ph_lo, ph_hi;
};

__device__ __forceinline__ bf16_t f2bf(float f) { unsigned u = __float_as_uint(f); u += 0x7FFFu + ((u >> 16) & 1u); return (bf16_t)(u >> 16); }
__device__ __forceinline__ float bf2f(bf16_t b) { return __uint_as_float(((unsigned)b) << 16); }
__device__ __forceinline__ float bflo(unsigned w) { return __uint_as_float(w << 16); }
__device__ __forceinline__ float bfhi(unsigned w) { return __uint_as_float(w & 0xffff0000u); }
__device__ __forceinline__ unsigned cvtpk(float lo, float hi) { unsigned r; asm volatile("v_cvt_pk_bf16_f32 %0, %1, %2" : "=v"(r) : "v"(lo), "v"(hi)); return r; }
__device__ __forceinline__ float wave_sum(float v) {
#pragma unroll
    for (int o = 32; o >= 1; o >>= 1) v += __shfl_xor(v, o);
    return v;
}
__device__ __forceinline__ int rel_bucket(int rel) {
    const int n = rel < 0 ? -rel : rel; int b;
    if (n < 8) b = n;
    else b = 8 + (n >= 15) + (n >= 27) + (n >= 50) + (n >= 91) + (n >= 166) + (n >= 305) + (n >= 559);
    return b + (rel > 0 ? 16 : 0);
}

constexpr int CVT_NQ = 4;
__device__ __forceinline__ void cvt_transpose(const float* __restrict__ src, bf16_t* __restrict__ dst, int K, int N, int Npad, lds_u8* lds, int wg, int nwg) {
    LAS float* tile = (LAS float*)lds;
    const int tid = pg8::opaque_tid(), tn4 = Npad / (64 * CVT_NQ), tk = K / 64;
    __syncthreads();
    for (int t = wg; t < tn4 * tk; t += nwg) {
        const int nt4 = t % tn4, kt = t / tn4;
        f32x4 v[CVT_NQ][2];
#pragma unroll
        for (int q = 0; q < CVT_NQ; ++q)
#pragma unroll
            for (int i = 0; i < 2; ++i) {
                const int row = (tid >> 4) + 32 * i, c4 = (tid & 15) * 4, n = (nt4 * CVT_NQ + q) * 64 + c4;
                v[q][i] = (f32x4){0.f, 0.f, 0.f, 0.f};
                if (n < N) v[q][i] = __builtin_nontemporal_load((const f32x4*)(src + (size_t)(kt * 64 + row) * N + n));
            }
#pragma unroll
        for (int q = 0; q < CVT_NQ; ++q)
#pragma unroll
            for (int i = 0; i < 2; ++i) {
                const int row = (tid >> 4) + 32 * i, c4 = (tid & 15) * 4;
                LAS float* tp = tile + q * (64 * 65) + row * 65 + c4;
                tp[0] = v[q][i][0]; tp[1] = v[q][i][1]; tp[2] = v[q][i][2]; tp[3] = v[q][i][3];
            }
        __syncthreads();
#pragma unroll
        for (int q = 0; q < CVT_NQ; ++q) {
            const int nl = tid >> 3, kc = (tid & 7) * 8;
            float f[8];
#pragma unroll
            for (int j = 0; j < 8; ++j) f[j] = tile[q * (64 * 65) + (kc + j) * 65 + nl];
            u32x4 w; w.x = cvtpk(f[0], f[1]); w.y = cvtpk(f[2], f[3]); w.z = cvtpk(f[4], f[5]); w.w = cvtpk(f[6], f[7]);
            *(u32x4*)(dst + (size_t)((nt4 * CVT_NQ + q) * 64 + nl) * K + kt * 64 + kc) = w;
        }
        __syncthreads();
    }
}

__device__ __forceinline__ void build_cs(float2* cs, int wg, int nwg) {
    for (int idx = wg * 512 + pg8::opaque_tid(); idx < SEQ * 32; idx += nwg * 512) {
        const int pos = idx >> 5, i = idx & 31;
        const float inv = exp2f(-(float)i * (13.287712379549449f / 32.0f));
        const float ang = (float)pos * inv;
        const float k = rintf(ang * 0.15915494309189535f);
        float r = fmaf(-k, 6.2831854820251465f, ang); r = fmaf(-k, -1.7484555e-7f, r);
        cs[idx] = make_float2(__cosf(r), __sinf(r));
    }
}

template <int NDELTA, bool TO_BF16>
__device__ __forceinline__ void rmsnorm_rows(const float* __restrict__ x, const bf16_t* __restrict__ delta0, const bf16_t* __restrict__ delta1, const float* __restrict__ g,
                                             bf16_t* __restrict__ hout, float* __restrict__ fout, int wg, int nwg) {
    const int tid = pg8::opaque_tid(), wid = tid >> 6, lane = tid & 63;
    f32x4 gk[16];
#pragma unroll
    for (int k = 0; k < 16; ++k) gk[k] = *(const f32x4*)(g + k * 256 + lane * 4);
    for (int row = wg * 8 + wid; row < MTOK; row += nwg * 8) {
        const float* xr = x + (size_t)row * DM + lane * 4;
        f32x4 v[16];
#pragma unroll
        for (int k = 0; k < 16; ++k) v[k] = __builtin_nontemporal_load((const f32x4*)(xr + k * 256));
        if (NDELTA >= 1) {
            u32x2 d[16];
#pragma unroll
            for (int k = 0; k < 16; ++k) d[k] = __builtin_nontemporal_load((const u32x2*)(delta0 + (size_t)row * DM + k * 256 + lane * 4));
#pragma unroll
            for (int k = 0; k < 16; ++k) { v[k][0] += bflo(d[k].x); v[k][1] += bfhi(d[k].x); v[k][2] += bflo(d[k].y); v[k][3] += bfhi(d[k].y); }
        }
        if (NDELTA >= 2) {
            u32x2 d[16];
#pragma unroll
            for (int k = 0; k < 16; ++k) d[k] = __builtin_nontemporal_load((const u32x2*)(delta1 + (size_t)row * DM + k * 256 + lane * 4));
#pragma unroll
            for (int k = 0; k < 16; ++k) { v[k][0] += bflo(d[k].x); v[k][1] += bfhi(d[k].x); v[k][2] += bflo(d[k].y); v[k][3] += bfhi(d[k].y); }
        }
        float ss = 0.f;
#pragma unroll
        for (int k = 0; k < 16; ++k) ss += v[k][0] * v[k][0] + v[k][1] * v[k][1] + v[k][2] * v[k][2] + v[k][3] * v[k][3];
        ss = wave_sum(ss);
        const float rstd = rsqrtf(ss * (1.0f / DM) + EPS);
#pragma unroll
        for (int k = 0; k < 16; ++k) {
            const f32x4 y = v[k] * rstd * gk[k];
            if (TO_BF16) { u32x2 w; w.x = cvtpk(y[0], y[1]); w.y = cvtpk(y[2], y[3]); *(u32x2*)(hout + (size_t)row * DM + k * 256 + lane * 4) = w; }
            else __builtin_nontemporal_store(y, (f32x4*)(fout + (size_t)row * DM + k * 256 + lane * 4));
        }
    }
}

__device__ __forceinline__ void prep_tokens(const bf16_t* __restrict__ proj, const float* __restrict__ g_qa, const float* __restrict__ g_kva,
                                            const float* __restrict__ g_qn, const float* __restrict__ g_kn, const float2* __restrict__ cs,
                                            bf16_t* __restrict__ qan, bf16_t* __restrict__ kvan, bf16_t* __restrict__ kpe, bf16_t* __restrict__ qc, bf16_t* __restrict__ kc, bf16_t* __restrict__ dkv, int wg, int nwg) {
    const int tid = pg8::opaque_tid(), wid = tid >> 6, lane = tid & 63, hf = lane >> 5, i = lane & 31;
    for (int t = wg * 8 + wid; t < MTOK; t += nwg * 8) {
        const bf16_t* pr = proj + (size_t)t * NINP;
        const int pos = t & (SEQ - 1);
        u32x2 wq[3], wk[2];
#pragma unroll
        for (int k = 0; k < 3; ++k) wq[k] = *(const u32x2*)(pr + C_ACQ + k * 256 + lane * 4);
#pragma unroll
        for (int k = 0; k < 2; ++k) wk[k] = *(const u32x2*)(pr + C_ACKV + k * 256 + lane * 4);
        bf16_t hv[5][4];
#pragma unroll
        for (int s = 0; s < 5; ++s)
#pragma unroll
            for (int q = 0; q < 4; ++q) hv[s][q] = pr[C_CQ + (2 * s + hf) * 128 + q * 32 + i];
        const bf16_t kp1 = pr[C_KPE + i], kp2 = pr[C_KPE + 32 + i];
        const float2 ct = cs[pos * 32 + i], crow_ = cs[(pos >> 6) * 32 + i], ccol = cs[(pos & 63) * 32 + i];
        {
            float v[12]; float ss = 0.f;
#pragma unroll
            for (int k = 0; k < 3; ++k) { v[4 * k] = bflo(wq[k].x); v[4 * k + 1] = bfhi(wq[k].x); v[4 * k + 2] = bflo(wq[k].y); v[4 * k + 3] = bfhi(wq[k].y); }
#pragma unroll
            for (int j = 0; j < 12; ++j) ss += v[j] * v[j];
            ss = wave_sum(ss);
            const float rstd = rsqrtf(ss * (1.0f / 768.0f) + EPS);
#pragma unroll
            for (int k = 0; k < 3; ++k) { const f32x4 gg = *(const f32x4*)(g_qa + k * 256 + lane * 4);
                u32x2 w; w.x = cvtpk(v[4 * k] * rstd * gg[0], v[4 * k + 1] * rstd * gg[1]); w.y = cvtpk(v[4 * k + 2] * rstd * gg[2], v[4 * k + 3] * rstd * gg[3]);
                *(u32x2*)(qan + (size_t)t * 768 + k * 256 + lane * 4) = w; }
        }
        {
            float v[8]; float ss = 0.f;
#pragma unroll
            for (int k = 0; k < 2; ++k) { v[4 * k] = bflo(wk[k].x); v[4 * k + 1] = bfhi(wk[k].x); v[4 * k + 2] = bflo(wk[k].y); v[4 * k + 3] = bfhi(wk[k].y); }
#pragma unroll
            for (int j = 0; j < 8; ++j) ss += v[j] * v[j];
            ss = wave_sum(ss);
            const float rstd = rsqrtf(ss * (1.0f / 512.0f) + EPS);
#pragma unroll
            for (int k = 0; k < 2; ++k) { const f32x4 gg = *(const f32x4*)(g_kva + k * 256 + lane * 4);
                u32x2 w; w.x = cvtpk(v[4 * k] * rstd * gg[0], v[4 * k + 1] * rstd * gg[1]); w.y = cvtpk(v[4 * k + 2] * rstd * gg[2], v[4 * k + 3] * rstd * gg[3]);
                *(u32x2*)(kvan + (size_t)t * 512 + k * 256 + lane * 4) = w; }
        }
        if (hf == 0) {
            const float x1 = bf2f(kp1), x2 = bf2f(kp2);
            kpe[(size_t)t * 64 + i] = f2bf(x1 * ct.x - x2 * ct.y);
            kpe[(size_t)t * 64 + 32 + i] = f2bf(x2 * ct.x + x1 * ct.y);
        }
#pragma unroll
        for (int s = 0; s < 5; ++s) {
            const int head = 2 * s + hf;
            const float* gg = (head < 8) ? g_qn : g_kn;
            float a0 = bf2f(hv[s][0]), a1 = bf2f(hv[s][1]), a2 = bf2f(hv[s][2]), a3 = bf2f(hv[s][3]);
            float ss = a0 * a0 + a1 * a1 + a2 * a2 + a3 * a3;
#pragma unroll
            for (int o = 16; o >= 1; o >>= 1) ss += __shfl_xor(ss, o);
            const float rstd = rsqrtf(ss * (1.0f / 128.0f) + EPS);
            a0 *= rstd * gg[i]; a1 *= rstd * gg[32 + i]; a2 *= rstd * gg[64 + i]; a3 *= rstd * gg[96 + i];
            bf16_t* dst = (head < 8) ? (qc + (size_t)t * 1024 + head * 128) : (kc + (size_t)t * 256 + (head - 8) * 128);
            dst[i] = f2bf(a0 * crow_.x - a1 * crow_.y); dst[32 + i] = f2bf(a1 * crow_.x + a0 * crow_.y);
            dst[64 + i] = f2bf(a2 * ccol.x - a3 * ccol.y); dst[96 + i] = f2bf(a3 * ccol.x + a2 * ccol.y);
        }
    }
}

__device__ __forceinline__ void fixup_b(bf16_t* mixed, const float* __restrict__ lse, int wg, int nwg) {
    const int tid = pg8::opaque_tid(), wid = tid >> 6, lane = tid & 63, hh = lane >> 4;
    for (int t = wg * 8 + wid; t < MTOK; t += nwg * 8) {
        const float l0 = lse[((size_t)0 * MTOK + t) * 4 + hh], l1 = lse[((size_t)1 * MTOK + t) * 4 + hh], l2 = lse[((size_t)2 * MTOK + t) * 4 + hh];
        const float mx = fmaxf(l0, fmaxf(l1, l2));
        const float e0 = __expf(l0 - mx), e1 = __expf(l1 - mx), e2 = __expf(l2 - mx), inv = 1.0f / (e0 + e1 + e2);
        const float al[3] = {e0 * inv, e1 * inv, e2 * inv};
        u32x4 wv[3];
#pragma unroll
        for (int k = 0; k < 3; ++k) wv[k] = *(const u32x4*)(mixed + (size_t)t * MIXW + MX_B + k * 512 + lane * 8);
#pragma unroll
        for (int k = 0; k < 3; ++k) {
            u32x4 w = wv[k];
            const float a = al[k];
            w.x = cvtpk(bflo(w.x) * a, bfhi(w.x) * a); w.y = cvtpk(bflo(w.y) * a, bfhi(w.y) * a);
            w.z = cvtpk(bflo(w.z) * a, bfhi(w.z) * a); w.w = cvtpk(bflo(w.w) * a, bfhi(w.w) * a);
            *(u32x4*)(mixed + (size_t)t * MIXW + MX_B + k * 512 + lane * 8) = w;
        }
    }
}

__device__ __forceinline__ int crow(int r, int hi) { return (r & 3) + 8 * (r >> 2) + 4 * hi; }
#define KSWZ(row, colB) ((row) * 256 + ((colB) ^ (((row) & 7) << 4)))
#define PSWZ(row, colB) ((row) * 128 + ((colB) ^ (((row) & 7) << 4)))
__device__ __forceinline__ int v_st(int k, int c) { const int kk = (k & ~0xC) | ((k & 4) << 1) | ((k & 8) >> 1); return ((kk >> 3) * 4 + (c >> 5)) * 512 + ((kk & 7) * 32 + (c & 31)) * 2; }
__device__ __forceinline__ int v_rd_base(int lane) { return ((lane & 3) << 3) | (((lane >> 2) & 3) << 6) | (((lane >> 4) & 1) << 5) | (((lane >> 5) & 1) << 8); }
constexpr int v_rd_off(int d0, int ks, int half) { return d0 * 512 + ks * 4096 + half * 2048; }
template <int OFF> __device__ __forceinline__ s16x4 tr_read(int vb) {
    s16x4 r; asm volatile("ds_read_b64_tr_b16 %0, %1 offset:%2" : "=&v"(r) : "v"(vb), "i"(OFF) : "memory"); return r;
}
template <int D0> __device__ __forceinline__ void pv_one(f32x16& od, int vb, bf16x8 pa0, bf16x8 pa1, bf16x8 pa2, bf16x8 pa3) {
    const s16x4 l0 = tr_read<v_rd_off(D0, 0, 0)>(vb), h0 = tr_read<v_rd_off(D0, 0, 1)>(vb), l1 = tr_read<v_rd_off(D0, 1, 0)>(vb), h1 = tr_read<v_rd_off(D0, 1, 1)>(vb);
    const s16x4 l2 = tr_read<v_rd_off(D0, 2, 0)>(vb), h2 = tr_read<v_rd_off(D0, 2, 1)>(vb), l3 = tr_read<v_rd_off(D0, 3, 0)>(vb), h3 = tr_read<v_rd_off(D0, 3, 1)>(vb);
    asm volatile("s_waitcnt lgkmcnt(0)" ::: "memory"); __builtin_amdgcn_sched_barrier(0);
#define PK(L, H) (bf16x8){L[0], L[1], L[2], L[3], H[0], H[1], H[2], H[3]}
    od = __builtin_amdgcn_mfma_f32_32x32x16_bf16(pa0, PK(l0, h0), od, 0, 0, 0);
    od = __builtin_amdgcn_mfma_f32_32x32x16_bf16(pa1, PK(l1, h1), od, 0, 0, 0);
    od = __builtin_amdgcn_mfma_f32_32x32x16_bf16(pa2, PK(l2, h2), od, 0, 0, 0);
    od = __builtin_amdgcn_mfma_f32_32x32x16_bf16(pa3, PK(l3, h3), od, 0, 0, 0);
#undef PK
}

constexpr int AL_V = 0, AL_K = 16384, AL_KP = 32768, AL_WS = 40960, AL_LUT = 43008;

struct AttnArgs {
    const bf16_t* Q; long ldq;
    const bf16_t* K; long ldk;
    const bf16_t* K2; long ldk2;
    const bf16_t* V; long ldv;
    const bf16_t* G; long ldg;
    bf16_t* O; long ldo;
    float* lse; long ldl;
    const float2* cs;
    int i0, L, side, dil;
    const float* bias; int bcol;
    float C;
    float sink2;
};

template <int DQK, bool BAND, bool SINK, bool WLSE, bool ROPEQ>
__device__ __forceinline__ void attn_unit(lds_u8* lds, const AttnArgs& a) {
    constexpr int ND0 = DQK / 16;
    const int tid = pg8::opaque_tid(), wid = tid >> 6, lane = tid & 63, r32 = lane & 31, hi = lane >> 5;
    lds_u8* Vl = lds + AL_V; lds_u8* Kl = lds + AL_K; lds_u8* Kp = lds + AL_KP;
    LAS float* wsf = (LAS float*)(lds + AL_WS) + wid * 64; LAS float* li_l = wsf; LAS float* al_l = wsf + 32;
    LAS float* lut = (LAS float*)(lds + AL_LUT);
    __syncthreads();
    if (BAND) {
        if (tid <= 2 * a.side) { const int rel = tid - a.side; lut[tid] = a.bias[rel_bucket(rel * a.dil) * 20 + a.bcol] * LOG2E; }
    }
    const int qi = a.i0 + wid * 32 + r32;
    bf16x8 qr[ND0];
    {
        const bf16_t* Qw = a.Q + (long)qi * a.ldq + hi * 8;
#pragma unroll
        for (int d0 = 0; d0 < ND0; ++d0) qr[d0] = *(const bf16x8*)(Qw + d0 * 16);
    }
    if constexpr (ROPEQ) {
#pragma unroll
        for (int dd = 0; dd < 2; ++dd) {
            bf16x8 x1 = qr[8 + dd], x2 = qr[10 + dd];
#pragma unroll
            for (int j = 0; j < 8; ++j) {
                const float2 c = a.cs[qi * 32 + dd * 16 + hi * 8 + j];
                const float f1 = bf2f((bf16_t)x1[j]), f2 = bf2f((bf16_t)x2[j]);
                x1[j] = (short)f2bf(f1 * c.x - f2 * c.y); x2[j] = (short)f2bf(f2 * c.x + f1 * c.y);
            }
            qr[8 + dd] = x1; qr[10 + dd] = x2;
        }
    }
    int t_lo = 0, t_hi = a.L / 64, lo_w = 0, hi_w = 1 << 30;
    if (BAND) {
        t_lo = (a.i0 - a.side) / 64; if (t_lo < 0) t_lo = 0;
        int th = (a.i0 + 256 + a.side) / 64; if (th < t_hi) t_hi = th;
        const int w0 = a.i0 + wid * 32;
        lo_w = (w0 - a.side) >> 6; hi_w = (w0 + 31 + a.side) >> 6;
    }
    const int sr = tid >> 4, sc = (tid & 15) * 8;
    const int vst0 = v_st(sr, sc), vst1 = v_st(32 + sr, sc), kst0 = KSWZ(sr, sc * 2), kst1 = KSWZ(32 + sr, sc * 2);
    const int pr_ = tid >> 3, pc = (tid & 7) * 8, pst = PSWZ(pr_, pc * 2);
    const int vb0 = (int)(unsigned)(size_t)Vl + v_rd_base(lane);
    bf16x8 kA, kB, vA, vB, kP;
#define ALOAD(T) do { const long j0 = (long)(T) * 64; \
        kA = *(const bf16x8*)(a.K + (j0 + sr) * a.ldk + sc); kB = *(const bf16x8*)(a.K + (j0 + 32 + sr) * a.ldk + sc); \
        vA = *(const bf16x8*)(a.V + (j0 + sr) * a.ldv + sc); vB = *(const bf16x8*)(a.V + (j0 + 32 + sr) * a.ldv + sc); \
        if constexpr (DQK == 192) kP = *(const bf16x8*)(a.K2 + (j0 + pr_) * a.ldk2 + pc); } while (0)
    float m_reg = -1e29f, l_reg = 0.f;
    f32x16 o[4];
#pragma unroll
    for (int d = 0; d < 4; ++d)
#pragma unroll
        for (int r = 0; r < 16; ++r) o[d][r] = 0.f;
    ALOAD(t_lo);
    for (int T = t_lo; T < t_hi; ++T) {
        __syncthreads();
        *(LAS bf16x8*)(Kl + kst0) = kA; *(LAS bf16x8*)(Kl + kst1) = kB;
        *(LAS bf16x8*)(Vl + vst0) = vA; *(LAS bf16x8*)(Vl + vst1) = vB;
        if constexpr (DQK == 192) *(LAS bf16x8*)(Kp + pst) = kP;
        if (T + 1 < t_hi) ALOAD(T + 1);
        __syncthreads();
        if (T >= lo_w && T <= hi_w) {
            f32x16 p0, p1;
#pragma unroll
            for (int r = 0; r < 16; ++r) { p0[r] = 0.f; p1[r] = 0.f; }
#pragma unroll
            for (int d0 = 0; d0 < 8; ++d0) { const int cb = (d0 * 16 + hi * 8) * 2;
                const bf16x8 b0 = *(const LAS bf16x8*)(Kl + KSWZ(r32, cb)), b1 = *(const LAS bf16x8*)(Kl + KSWZ(32 + r32, cb));
                p0 = __builtin_amdgcn_mfma_f32_32x32x16_bf16(b0, qr[d0], p0, 0, 0, 0);
                p1 = __builtin_amdgcn_mfma_f32_32x32x16_bf16(b1, qr[d0], p1, 0, 0, 0); }
            if constexpr (DQK == 192) {
#pragma unroll
                for (int d0 = 0; d0 < 4; ++d0) { const int cb = (d0 * 16 + hi * 8) * 2;
                    const bf16x8 b0 = *(const LAS bf16x8*)(Kp + PSWZ(r32, cb)), b1 = *(const LAS bf16x8*)(Kp + PSWZ(32 + r32, cb));
                    p0 = __builtin_amdgcn_mfma_f32_32x32x16_bf16(b0, qr[8 + d0], p0, 0, 0, 0);
                    p1 = __builtin_amdgcn_mfma_f32_32x32x16_bf16(b1, qr[8 + d0], p1, 0, 0, 0); }
            }
            if (BAND) {
                const int base = T * 64 - qi + a.side;
#pragma unroll
                for (int r = 0; r < 16; ++r) {
                    const int i0_ = base + crow(r, hi), i1_ = i0_ + 32;
                    const bool ok0 = (unsigned)i0_ <= (unsigned)(2 * a.side), ok1 = (unsigned)i1_ <= (unsigned)(2 * a.side);
                    const float b0 = lut[ok0 ? i0_ : 0], b1 = lut[ok1 ? i1_ : 0];
                    p0[r] = ok0 ? fmaf(p0[r], a.C, b0) : -1e30f; p1[r] = ok1 ? fmaf(p1[r], a.C, b1) : -1e30f;
                }
            } else {
#pragma unroll
                for (int r = 0; r < 16; ++r) { p0[r] *= a.C; p1[r] *= a.C; }
            }
            float pmax = p0[0];
#pragma unroll
            for (int r = 1; r < 16; ++r) pmax = fmaxf(pmax, p0[r]);
#pragma unroll
            for (int r = 0; r < 16; ++r) pmax = fmaxf(pmax, p1[r]);
            { auto rr = __builtin_amdgcn_permlane32_swap(__float_as_uint(pmax), __float_as_uint(pmax), false, false);
              pmax = fmaxf(__uint_as_float(rr[0]), __uint_as_float(rr[1])); }
            const float mn = fmaxf(m_reg, pmax);
            const float alpha = __builtin_amdgcn_exp2f(m_reg - mn);
            m_reg = mn;
            float ps = 0.f;
#pragma unroll
            for (int r = 0; r < 16; ++r) { p0[r] = __builtin_amdgcn_exp2f(p0[r] - mn); p1[r] = __builtin_amdgcn_exp2f(p1[r] - mn); ps += p0[r] + p1[r]; }
            { auto rr = __builtin_amdgcn_permlane32_swap(__float_as_uint(ps), __float_as_uint(ps), false, false);
              ps = __uint_as_float(rr[0]) + __uint_as_float(rr[1]); }
            l_reg = l_reg * alpha + ps;
            if (__any(alpha < 1.f)) {
                if (hi == 0) al_l[r32] = alpha;
                asm volatile("s_waitcnt lgkmcnt(0)" ::: "memory");
#pragma unroll
                for (int r = 0; r < 16; ++r) { const float al = al_l[crow(r, hi)];
#pragma unroll
                    for (int d = 0; d < 4; ++d) o[d][r] *= al; }
            }
            bf16x8 pa0, pa1, pa2, pa3;
#define PK4(P, BASE, OUT) do { unsigned a0 = cvtpk(P[BASE + 0], P[BASE + 1]), a1 = cvtpk(P[BASE + 2], P[BASE + 3]);   \
    unsigned b0 = cvtpk(P[BASE + 4], P[BASE + 5]), b1 = cvtpk(P[BASE + 6], P[BASE + 7]);                              \
    auto r0 = __builtin_amdgcn_permlane32_swap(a0, b0, false, false); auto r1 = __builtin_amdgcn_permlane32_swap(a1, b1, false, false); \
    u32x4 w = {r0[0], r1[0], r0[1], r1[1]}; OUT = *reinterpret_cast<bf16x8*>(&w); } while (0)
            PK4(p0, 0, pa0); PK4(p0, 8, pa1); PK4(p1, 0, pa2); PK4(p1, 8, pa3);
#undef PK4
            pv_one<0>(o[0], vb0, pa0, pa1, pa2, pa3); pv_one<1>(o[1], vb0, pa0, pa1, pa2, pa3);
            pv_one<2>(o[2], vb0, pa0, pa1, pa2, pa3); pv_one<3>(o[3], vb0, pa0, pa1, pa2, pa3);
        }
    }
#undef ALOAD
    if (SINK) l_reg += __builtin_amdgcn_exp2f(a.sink2 - m_reg);
    if (hi == 0) li_l[r32] = l_reg;
    if (WLSE) { if (hi == 0) a.lse[(long)qi * a.ldl] = (m_reg + __builtin_amdgcn_logf(l_reg)) * LN2; }
    asm volatile("s_waitcnt lgkmcnt(0)" ::: "memory");
    bf16_t gv[16][4];
#pragma unroll
    for (int r = 0; r < 16; ++r) {
        const bf16_t* gp = a.G + (long)(a.i0 + wid * 32 + crow(r, hi)) * a.ldg + r32;
#pragma unroll
        for (int d0 = 0; d0 < 4; ++d0) gv[r][d0] = gp[d0 * 32];
    }
#pragma unroll
    for (int r = 0; r < 16; ++r) {
        const int row = crow(r, hi);
        const float rl = __builtin_amdgcn_rcpf(li_l[row]);
        const long i = a.i0 + wid * 32 + row;
        bf16_t* op = a.O + i * a.ldo + r32;
#pragma unroll
        for (int d0 = 0; d0 < 4; ++d0) {
            const float g = bf2f(gv[r][d0]);
            const float sg = g * __builtin_amdgcn_rcpf(1.0f + __builtin_amdgcn_exp2f(-LOG2E * g));
            op[d0 * 32] = (bf16_t)cvtpk(o[d0][r] * rl * sg, 0.f);
        }
    }
}


constexpr int DL_V = 0, DL_K = 32768, DL_P = 65536, DL_WS = 81920;
template <int DQK>
__device__ __forceinline__ void d_qkt(f32x16& p0, f32x16& p1, const lds_u8* Ks, const lds_u8* Ps, const bf16x8* qr, int r32, int hi) {
#pragma unroll
    for (int r = 0; r < 16; ++r) { p0[r] = 0.f; p1[r] = 0.f; }
#pragma unroll
    for (int d0 = 0; d0 < 8; ++d0) { const int cb = (d0 * 16 + hi * 8) * 2;
        const bf16x8 b0 = *(const LAS bf16x8*)(Ks + KSWZ(r32, cb)), b1 = *(const LAS bf16x8*)(Ks + KSWZ(32 + r32, cb));
        p0 = __builtin_amdgcn_mfma_f32_32x32x16_bf16(b0, qr[d0], p0, 0, 0, 0);
        p1 = __builtin_amdgcn_mfma_f32_32x32x16_bf16(b1, qr[d0], p1, 0, 0, 0); }
    if constexpr (DQK == 192) {
#pragma unroll
        for (int d0 = 0; d0 < 4; ++d0) { const int cb = (d0 * 16 + hi * 8) * 2;
            const bf16x8 b0 = *(const LAS bf16x8*)(Ps + PSWZ(r32, cb)), b1 = *(const LAS bf16x8*)(Ps + PSWZ(32 + r32, cb));
            p0 = __builtin_amdgcn_mfma_f32_32x32x16_bf16(b0, qr[8 + d0], p0, 0, 0, 0);
            p1 = __builtin_amdgcn_mfma_f32_32x32x16_bf16(b1, qr[8 + d0], p1, 0, 0, 0); }
    }
}
__device__ __forceinline__ void d_partialSM(f32x16& p0, f32x16& p1, float& m_reg, float& mn, float& alpha, const float C) {
    float pmax = p0[0];
#pragma unroll
    for (int r = 1; r < 16; ++r) pmax = fmaxf(pmax, p0[r]);
#pragma unroll
    for (int r = 0; r < 16; ++r) pmax = fmaxf(pmax, p1[r]);
    { auto rr = __builtin_amdgcn_permlane32_swap(__float_as_uint(pmax), __float_as_uint(pmax), false, false);
      pmax = fmaxf(__uint_as_float(rr[0]), __uint_as_float(rr[1])); }
    if (__builtin_expect(__all((pmax - m_reg) * C <= 8.0f * LOG2E), 1)) { mn = m_reg; alpha = 1.f; }
    else { mn = fmaxf(m_reg, pmax); alpha = __builtin_amdgcn_exp2f((m_reg - mn) * C); m_reg = mn; }
    const float mnC = -mn * C;
#pragma unroll
    for (int r = 0; r < 16; ++r) p0[r] = fmaf(p0[r], C, mnC);
#pragma unroll
    for (int r = 0; r < 16; ++r) p1[r] = fmaf(p1[r], C, mnC);
#pragma unroll
    for (int r = 0; r < 16; ++r) p0[r] = __builtin_amdgcn_exp2f(p0[r]);
}
__device__ __forceinline__ void d_finishSM(f32x16& p0, f32x16& p1, float alpha, float& l_reg, bf16x8& pa0, bf16x8& pa1, bf16x8& pa2, bf16x8& pa3) {
#pragma unroll
    for (int r = 0; r < 16; ++r) p1[r] = __builtin_amdgcn_exp2f(p1[r]);
    float ps = 0;
#pragma unroll
    for (int r = 0; r < 16; ++r) ps += p0[r];
#pragma unroll
    for (int r = 0; r < 16; ++r) ps += p1[r];
    { auto rr = __builtin_amdgcn_permlane32_swap(__float_as_uint(ps), __float_as_uint(ps), false, false);
      ps = __uint_as_float(rr[0]) + __uint_as_float(rr[1]); }
    l_reg = l_reg * alpha + ps;
#define PK4(P, BASE, OUT) do { unsigned a0 = cvtpk(P[BASE + 0], P[BASE + 1]), a1 = cvtpk(P[BASE + 2], P[BASE + 3]);   \
    unsigned b0 = cvtpk(P[BASE + 4], P[BASE + 5]), b1 = cvtpk(P[BASE + 6], P[BASE + 7]);                              \
    auto r0 = __builtin_amdgcn_permlane32_swap(a0, b0, false, false); auto r1 = __builtin_amdgcn_permlane32_swap(a1, b1, false, false); \
    u32x4 w = {r0[0], r1[0], r0[1], r1[1]}; OUT = *reinterpret_cast<bf16x8*>(&w); } while (0)
    PK4(p0, 0, pa0); PK4(p0, 8, pa1); PK4(p1, 0, pa2); PK4(p1, 8, pa3);
#undef PK4
}
__device__ __forceinline__ void d_pv(f32x16* o, int vb, bf16x8 pa0, bf16x8 pa1, bf16x8 pa2, bf16x8 pa3) {
    pv_one<0>(o[0], vb, pa0, pa1, pa2, pa3); pv_one<1>(o[1], vb, pa0, pa1, pa2, pa3); pv_one<2>(o[2], vb, pa0, pa1, pa2, pa3); pv_one<3>(o[3], vb, pa0, pa1, pa2, pa3);
}
#define SBAR() __builtin_amdgcn_sched_barrier(0)

template <int DQK, bool ROPEQ, int SDEPTH>
__device__ __forceinline__ void attn_dense_unit(lds_u8* lds, const AttnArgs& a) {
    constexpr int ND0 = DQK / 16;
    const int tid = pg8::opaque_tid(), wid = tid >> 6, lane = tid & 63, r32 = lane & 31, hi = lane >> 5;
    lds_u8* V_lds = lds + DL_V; lds_u8* K_lds = lds + DL_K; lds_u8* P_lds = lds + DL_P;
    LAS float* wsf = (LAS float*)(lds + DL_WS) + wid * 64; LAS float* li_l = wsf; LAS float* al_l = wsf + 32;
    const float C = a.C;
    __syncthreads();
    const int qi = a.i0 + wid * 32 + r32;
    float m_reg = -1e30f, l_reg = 0.f;
    f32x16 o[4];
#pragma unroll
    for (int d = 0; d < 4; ++d)
#pragma unroll
        for (int r = 0; r < 16; ++r) o[d][r] = 0.f;
    bf16x8 qr[ND0];
    {
        const bf16_t* Qw = a.Q + (long)qi * a.ldq + hi * 8;
#pragma unroll
        for (int d0 = 0; d0 < ND0; ++d0) qr[d0] = *(const bf16x8*)(Qw + d0 * 16);
    }
    if constexpr (ROPEQ) {
#pragma unroll
        for (int dd = 0; dd < 2; ++dd) {
            bf16x8 x1 = qr[8 + dd], x2 = qr[10 + dd];
#pragma unroll
            for (int j = 0; j < 8; ++j) {
                const float2 c = a.cs[qi * 32 + dd * 16 + hi * 8 + j];
                const float f1 = bf2f((bf16_t)x1[j]), f2 = bf2f((bf16_t)x2[j]);
                x1[j] = (short)f2bf(f1 * c.x - f2 * c.y); x2[j] = (short)f2bf(f2 * c.x + f1 * c.y);
            }
            qr[8 + dd] = x1; qr[10 + dd] = x2;
        }
    }
    const int sr = tid >> 4, sc = (tid & 15) * 8, vst0 = v_st(sr, sc), vst1 = v_st(32 + sr, sc), kst0 = KSWZ(sr, sc * 2), kst1 = KSWZ(32 + sr, sc * 2);
    const int pr_ = tid >> 3, pc = (tid & 7) * 8, pst = PSWZ(pr_, pc * 2);
    const int vb0 = (int)(unsigned)(size_t)V_lds + v_rd_base(lane);
    struct { bf16x8 vs0, vs1, ks0, ks1, kp; } sr_[SDEPTH];
#define SLOAD(i, k0) do { sr_[i].vs0 = *(const bf16x8*)(a.V + (long)((k0) + sr) * a.ldv + sc); sr_[i].vs1 = *(const bf16x8*)(a.V + (long)((k0) + 32 + sr) * a.ldv + sc); \
    sr_[i].ks0 = *(const bf16x8*)(a.K + (long)((k0) + sr) * a.ldk + sc); sr_[i].ks1 = *(const bf16x8*)(a.K + (long)((k0) + 32 + sr) * a.ldk + sc); \
    if constexpr (DQK == 192) sr_[i].kp = *(const bf16x8*)(a.K2 + (long)((k0) + pr_) * a.ldk2 + pc); } while (0)
#define SWRITE(b, i) do { *(LAS bf16x8*)(V_lds + (b) * 16384 + vst0) = sr_[i].vs0; *(LAS bf16x8*)(V_lds + (b) * 16384 + vst1) = sr_[i].vs1; \
    *(LAS bf16x8*)(K_lds + (b) * 16384 + kst0) = sr_[i].ks0; *(LAS bf16x8*)(K_lds + (b) * 16384 + kst1) = sr_[i].ks1; \
    if constexpr (DQK == 192) *(LAS bf16x8*)(P_lds + (b) * 8192 + pst) = sr_[i].kp; } while (0)
#define SWAIT() do { if constexpr (SDEPTH == 2) { if constexpr (DQK == 192) asm volatile("s_waitcnt vmcnt(5)" ::: "memory"); else asm volatile("s_waitcnt vmcnt(4)" ::: "memory"); } \
    else asm volatile("s_waitcnt vmcnt(0)" ::: "memory"); } while (0)
#define RESC(al) do { if (__any((al) < 1.f)) { if (hi == 0) al_l[r32] = (al); asm volatile("s_waitcnt lgkmcnt(0)" ::: "memory"); \
    _Pragma("unroll") for (int r = 0; r < 16; ++r) { const float s_ = al_l[crow(r, hi)]; _Pragma("unroll") for (int d = 0; d < 4; ++d) o[d][r] *= s_; } } } while (0)
    f32x16 pA0, pA1, pB0, pB1; float mnA, mnB, alA, alB; bf16x8 pa0, pa1, pa2, pa3; const int NT = a.L / 64;
    constexpr int SE = 0, SO = SDEPTH - 1;
    SLOAD(SE, 0); asm volatile("s_waitcnt vmcnt(0)" ::: "memory"); SWRITE(0, SE); __syncthreads();
    d_qkt<DQK>(pA0, pA1, K_lds, P_lds, qr, r32, hi); d_partialSM(pA0, pA1, m_reg, mnA, alA, C);
    SLOAD(SO, 64); if constexpr (SDEPTH == 2) { if (2 < NT) SLOAD(SE, 128); }
    SWAIT(); SWRITE(1, SO); __syncthreads();
    for (int j = 1; j + 1 < NT; j += 2) {
        SBAR(); d_qkt<DQK>(pB0, pB1, K_lds + 16384, P_lds + 8192, qr, r32, hi);
        d_finishSM(pA0, pA1, alA, l_reg, pa0, pa1, pa2, pa3); SBAR();
        SLOAD(SO, (j + SDEPTH) * 64); SBAR();
        d_pv(o, vb0, pa0, pa1, pa2, pa3); d_partialSM(pB0, pB1, m_reg, mnB, alB, C);
        __syncthreads(); SWAIT(); SWRITE(0, SE);
        RESC(alB); __syncthreads();
        SBAR(); d_qkt<DQK>(pA0, pA1, K_lds, P_lds, qr, r32, hi);
        d_finishSM(pB0, pB1, alB, l_reg, pa0, pa1, pa2, pa3); SBAR();
        if (SDEPTH == 1 || j + 3 < NT) SLOAD(SE, (j + 1 + SDEPTH) * 64); SBAR();
        d_pv(o, vb0 + 16384, pa0, pa1, pa2, pa3); d_partialSM(pA0, pA1, m_reg, mnA, alA, C);
        __syncthreads(); SWAIT(); SWRITE(1, SO);
        RESC(alA); __syncthreads();
    }
    SBAR(); d_qkt<DQK>(pB0, pB1, K_lds + 16384, P_lds + 8192, qr, r32, hi);
    d_finishSM(pA0, pA1, alA, l_reg, pa0, pa1, pa2, pa3); SBAR();
    d_pv(o, vb0, pa0, pa1, pa2, pa3); d_partialSM(pB0, pB1, m_reg, mnB, alB, C);
    __syncthreads(); RESC(alB);
    d_finishSM(pB0, pB1, alB, l_reg, pa0, pa1, pa2, pa3); SBAR();
    d_pv(o, vb0 + 16384, pa0, pa1, pa2, pa3);
#undef SLOAD
#undef SWRITE
#undef SWAIT
#undef RESC
    if (hi == 0) li_l[r32] = l_reg;
    asm volatile("s_waitcnt lgkmcnt(0)" ::: "memory");
    bf16_t gv[16][4];
#pragma unroll
    for (int r = 0; r < 16; ++r) {
        const bf16_t* gp = a.G + (long)(a.i0 + wid * 32 + crow(r, hi)) * a.ldg + r32;
#pragma unroll
        for (int d0 = 0; d0 < 4; ++d0) gv[r][d0] = gp[d0 * 32];
    }
#pragma unroll
    for (int r = 0; r < 16; ++r) {
        const int row = crow(r, hi);
        const float rl = __builtin_amdgcn_rcpf(li_l[row]);
        const long i = a.i0 + wid * 32 + row;
        bf16_t* op = a.O + i * a.ldo + r32;
#pragma unroll
        for (int d0 = 0; d0 < 4; ++d0) {
            const float g = bf2f(gv[r][d0]);
            const float sg = g * __builtin_amdgcn_rcpf(1.0f + __builtin_amdgcn_exp2f(-LOG2E * g));
            op[d0 * 32] = (bf16_t)cvtpk(o[d0][r] * rl * sg, 0.f);
        }
    }
}


constexpr int D3_V = 0, D3_K = 49152, D3_P = 98304, D3_WS = 122880;
template <int DQK, bool ROPEQ>
__device__ __forceinline__ void attn_dense_unit3(lds_u8* lds, const AttnArgs& a) {
    constexpr int ND0 = DQK / 16;
    const int tid = pg8::opaque_tid(), wid = tid >> 6, lane = tid & 63, r32 = lane & 31, hi = lane >> 5;
    lds_u8* V_lds = lds + D3_V; lds_u8* K_lds = lds + D3_K; lds_u8* P_lds = lds + D3_P;
    LAS float* wsf = (LAS float*)(lds + D3_WS) + wid * 64; LAS float* li_l = wsf; LAS float* al_l = wsf + 32;
    const float C = a.C;
    __syncthreads();
    const int qi = a.i0 + wid * 32 + r32;
    float m_reg = -1e30f, l_reg = 0.f;
    f32x16 o[4];
#pragma unroll
    for (int d = 0; d < 4; ++d)
#pragma unroll
        for (int r = 0; r < 16; ++r) o[d][r] = 0.f;
    bf16x8 qr[ND0];
    {
        const bf16_t* Qw = a.Q + (long)qi * a.ldq + hi * 8;
#pragma unroll
        for (int d0 = 0; d0 < ND0; ++d0) qr[d0] = *(const bf16x8*)(Qw + d0 * 16);
    }
    if constexpr (ROPEQ) {
#pragma unroll
        for (int dd = 0; dd < 2; ++dd) {
            bf16x8 x1 = qr[8 + dd], x2 = qr[10 + dd];
#pragma unroll
            for (int j = 0; j < 8; ++j) {
                const float2 c = a.cs[qi * 32 + dd * 16 + hi * 8 + j];
                const float f1 = bf2f((bf16_t)x1[j]), f2 = bf2f((bf16_t)x2[j]);
                x1[j] = (short)f2bf(f1 * c.x - f2 * c.y); x2[j] = (short)f2bf(f2 * c.x + f1 * c.y);
            }
            qr[8 + dd] = x1; qr[10 + dd] = x2;
        }
    }
    const int sr = tid >> 4, sc = (tid & 15) * 8, vst0 = v_st(sr, sc), vst1 = v_st(32 + sr, sc), kst0 = KSWZ(sr, sc * 2), kst1 = KSWZ(32 + sr, sc * 2);
    const int pr_ = tid >> 3, pc = (tid & 7) * 8, pst = PSWZ(pr_, pc * 2);
    const int vb0 = (int)(unsigned)(size_t)V_lds + v_rd_base(lane);
    bf16x8 s_vs0, s_vs1, s_ks0, s_ks1, s_kp;
#define SLOAD(k0) do { s_vs0 = *(const bf16x8*)(a.V + (long)((k0) + sr) * a.ldv + sc); s_vs1 = *(const bf16x8*)(a.V + (long)((k0) + 32 + sr) * a.ldv + sc); \
    s_ks0 = *(const bf16x8*)(a.K + (long)((k0) + sr) * a.ldk + sc); s_ks1 = *(const bf16x8*)(a.K + (long)((k0) + 32 + sr) * a.ldk + sc); \
    if constexpr (DQK == 192) s_kp = *(const bf16x8*)(a.K2 + (long)((k0) + pr_) * a.ldk2 + pc); } while (0)
#define SWRITE(b) do { *(LAS bf16x8*)(V_lds + (b) * 16384 + vst0) = s_vs0; *(LAS bf16x8*)(V_lds + (b) * 16384 + vst1) = s_vs1; \
    *(LAS bf16x8*)(K_lds + (b) * 16384 + kst0) = s_ks0; *(LAS bf16x8*)(K_lds + (b) * 16384 + kst1) = s_ks1; \
    if constexpr (DQK == 192) *(LAS bf16x8*)(P_lds + (b) * 8192 + pst) = s_kp; } while (0)
#define RESC(al) do { if (__any((al) < 1.f)) { if (hi == 0) al_l[r32] = (al); asm volatile("s_waitcnt lgkmcnt(0)" ::: "memory"); \
    _Pragma("unroll") for (int r = 0; r < 16; ++r) { const float s_ = al_l[crow(r, hi)]; _Pragma("unroll") for (int d = 0; d < 4; ++d) o[d][r] *= s_; } } } while (0)
#define ROT() do { bv = bq; bq = bw; bw = (bw == 2) ? 0 : bw + 1; } while (0)
    f32x16 pA0, pA1, pB0, pB1; float mnA, mnB, alA, alB; bf16x8 pa0, pa1, pa2, pa3; const int NT = a.L / 64;
    SLOAD(0); SWRITE(0); SLOAD(64); SWRITE(1); SLOAD(128); __syncthreads();
    d_qkt<DQK>(pA0, pA1, K_lds, P_lds, qr, r32, hi); d_partialSM(pA0, pA1, m_reg, mnA, alA, C);
    int bq = 1, bv = 0, bw = 2;
    for (int j = 1; j + 1 < NT; j += 2) {
        SBAR(); d_qkt<DQK>(pB0, pB1, K_lds + bq * 16384, P_lds + bq * 8192, qr, r32, hi);
        d_finishSM(pA0, pA1, alA, l_reg, pa0, pa1, pa2, pa3); SBAR();
        d_pv(o, vb0 + bv * 16384, pa0, pa1, pa2, pa3); d_partialSM(pB0, pB1, m_reg, mnB, alB, C);
        SWRITE(bw);
        if (j + 2 < NT) SLOAD((j + 2) * 64);
        RESC(alB); __syncthreads(); ROT();
        SBAR(); d_qkt<DQK>(pA0, pA1, K_lds + bq * 16384, P_lds + bq * 8192, qr, r32, hi);
        d_finishSM(pB0, pB1, alB, l_reg, pa0, pa1, pa2, pa3); SBAR();
        d_pv(o, vb0 + bv * 16384, pa0, pa1, pa2, pa3); d_partialSM(pA0, pA1, m_reg, mnA, alA, C);
        if (j + 2 < NT) SWRITE(bw);
        if (j + 3 < NT) SLOAD((j + 3) * 64);
        RESC(alA); __syncthreads(); ROT();
    }
    SBAR(); d_qkt<DQK>(pB0, pB1, K_lds + bq * 16384, P_lds + bq * 8192, qr, r32, hi);
    d_finishSM(pA0, pA1, alA, l_reg, pa0, pa1, pa2, pa3); SBAR();
    d_pv(o, vb0 + bv * 16384, pa0, pa1, pa2, pa3); d_partialSM(pB0, pB1, m_reg, mnB, alB, C);
    RESC(alB);
    d_finishSM(pB0, pB1, alB, l_reg, pa0, pa1, pa2, pa3); SBAR();
    d_pv(o, vb0 + bq * 16384, pa0, pa1, pa2, pa3);
#undef SLOAD
#undef SWRITE
#undef RESC
#undef ROT
    if (hi == 0) li_l[r32] = l_reg;
    asm volatile("s_waitcnt lgkmcnt(0)" ::: "memory");
    bf16_t gv[16][4];
#pragma unroll
    for (int r = 0; r < 16; ++r) {
        const bf16_t* gp = a.G + (long)(a.i0 + wid * 32 + crow(r, hi)) * a.ldg + r32;
#pragma unroll
        for (int d0 = 0; d0 < 4; ++d0) gv[r][d0] = gp[d0 * 32];
    }
#pragma unroll
    for (int r = 0; r < 16; ++r) {
        const int row = crow(r, hi);
        const float rl = __builtin_amdgcn_rcpf(li_l[row]);
        const long i = a.i0 + wid * 32 + row;
        bf16_t* op = a.O + i * a.ldo + r32;
#pragma unroll
        for (int d0 = 0; d0 < 4; ++d0) {
            const float g = bf2f(gv[r][d0]);
            const float sg = g * __builtin_amdgcn_rcpf(1.0f + __builtin_amdgcn_exp2f(-LOG2E * g));
            op[d0 * 32] = (bf16_t)cvtpk(o[d0][r] * rl * sg, 0.f);
        }
    }
}

constexpr int BL_WS = 131072, BL_LUT = 133120, BL_LUTSTRIDE = 260;
constexpr int BL_LUT2 = 65536, BL_LUT2MARGIN = 320, BL_LUT2STRIDE = 960;
struct BandArgs {
    const bf16_t* Q; long ldq;
    const bf16_t* K; const bf16_t* V; long ldk;
    const bf16_t* G; long ldg; bf16_t* O; long ldo;
    float* lse; long ldl;
    const float* bias; const float* sinks;
    int i0, L, side, dil, nt;
    float C;
};
template <int NH, bool SINK, bool WLSE, int PROBE = 0>
__device__ __forceinline__ void attn_band_unit(lds_u8* lds, const BandArgs& a) {
    constexpr int WPH = 8 / NH;
    const int tid = pg8::opaque_tid(), wid = tid >> 6, lane = tid & 63, r32 = lane & 31, hi = lane >> 5;
    const int hw = wid / WPH, rb = wid % WPH;
    LAS float* wsf = (LAS float*)(lds + BL_WS) + wid * 64; LAS float* li_l = wsf; LAS float* al_l = wsf + 32;
    LAS float* lut = (LAS float*)(lds + BL_LUT2) + hw * BL_LUT2STRIDE + BL_LUT2MARGIN;
    const int side = a.side, nlut = 2 * side + 1;
    __syncthreads();
    const int qi = a.i0 + rb * 32 + r32;
    bf16x8 qr[8];
    {
        const bf16_t* Qw = a.Q + hw * 128 + (long)qi * a.ldq + hi * 8;
#pragma unroll
        for (int d0 = 0; d0 < 8; ++d0) qr[d0] = *(const bf16x8*)(Qw + d0 * 16);
    }
    const int t_lo = (a.i0 >= side) ? 0 : (side - a.i0) / 64;
    int t_hi = (a.L - a.i0 + side) / 64; if (t_hi > a.nt) t_hi = a.nt;
    const int lo_w = rb >> 1, hi_w = (rb * 32 + 31 + 2 * side) >> 6;
    const int sr = tid >> 4, sc = (tid & 15) * 8;
    const int vst0 = v_st(sr, sc), vst1 = v_st(32 + sr, sc), kst0 = KSWZ(sr, sc * 2), kst1 = KSWZ(32 + sr, sc * 2);
    const int vbase = (int)(unsigned)(size_t)(lds + 16384) + v_rd_base(lane);
    constexpr int GT = 2;
    bf16x8 st[GT][4];
#define BLOAD(G0) do { _Pragma("unroll") for (int tt = 0; tt < GT; ++tt) { int T_ = (G0) + tt; if (T_ < t_lo) T_ = t_lo; if (T_ > t_hi - 1) T_ = t_hi - 1; \
            const long kb_ = (long)(a.i0 - side + 64 * T_); \
            st[tt][0] = *(const bf16x8*)(a.K + (kb_ + sr) * a.ldk + sc); st[tt][1] = *(const bf16x8*)(a.K + (kb_ + 32 + sr) * a.ldk + sc); \
            st[tt][2] = *(const bf16x8*)(a.V + (kb_ + sr) * a.ldk + sc); st[tt][3] = *(const bf16x8*)(a.V + (kb_ + 32 + sr) * a.ldk + sc); } } while (0)
    float m_reg = -1e29f, l_reg = 0.f;
    f32x16 o[4];
#pragma unroll
    for (int d = 0; d < 4; ++d)
#pragma unroll
        for (int r = 0; r < 16; ++r) o[d][r] = 0.f;
    const int g_lo = (t_lo / GT) * GT;
    BLOAD(g_lo);
    for (int idx = tid; idx < NH * nlut; idx += 512) { const int h = idx / nlut, e = idx - h * nlut;
        ((LAS float*)(lds + BL_LUT2))[h * BL_LUT2STRIDE + BL_LUT2MARGIN + e] = a.bias[rel_bucket((e - side) * a.dil) * 20 + h] * LOG2E; }
    for (int G0 = g_lo; G0 < t_hi; G0 += GT) {
        __syncthreads();
#pragma unroll
        for (int tt = 0; tt < GT; ++tt) {
            *(LAS bf16x8*)(lds + tt * 32768 + kst0) = st[tt][0]; *(LAS bf16x8*)(lds + tt * 32768 + kst1) = st[tt][1];
            *(LAS bf16x8*)(lds + tt * 32768 + 16384 + vst0) = st[tt][2]; *(LAS bf16x8*)(lds + tt * 32768 + 16384 + vst1) = st[tt][3];
        }
        if (G0 + GT < t_hi) BLOAD(G0 + GT);
        __syncthreads();
#pragma unroll 1
        for (int tt = 0; tt < GT; ++tt) {
            const int T = G0 + tt;
            if (T < t_lo || T >= t_hi || T < lo_w || T > hi_w) continue;
            if (PROBE >= 2) { l_reg += ((const LAS float*)(lds + tt * 32768))[tid]; continue; }
            const lds_u8* Kl = lds + tt * 32768; const int vb0 = vbase + tt * 32768;
            f32x16 p0, p1;
#pragma unroll
            for (int r = 0; r < 16; ++r) { p0[r] = 0.f; p1[r] = 0.f; }
#pragma unroll
            for (int d0 = 0; d0 < 8; ++d0) { const int cb = (d0 * 16 + hi * 8) * 2;
                const bf16x8 b0 = *(const LAS bf16x8*)(Kl + KSWZ(r32, cb)), b1 = *(const LAS bf16x8*)(Kl + KSWZ(32 + r32, cb));
                p0 = __builtin_amdgcn_mfma_f32_32x32x16_bf16(b0, qr[d0], p0, 0, 0, 0);
                p1 = __builtin_amdgcn_mfma_f32_32x32x16_bf16(b1, qr[d0], p1, 0, 0, 0); }
            const int base = a.i0 + 64 * T - qi;
            const LAS float* lrow = lut + base + 4 * hi;
            const int wlo = 64 * T - rb * 32 - 31, whi = 64 * T - rb * 32 + 63;
            if (wlo >= 0 && whi <= 2 * side) {
#pragma unroll
                for (int r = 0; r < 16; ++r) { const int c_ = (r & 3) + 8 * (r >> 2);
                    p0[r] = fmaf(p0[r], a.C, lrow[c_]); p1[r] = fmaf(p1[r], a.C, lrow[c_ + 32]); }
            } else {
                const int b0i = base + 4 * hi;
#pragma unroll
                for (int r = 0; r < 16; ++r) { const int c_ = (r & 3) + 8 * (r >> 2);
                    const bool ok0 = (unsigned)(b0i + c_) <= (unsigned)(2 * side), ok1 = (unsigned)(b0i + c_ + 32) <= (unsigned)(2 * side);
                    const float v0 = fmaf(p0[r], a.C, lrow[c_]), v1 = fmaf(p1[r], a.C, lrow[c_ + 32]);
                    p0[r] = ok0 ? v0 : -1e30f; p1[r] = ok1 ? v1 : -1e30f; }
            }
            float pmax = p0[0];
#pragma unroll
            for (int r = 1; r < 16; ++r) pmax = fmaxf(pmax, p0[r]);
#pragma unroll
            for (int r = 0; r < 16; ++r) pmax = fmaxf(pmax, p1[r]);
            { auto rr = __builtin_amdgcn_permlane32_swap(__float_as_uint(pmax), __float_as_uint(pmax), false, false);
              pmax = fmaxf(__uint_as_float(rr[0]), __uint_as_float(rr[1])); }
            const float mn = fmaxf(m_reg, pmax);
            const float alpha = __builtin_amdgcn_exp2f(m_reg - mn);
            m_reg = mn;
            float ps = 0.f;
#pragma unroll
            for (int r = 0; r < 16; ++r) { p0[r] = __builtin_amdgcn_exp2f(p0[r] - mn); p1[r] = __builtin_amdgcn_exp2f(p1[r] - mn); ps += p0[r] + p1[r]; }
            { auto rr = __builtin_amdgcn_permlane32_swap(__float_as_uint(ps), __float_as_uint(ps), false, false);
              ps = __uint_as_float(rr[0]) + __uint_as_float(rr[1]); }
            l_reg = l_reg * alpha + ps;
            if (__any(alpha < 1.f)) {
                if (hi == 0) al_l[r32] = alpha;
                asm volatile("s_waitcnt lgkmcnt(0)" ::: "memory");
#pragma unroll
                for (int r = 0; r < 16; ++r) { const float al = al_l[crow(r, hi)];
#pragma unroll
                    for (int d = 0; d < 4; ++d) o[d][r] *= al; }
            }
            bf16x8 pa0, pa1, pa2, pa3;
#define PK4(P, BASE, OUT) do { unsigned a0 = cvtpk(P[BASE + 0], P[BASE + 1]), a1 = cvtpk(P[BASE + 2], P[BASE + 3]);   \
    unsigned b0 = cvtpk(P[BASE + 4], P[BASE + 5]), b1 = cvtpk(P[BASE + 6], P[BASE + 7]);                              \
    auto r0 = __builtin_amdgcn_permlane32_swap(a0, b0, false, false); auto r1 = __builtin_amdgcn_permlane32_swap(a1, b1, false, false); \
    u32x4 w = {r0[0], r1[0], r0[1], r1[1]}; OUT = *reinterpret_cast<bf16x8*>(&w); } while (0)
            PK4(p0, 0, pa0); PK4(p0, 8, pa1); PK4(p1, 0, pa2); PK4(p1, 8, pa3);
#undef PK4
            pv_one<0>(o[0], vb0, pa0, pa1, pa2, pa3); pv_one<1>(o[1], vb0, pa0, pa1, pa2, pa3);
            pv_one<2>(o[2], vb0, pa0, pa1, pa2, pa3); pv_one<3>(o[3], vb0, pa0, pa1, pa2, pa3);
        }
    }
#undef BLOAD
    if (PROBE >= 1) { float acc_ = l_reg + m_reg; for (int d = 0; d < 4; ++d) for (int r = 0; r < 16; ++r) acc_ += o[d][r]; if (acc_ == 12345.678f) a.O[tid] = 0; return; }
    if (SINK) l_reg += __builtin_amdgcn_exp2f(a.sinks[hw] * LOG2E - m_reg);
    if (hi == 0) li_l[r32] = l_reg;
    if (WLSE) { if (hi == 0) a.lse[hw + (long)qi * a.ldl] = (m_reg + __builtin_amdgcn_logf(l_reg)) * LN2; }
    asm volatile("s_waitcnt lgkmcnt(0)" ::: "memory");
    bf16_t gv[16][4];
#pragma unroll
    for (int r = 0; r < 16; ++r) {
        const bf16_t* gp = a.G + hw * 128 + (long)(a.i0 + rb * 32 + crow(r, hi)) * a.ldg + r32;
#pragma unroll
        for (int d0 = 0; d0 < 4; ++d0) gv[r][d0] = gp[d0 * 32];
    }
#pragma unroll
    for (int r = 0; r < 16; ++r) {
        const int row = crow(r, hi);
        const float rl = __builtin_amdgcn_rcpf(li_l[row]);
        const long i = a.i0 + rb * 32 + row;
        bf16_t* op = a.O + hw * 128 + i * a.ldo + r32;
#pragma unroll
        for (int d0 = 0; d0 < 4; ++d0) {
            const float g = bf2f(gv[r][d0]);
            const float sg = g * __builtin_amdgcn_rcpf(1.0f + __builtin_amdgcn_exp2f(-LOG2E * g));
            op[d0 * 32] = (bf16_t)cvtpk(o[d0][r] * rl * sg, 0.f);
        }
    }
}

__device__ __forceinline__ void attn_phase(lds_u8* lds, const Params& p, int layer, int wg, int nwg) {
    unsigned char* ws = p.ws;
    const bf16_t* proj = (const bf16_t*)(ws + WS_PROJ);
    bf16_t* mixed = (bf16_t*)(ws + WS_MIXED);
    const float2* cs = (const float2*)(ws + WS_CS);
    constexpr int NA = 256, NC = 256, ND = 256, NBU = 384;
    for (int rep = 0; rep < REP_BAND; ++rep)
    for (int it = (rep == 0 ? wg : NA + NC + wg); it < NA + NC + ND + NBU; it += nwg) {
        AttnArgs a; a.lse = nullptr; a.ldl = 0; a.cs = cs; a.side = 0; a.dil = 1; a.bias = p.rel_bias; a.bcol = 0; a.sink2 = 0.f; a.K2 = nullptr; a.ldk2 = 0; a.L = SEQ;
        if (it < NA) {
            #ifdef LINEAR_MAP
            const int c = it, bh = c >> 4, qb = c & 15, b = bh >> 3, h = bh & 7;
#else
            const int c = it, xcd = c & 7, slot = c >> 3, bh = xcd * 2 + (slot >> 4), qb = slot & 15, b = bh >> 3, h = bh & 7;
#endif
            const size_t t0 = (size_t)b * SEQ;
            const bf16_t* qraw = (const bf16_t*)(ws + WS_QRAW); const bf16_t* kvraw = (const bf16_t*)(ws + WS_KVRAW); const bf16_t* kpe = (const bf16_t*)(ws + WS_KPE);
            a.Q = qraw + t0 * 1536 + h * 192; a.ldq = 1536;
            a.K = kvraw + t0 * 2048 + h * 256; a.ldk = 2048; a.K2 = kpe + t0 * 64; a.ldk2 = 64;
            a.V = kvraw + t0 * 2048 + h * 256 + 128; a.ldv = 2048;
            a.G = proj + t0 * NINP + C_GATE + MX_A + h * 128; a.ldg = NINP;
            a.O = mixed + t0 * MIXW + MX_A + h * 128; a.ldo = MIXW;
            a.i0 = qb * 256; a.C = 0.07216878364870322f * LOG2E;
#ifdef SIMPLE_DENSE
            attn_unit<192, false, false, false, true>(lds, a);
#else
            #ifndef DENSE3BUF
            for (int rep = 0; rep < REP_A; ++rep) attn_dense_unit<192, true, 1>(lds, a);
#else
            for (int rep = 0; rep < REP_A; ++rep) attn_dense_unit3<192, true>(lds, a);
#endif
#endif
        } else if (it < NA + NC) {
            #ifdef LINEAR_MAP
            const int c = it - NA, pair = c >> 4, qb = c & 15, b = pair >> 3, hq = pair & 7, hk = hq >> 2;
#else
            const int c = it - NA, xcd = c & 7, slot = c >> 3, pair = xcd * 2 + (slot >> 4), qb = slot & 15, b = pair >> 3, hq = pair & 7, hk = hq >> 2;
#endif
            const size_t t0 = (size_t)b * SEQ;
            const bf16_t* qc = (const bf16_t*)(ws + WS_QC); const bf16_t* kc = (const bf16_t*)(ws + WS_KC);
            a.Q = qc + t0 * 1024 + hq * 128; a.ldq = 1024;
            a.K = kc + t0 * 256 + hk * 128; a.ldk = 256;
            a.V = proj + t0 * NINP + C_CV + hk * 128; a.ldv = NINP;
            a.G = proj + t0 * NINP + C_GATE + MX_C + hq * 128; a.ldg = NINP;
            a.O = mixed + t0 * MIXW + MX_C + hq * 128; a.ldo = MIXW;
            a.i0 = qb * 256; a.C = 0.08838834764831845f * LOG2E;
#ifdef SIMPLE_DENSE
            attn_unit<128, false, false, false, false>(lds, a);
#else
            #ifndef DENSE3BUF
            for (int rep = 0; rep < REP_C; ++rep) attn_dense_unit<128, false, 2>(lds, a);
#else
            for (int rep = 0; rep < REP_C; ++rep) attn_dense_unit3<128, false>(lds, a);
#endif
#endif
        } else if (it < NA + NC + ND) {
            const int c = it - NA - NC, blk = c & 63, hk = (c >> 6) & 1, b = c >> 7;
            const size_t t0 = (size_t)b * SEQ;
            BandArgs d;
            d.Q = proj + t0 * NINP + C_DQ + hk * 512; d.ldq = NINP;
            d.K = proj + t0 * NINP + C_DK + hk * 128; d.V = proj + t0 * NINP + C_DV + hk * 128; d.ldk = NINP;
            d.G = proj + t0 * NINP + C_GATE + MX_D + hk * 512; d.ldg = NINP;
            d.O = mixed + t0 * MIXW + MX_D + hk * 512; d.ldo = MIXW;
            d.lse = nullptr; d.ldl = 0; d.bias = p.rel_bias + 12 + hk * 4; d.sinks = p.sinks + layer * 8 + hk * 4;
            d.i0 = blk * 64; d.L = SEQ; d.side = 128; d.dil = 1; d.nt = 5; d.C = 0.08838834764831845f * LOG2E;
#if defined(PROBE_D)
            attn_band_unit<4, true, false, PROBE_D>(lds, d);
#endif
            for (int rep2 = 0; rep2 < REP_D; ++rep2) attn_band_unit<4, true, false>(lds, d);
        } else {
            const int c = it - NA - NC - ND, u = c & 15, hh = (c >> 4) & 3, j = (c >> 6) % 3, b = c / 192;
            const int dil = (j == 0) ? 1 : (j == 1 ? 4 : 16), L = SEQ / dil, nblk = L / 256, r = u / nblk, qb = u % nblk;
            const size_t t0 = (size_t)b * SEQ + r; const int head = j * 4 + hh;
            BandArgs d;
            d.Q = proj + t0 * NINP + C_BQ + head * 128; d.ldq = (long)dil * NINP;
            d.K = proj + t0 * NINP + C_BK + head * 128; d.V = proj + t0 * NINP + C_BV + head * 128; d.ldk = (long)dil * NINP;
            d.G = proj + t0 * NINP + C_GATE + MX_B + head * 128; d.ldg = (long)dil * NINP;
            d.O = mixed + t0 * MIXW + MX_B + head * 128; d.ldo = (long)dil * MIXW;
            d.lse = (float*)(ws + WS_LSE) + ((size_t)j * MTOK + t0) * 4 + hh; d.ldl = (long)dil * 4;
            d.bias = p.rel_bias + head; d.sinks = nullptr;
            d.i0 = qb * 256; d.L = L; d.side = 64; d.dil = dil; d.nt = 6; d.C = 0.08838834764831845f * LOG2E;
            for (int rep2 = 0; rep2 < REP_B; ++rep2) attn_band_unit<1, false, true>(lds, d);
        }
    }
}

#define XB_TMO      128
#define XB_XCNT(j)  (256  + 64 * (j))
#define XB_XSUB(j)  (1280 + 64 * (j))
#define XB_XGEN(j)  (2304 + 64 * (j))
#define XB_TOP      3328
#define XB_TOPGEN   3392
#define XCD_BAR_WORDS 3456
#define XB_SPIN_CAP (1u << 18)

__device__ __forceinline__ unsigned xb_ld(unsigned* p)              { return __hip_atomic_load(p, __ATOMIC_RELAXED, __HIP_MEMORY_SCOPE_AGENT); }
__device__ __forceinline__ unsigned xb_add(unsigned* p, unsigned v) { return __hip_atomic_fetch_add(p, v, __ATOMIC_RELAXED, __HIP_MEMORY_SCOPE_AGENT); }
__device__ __forceinline__ unsigned xb_xcc_id() { return (unsigned)__builtin_amdgcn_s_getreg((3 << 11) | 20) & 0xFu; }
#define XB_SPIN(cond, bar) do { unsigned _sp = 0; while (cond) { __builtin_amdgcn_s_sleep(1); \
    if ((++_sp & 255u) == 0u) { if (xb_ld(&(bar)[XB_TMO])) break; if (_sp > XB_SPIN_CAP) { atomicAdd(&(bar)[XB_TMO], 1u); break; } } } } while (0)

struct XcdBarrier {
    unsigned* bar; unsigned x;
    volatile LAS unsigned* st;
};

__device__ __forceinline__ XcdBarrier xcd_barrier_post(unsigned* bar, volatile LAS unsigned* st) {
    XcdBarrier b; b.bar = bar; b.x = xb_xcc_id(); b.st = st;
    if (threadIdx.x == 0) (void)xb_add(&bar[XB_XCNT(b.x)], 1u);
    return b;
}
__device__ __forceinline__ void xcd_barrier_complete(unsigned* bar, unsigned x, unsigned& nloc, unsigned& nx) {
    const unsigned G = gridDim.x * gridDim.y * gridDim.z;
    unsigned sum, cnt, mine, sp = 0u;
    for (;;) {
        sum = 0u; cnt = 0u; mine = 0u;
#pragma unroll
        for (unsigned j = 0; j < 16; ++j) { const unsigned c = xb_ld(&bar[XB_XCNT(j)]); sum += c; cnt += (c > 0u) ? 1u : 0u; mine = (j == x) ? c : mine; }
        if (sum == G) break;
        __builtin_amdgcn_s_sleep(1);
        if ((++sp & 255u) == 0u) { if (xb_ld(&bar[XB_TMO])) break; if (sp > XB_SPIN_CAP) { atomicAdd(&bar[XB_TMO], 1u); break; } }
    }
    nloc = mine > 0u ? mine : 1u; nx = cnt > 0u ? cnt : 1u;
}

__device__ __forceinline__ void xcd_barrier(const XcdBarrier& b) {
    asm volatile("s_waitcnt vmcnt(0)" ::: "memory");
    __syncthreads();
    if (threadIdx.x == 0) {
        unsigned* bar = b.bar;
        __builtin_amdgcn_s_waitcnt(0);
        unsigned nloc = b.st[0], nx = b.st[1];
        if (nloc == 0u) { xcd_barrier_complete(bar, b.x, nloc, nx); b.st[0] = nloc; b.st[1] = nx; }
        const unsigned old = xb_add(&bar[XB_XSUB(b.x)], 1u);
        const unsigned gen = old / nloc;
        if (old + 1u == (gen + 1u) * nloc) {
            __builtin_amdgcn_fence(__ATOMIC_RELEASE, "agent");
            asm volatile("s_waitcnt vmcnt(0)" ::: "memory");
            const unsigned og = xb_add(&bar[XB_TOP], 1u);
            const unsigned tg = og / nx;
            if (og + 1u == (tg + 1u) * nx) xb_add(&bar[XB_TOPGEN], 1u);
            else XB_SPIN(xb_ld(&bar[XB_TOPGEN]) == tg, bar);
            __builtin_amdgcn_fence(__ATOMIC_ACQUIRE, "agent");
            xb_add(&bar[XB_XGEN(b.x)], 1u);
            asm volatile("s_waitcnt vmcnt(0)" ::: "memory");
        } else {
            XB_SPIN(xb_ld(&bar[XB_XGEN(b.x)]) == gen, bar);
            __builtin_amdgcn_fence(__ATOMIC_ACQUIRE, "agent");
            asm volatile("s_waitcnt vmcnt(0)" ::: "memory");
        }
    }
    __syncthreads();
}

__global__ void __launch_bounds__(512) hymba_fwd(Params p0) {
    extern __shared__ __attribute__((aligned(16))) unsigned char shm[];
    lds_u8* lds = (lds_u8*)shm;
    cg::grid_group grid = cg::this_grid();
    const int wg0 = blockIdx.x, nwg0 = gridDim.x;
    const int lo = p0.ph_lo, hi = p0.ph_hi;
    if (lo < 0) grid.sync();
    volatile LAS unsigned* bst = (volatile LAS unsigned*)(lds + LDS_BYTES - 256);
    if (threadIdx.x == 0) { bst[0] = 0u; bst[1] = 0u; }
    __syncthreads();
    XcdBarrier xbar = xcd_barrier_post((unsigned*)(p0.ws + WS_BAR), bst);
    int ph = 0;
#define PH_BEGIN if (lo <= ph && ph < hi) { auto kp4 = (__attribute__((address_space(4))) const char*)__builtin_amdgcn_kernarg_segment_ptr(); asm volatile("" : "+s"(kp4)); \
    const Params& p = *(const Params*)kp4; unsigned char* ws = p.ws; int wg = wg0, nwg = nwg0; asm volatile("" : "+s"(wg), "+s"(nwg)); \
    bf16_t* WinT = (bf16_t*)(ws + WS_WIN); bf16_t* WoutT = (bf16_t*)(ws + WS_WOUT); bf16_t* WuqT = (bf16_t*)(ws + WS_WUQ); bf16_t* WukvT = (bf16_t*)(ws + WS_WUKV); \
    bf16_t* H = (bf16_t*)(ws + WS_H); bf16_t* PROJ = (bf16_t*)(ws + WS_PROJ); float* X1 = (float*)(ws + WS_X1); \
    bf16_t* QAN = (bf16_t*)(ws + WS_QAN); bf16_t* KVAN = (bf16_t*)(ws + WS_KVAN); bf16_t* KPE = (bf16_t*)(ws + WS_KPE); \
    bf16_t* QRAW = (bf16_t*)(ws + WS_QRAW); bf16_t* KVRAW = (bf16_t*)(ws + WS_KVRAW); bf16_t* QC = (bf16_t*)(ws + WS_QC); bf16_t* KC = (bf16_t*)(ws + WS_KC); \
    bf16_t* MIXED = (bf16_t*)(ws + WS_MIXED); bf16_t* DELTA = (bf16_t*)(ws + WS_DELTA); (void)DELTA; float* LSE = (float*)(ws + WS_LSE); float2* CS = (float2*)(ws + WS_CS); \
    (void)WinT; (void)WoutT; (void)WuqT; (void)WukvT; (void)H; (void)PROJ; (void)X1; (void)QAN; (void)KVAN; (void)KPE; (void)QRAW; (void)KVRAW; (void)QC; (void)KC; (void)MIXED; (void)LSE; (void)CS;
#define PH_END } if (lo <= ph && ph + 1 < hi) xcd_barrier(xbar); ++ph;

    PH_BEGIN
        for (int l = 1; l >= 0; --l) {
            cvt_transpose(p.w_ukv + (size_t)l * 512 * 2048, WukvT + (size_t)l * 2048 * 512, 512, 2048, 2048, lds, wg, nwg);
            cvt_transpose(p.w_uq + (size_t)l * 768 * 1536, WuqT + (size_t)l * 1536 * 768, 768, 1536, 1536, lds, wg, nwg);
            cvt_transpose(p.w_in + (size_t)l * DM * NIN, WinT + (size_t)l * NINP * DM, DM, NIN, NINP, lds, wg, nwg);
        }
        build_cs(CS, wg, nwg);
        rmsnorm_rows<0, true>(p.x, nullptr, nullptr, p.g_attn, H, nullptr, wg, nwg);
    PH_END

#pragma unroll 1
    for (int l = 0; l < 2; ++l) {
        if (l > 0) {
            PH_BEGIN
                rmsnorm_rows<1, true>(p.x, DELTA, nullptr, p.g_attn + (size_t)l * DM, H, nullptr, wg, nwg);
            PH_END
        }
        PH_BEGIN
#ifndef NO_GEMM
            pg8::Gemm g{H, WinT + (size_t)l * NINP * DM, MTOK, NINP, DM}; pg8::RevColOrder S; S.init(MTOK, NINP, nwg, wg);
            pg8::EpiBf16P E{PROJ, NINP};
            for (int rep = 0; rep < REP_GEMM; ++rep)
            pg8::gemm_phase<pg8::EpiBf16P, pg8::RevColOrder, GEMM_ALIGN, GEMM_SP2>(lds, g, S, E);
            if (CVT_P0_LAYERS == 1 && l == 0 && nwg == 256 && wg >= 192)
                cvt_transpose(p.w_in + (size_t)DM * NIN, WinT + (size_t)NINP * DM, DM, NIN, NINP, lds, wg - 192, 64);
#endif
        PH_END
        PH_BEGIN
            for (int rep = 0; rep < REP_MISC; ++rep) prep_tokens(PROJ, p.g_qa + l * 768, p.g_kva + l * 512, p.g_qn + l * 128, p.g_kn + l * 128, CS, QAN, KVAN, KPE, QC, KC, (bf16_t*)(ws + WS_DKV), wg, nwg);
        PH_END
        PH_BEGIN
#ifndef NO_GEMM
            for (int rep = 0; rep < REP_UP; ++rep) {
            { pg8::Gemm g{QAN, WuqT + (size_t)l * 1536 * 768, MTOK, 1536, 768}; pg8::StaticOrder S; S.init(MTOK, 1536, nwg, wg);
              pg8::EpiBf16P E{QRAW, 1536};
              pg8::gemm_phase<pg8::EpiBf16P, pg8::StaticOrder, GEMM_ALIGN, GEMM_SP2>(lds, g, S, E); }
            { pg8::Gemm g{KVAN, WukvT + (size_t)l * 2048 * 512, MTOK, 2048, 512}; pg8::StaticOrder S; S.init(MTOK, 2048, nwg, nwg - 1 - wg);
              pg8::EpiBf16P E{KVRAW, 2048};
              pg8::gemm_phase<pg8::EpiBf16P, pg8::StaticOrder, GEMM_ALIGN, GEMM_SP2>(lds, g, S, E); }
            }
#endif
        PH_END
        PH_BEGIN
#ifndef NO_ATTN
            for (int rep = 0; rep < REP_ATTN; ++rep) attn_phase(lds, p, l, wg, nwg);
            if ((CVT_P0_LAYERS == 1 || HIDE_TAIL) && l == 0 && nwg == 256 && wg >= 128) {
                cvt_transpose(p.w_out + (size_t)MIXW * DM, WoutT + (size_t)DM * MIXW, MIXW, DM, DM, lds, wg - 128, 128);
                cvt_transpose(p.w_uq + (size_t)768 * 1536, WuqT + (size_t)1536 * 768, 768, 1536, 1536, lds, wg - 128, 128);
                cvt_transpose(p.w_ukv + (size_t)512 * 2048, WukvT + (size_t)2048 * 512, 512, 2048, 2048, lds, wg - 128, 128);
            }
#endif
        PH_END
        PH_BEGIN
            cvt_transpose(p.w_out + (size_t)l * MIXW * DM, WoutT + (size_t)l * DM * MIXW, MIXW, DM, DM, lds, wg, nwg);
            fixup_b(MIXED, LSE, wg, nwg);
        PH_END
        PH_BEGIN
#ifndef NO_GEMM
            pg8::Gemm g{MIXED, WoutT + (size_t)l * DM * MIXW, MTOK, DM, MIXW}; pg8::StaticOrder S; S.init(MTOK, DM, nwg, wg);
            pg8::EpiBf16P E{DELTA + (size_t)l * MTOK * DM, DM};
            for (int rep = 0; rep < REP_OUT; ++rep)
            pg8::gemm_phase<pg8::EpiBf16P, pg8::StaticOrder, GEMM_ALIGN, GEMM_SP2>(lds, g, S, E);
#endif
        PH_END
    }
    for (int rep = 0; rep < REP_SYNC; ++rep) xcd_barrier(xbar);
    PH_BEGIN
        rmsnorm_rows<2, false>(p.x, DELTA, DELTA + (size_t)MTOK * DM, p.g_final, nullptr, p.out, wg, nwg);
    PH_END
#undef PH_BEGIN
#undef PH_END
}

constexpr int N_PHASES = 15;

extern "C" void kernel_launch(void* const* d_in, const int* in_sizes, int n_in, void* d_out, int out_size, void* d_ws, size_t ws_size, hipStream_t stream) {
    static int grid_blocks = 0;
    if (grid_blocks == 0) {
        if (n_in != 13 || ws_size < WS_END || out_size != MTOK * DM) { fprintf(stderr, "kernel_launch: unexpected shapes (n_in %d, out %d, ws %zu, need %zu)\n", n_in, out_size, ws_size, (size_t)WS_END); grid_blocks = -1; return; }
        int dev = 0, cus = 0, per_cu = 0;
        hipGetDevice(&dev);
        hipDeviceGetAttribute(&cus, hipDeviceAttributeMultiprocessorCount, dev);
        if (hipFuncSetAttribute((const void*)hymba_fwd, hipFuncAttributeMaxDynamicSharedMemorySize, LDS_BYTES) != hipSuccess) { fprintf(stderr, "kernel_launch: hipFuncSetAttribute failed\n"); grid_blocks = -1; return; }
        if (hipOccupancyMaxActiveBlocksPerMultiprocessor(&per_cu, (const void*)hymba_fwd, 512, LDS_BYTES) != hipSuccess || per_cu < 1) { fprintf(stderr, "kernel_launch: occupancy query gave %d\n", per_cu); per_cu = 1; }
        (void)hipGetLastError();
        grid_blocks = cus * 1;
        fprintf(stderr, "kernel_launch: cus %d per_cu %d grid %d\n", cus, per_cu, grid_blocks);
    }
    if (grid_blocks < 0) return;
    Params p{};
    p.x = (const float*)d_in[0]; p.g_attn = (const float*)d_in[1]; p.w_in = (const float*)d_in[2]; p.g_qa = (const float*)d_in[3]; p.g_kva = (const float*)d_in[4];
    p.w_uq = (const float*)d_in[5]; p.w_ukv = (const float*)d_in[6]; p.g_qn = (const float*)d_in[7]; p.g_kn = (const float*)d_in[8]; p.sinks = (const float*)d_in[9];
    p.w_out = (const float*)d_in[10]; p.rel_bias = (const float*)d_in[11]; p.g_final = (const float*)d_in[12];
    p.out = (float*)d_out; p.ws = (unsigned char*)d_ws;
#if defined(MULTI_LAUNCH)
    for (int k = 0; k < N_PHASES; ++k) { p.ph_lo = k; p.ph_hi = k + 1; hipLaunchKernelGGL(hymba_fwd, dim3(grid_blocks), dim3(512), LDS_BYTES, stream, p); }
#else
    p.ph_lo = 0; p.ph_hi = N_PHASES;
    if (hipMemsetAsync((char*)d_ws + WS_BAR, 0, 3456 * 4, stream) != hipSuccess) { fprintf(stderr, "kernel_launch: memset of the barrier words failed\n"); return; }
    void* args[] = {&p};
    hipError_t e = hipLaunchCooperativeKernel((const void*)hymba_fwd, dim3(grid_blocks), dim3(512), args, LDS_BYTES, stream);
    if (e != hipSuccess) fprintf(stderr, "cooperative launch failed: %s (grid %d)\n", hipGetErrorString(e), grid_blocks);
#endif
}
```

```cpp
#include <hip/hip_runtime.h>
#include <hip/hip_cooperative_groups.h>
#include <cstdio>
namespace cg = cooperative_groups;
namespace pg8 {
#define PG8_LAS __attribute__((address_space(3)))
typedef unsigned short bf16_t;
__device__ __forceinline__ int opaque_tid() { int t = threadIdx.x; asm volatile("" : "+v"(t)); return t; }
typedef short bf16x8 __attribute__((ext_vector_type(8)));
typedef float f32x4 __attribute__((ext_vector_type(4)));
typedef unsigned u32x4 __attribute__((ext_vector_type(4)));
constexpr int BM = 256, BK = 64, HALF = 128, HTB = HALF * BK * 2  , STAGE_BYTES = 8 * HTB, NXCD = 8, WGM = 8;

__host__ __device__ __forceinline__ int lds_byte(int r, int c) { const int st = (r >> 4) * 2 + (c >> 5), rr = r & 15, cc = c & 31, ob = rr * 64 + cc * 2; return st * 1024 + (ob ^ (((ob >> 9) & 1) << 5)); }
__host__ __device__ __forceinline__ void stage_rc(int b, int& R, int& C) { const int st = b / 1024, sb = b % 1024, swz = sb ^ (((sb >> 9) & 1) << 5); R = (st >> 1) * 16 + swz / 64; C = (st & 1) * 32 + (swz % 64) / 2; }
__host__ __device__ __forceinline__ int perm32(int rho) { const int n = rho >> 4, i = rho & 15; return 8 * (i >> 2) + 4 * n + (i & 3); }

struct Unit { int pm, pn; };
struct Gemm { const bf16_t* A; const bf16_t* Bt; int M, N, K; };
struct StaticOrder {
    int nM, nN, nwg, G, c;
    __host__ __device__ void init(int M, int N, int G_, int c_) { nM = M / BM; nN = N / BM; nwg = nM * nN; G = G_; c = c_; }
    __host__ __device__ bool next(int i, Unit& u) const {
        const long L = (long)i * G + c; if (L >= nwg) return false;
        int wgid = (int)L; { const int q = nwg / NXCD, r = nwg % NXCD, xcd = wgid % NXCD, off = wgid / NXCD; wgid = (xcd < r ? xcd * (q + 1) : r * (q + 1) + (xcd - r) * q) + off; }
        const int nig = WGM * nN, gid = wgid / nig, fm = gid * WGM, gsz = (nM - fm) < WGM ? (nM - fm) : WGM;
        u.pm = fm + ((wgid % nig) % gsz); u.pn = (wgid % nig) / gsz; return true;
    }
    __device__ __forceinline__ void a_ready(const Unit&) const {}
    __device__ __forceinline__ void done(const Unit&) const {}
};
struct RevColOrder : StaticOrder {
    __host__ __device__ bool next(int i, Unit& u) const { const bool r = StaticOrder::next(i, u); if (r) u.pn = nN - 1 - u.pn; return r; }
};
__device__ __forceinline__ unsigned cvt_pk_bf16(float lo, float hi) { unsigned r; asm volatile("v_cvt_pk_bf16_f32 %0, %1, %2" : "=v"(r) : "v"(lo), "v"(hi)); return r; }
typedef float f32x2 __attribute__((ext_vector_type(2)));
struct EpiBf16P {
    static constexpr bool PERM = true, AFTER_DRAIN = false;
    bf16_t* O; int ldc;
    __device__ __forceinline__ void operator()(const f32x4 (&acc)[2][2][4][2], const Unit& u, int wr, int wc, int fr, int fq) const {
        const int row0 = u.pm * BM + wr * 64 + fr; const int col0 = u.pn * BM + wc * 32 + 8 * fq;
#pragma unroll
        for (int ai = 0; ai < 2; ++ai)
#pragma unroll
            for (int m = 0; m < 4; ++m) { bf16_t* rowp = O + (size_t)(row0 + ai * HALF + m * 16) * ldc + col0;
#pragma unroll
                for (int bj = 0; bj < 2; ++bj) { const f32x4 v0 = acc[ai][bj][m][0], v1 = acc[ai][bj][m][1];
                    u32x4 w; w.x = cvt_pk_bf16(v0[0], v0[1]); w.y = cvt_pk_bf16(v0[2], v0[3]); w.z = cvt_pk_bf16(v1[0], v1[1]); w.w = cvt_pk_bf16(v1[2], v1[3]);
                    *(u32x4*)(rowp + bj * HALF) = w; } }
    }
};
struct EpiResF32 {
    static constexpr bool PERM = false, AFTER_DRAIN = false;
    const float* base; float* out; int ldc;
    __device__ __forceinline__ void operator()(const f32x4 (&acc)[2][2][4][2], const Unit& u, int wr, int wc, int fr, int fq) const {
        const int row0 = u.pm * BM + wr * 64 + fr, col0 = u.pn * BM + wc * 32 + 4 * fq;
#pragma unroll
        for (int ai = 0; ai < 2; ++ai)
#pragma unroll
            for (int m = 0; m < 4; ++m) { const size_t off = (size_t)(row0 + ai * HALF + m * 16) * ldc + col0;
#pragma unroll
                for (int bj = 0; bj < 2; ++bj)
#pragma unroll
                    for (int n = 0; n < 2; ++n) { const f32x4 b = *(const f32x4*)(base + off + bj * HALF + n * 16); *(f32x4*)(out + off + bj * HALF + n * 16) = acc[ai][bj][m][n] + b; } }
    }
};
template <class Epi, class Sched, bool ALIGN_EPI = false, bool SP2 = false>
__device__ __forceinline__ void gemm_phase(PG8_LAS unsigned char* lds, const Gemm g, const Sched& S, const Epi& E) {
    const int tid = opaque_tid(), wid = __builtin_amdgcn_readfirstlane(tid >> 6), lane = tid & 63, wr = wid >> 2, wc = wid & 3, fr = lane & 15, fq = lane >> 4;
    const int K = g.K, nt = K / BK;
    unsigned voffA[2], voffB[2];
#pragma unroll
    for (int i = 0; i < 2; ++i) { int R, C; stage_rc(tid * 16 + i * 8192, R, C); const int Rb = Epi::PERM ? ((R & ~31) + perm32(R & 31)) : R;
        voffA[i] = (unsigned)(R * K + C) * 2u; voffB[i] = (unsigned)(Rb * K + C) * 2u; }
    const size_t kstep = (size_t)(BK * 2);
    const size_t hstep = (size_t)HALF * K * 2;
    const size_t tstep = 2 * hstep;
    const unsigned ldsw = (unsigned)wid * 1024u;
    const int aoff = lds_byte(wr * 64 + fr, fq * 8), boff = lds_byte(wc * 32 + fr, fq * 8);
#define PG8_SA(b, h) (((b) * 2 + (h)) * HTB)
#define PG8_SB(b, h) ((4 + (b) * 2 + (h)) * HTB)
#define PG8_STAGE(bufoff, gbase, voff) do { _Pragma("unroll") for (int _i = 0; _i < 2; ++_i) \
        __builtin_amdgcn_global_load_lds((const unsigned*)((const char*)(gbase) + (voff)[_i]), (PG8_LAS unsigned*)(lds + (bufoff) + ldsw + _i * 8192), 16, 0, 0); } while (0)
#define PG8_LDA(dst, b, h) do { _Pragma("unroll") for (int m = 0; m < 4; ++m) _Pragma("unroll") for (int k = 0; k < 2; ++k) dst[m][k] = *(const PG8_LAS bf16x8*)(lds + PG8_SA(b, h) + aoff + m * 2048 + k * 1024); } while (0)
#define PG8_LDB(dst, b, h) do { _Pragma("unroll") for (int n = 0; n < 2; ++n) _Pragma("unroll") for (int k = 0; k < 2; ++k) dst[n][k] = *(const PG8_LAS bf16x8*)(lds + PG8_SB(b, h) + boff + n * 2048 + k * 1024); } while (0)
#define PG8_MMA(ai, bj, At, Bt) do { __builtin_amdgcn_s_setprio(1); _Pragma("unroll") for (int m = 0; m < 4; ++m) _Pragma("unroll") for (int n = 0; n < 2; ++n) _Pragma("unroll") for (int k = 0; k < 2; ++k) \
        acc[ai][bj][m][n] = __builtin_amdgcn_mfma_f32_16x16x32_bf16(Bt[n][k], At[m][k], acc[ai][bj][m][n], 0, 0, 0); __builtin_amdgcn_s_setprio(0); } while (0)
#define PG8_WAIT_V(n) asm volatile("s_waitcnt vmcnt(" #n ")" ::: "memory")
#define PG8_WAIT_L(n) asm volatile("s_waitcnt lgkmcnt(" #n ")" ::: "memory")
#define PG8_BAR __builtin_amdgcn_s_barrier()
#define PG8_SCHED __builtin_amdgcn_sched_barrier(0)
    Unit cur, nxt; int ui = 0;
    if (!S.next(0, cur)) return;
    f32x4 acc[2][2][4][2];
#pragma unroll
    for (int a = 0; a < 2; ++a)
#pragma unroll
        for (int b = 0; b < 2; ++b)
#pragma unroll
            for (int m = 0; m < 4; ++m)
#pragma unroll
                for (int n = 0; n < 2; ++n) acc[a][b][m][n] = (f32x4){0.f, 0.f, 0.f, 0.f};
    bf16x8 At[4][2], B0[2][2], B1[2][2];
    const char* cA = (const char*)g.A + (size_t)cur.pm * tstep; const char* cB = (const char*)g.Bt + (size_t)cur.pn * tstep;
    S.a_ready(cur);
    if constexpr (SP2) {
        PG8_STAGE(PG8_SB(0, 0), cB, voffB); PG8_STAGE(PG8_SB(0, 1), cB + hstep, voffB); PG8_STAGE(PG8_SA(0, 0), cA, voffA); PG8_STAGE(PG8_SA(0, 1), cA + hstep, voffA);
        if (wr == 1) PG8_BAR;
        PG8_WAIT_V(2); PG8_BAR;
        PG8_STAGE(PG8_SB(1, 0), cB + kstep, voffB); PG8_STAGE(PG8_SA(1, 0), cA + kstep, voffA); PG8_STAGE(PG8_SB(1, 1), cB + hstep + kstep, voffB);
        PG8_WAIT_V(6); PG8_BAR;
    } else {
        PG8_STAGE(PG8_SB(0, 0), cB, voffB); PG8_STAGE(PG8_SA(0, 0), cA, voffA); PG8_STAGE(PG8_SB(0, 1), cB + hstep, voffB); PG8_STAGE(PG8_SA(0, 1), cA + hstep, voffA);
        if (wr == 1) PG8_BAR;
        PG8_WAIT_V(4); PG8_BAR;
        PG8_STAGE(PG8_SB(1, 0), cB + kstep, voffB); PG8_STAGE(PG8_SA(1, 0), cA + kstep, voffA); PG8_STAGE(PG8_SB(1, 1), cB + hstep + kstep, voffB);
        PG8_WAIT_V(6); PG8_BAR;
    }
    for (;;) {
        const bool has_next = S.next(ui + 1, nxt);
        const char* nA = has_next ? (const char*)g.A + (size_t)nxt.pm * tstep : cA; const char* nB = has_next ? (const char*)g.Bt + (size_t)nxt.pn * tstep : cB;
        for (int t = 0; t < nt; t += 2) {
            const bool last = (t == nt - 2);
            const char* a1 = cA + (size_t)(t + 1) * kstep;
            const char* a2 = last ? nA : cA + (size_t)(t + 2) * kstep; const char* b2 = last ? nB : cB + (size_t)(t + 2) * kstep;
            const char* a3 = a2 + kstep; const char* b3 = b2 + kstep;
            if (last && has_next) S.a_ready(nxt);
            if constexpr (SP2) {
            PG8_LDB(B0, 0, 0); PG8_LDB(B1, 0, 1); PG8_SCHED; PG8_LDA(At, 0, 0); PG8_STAGE(PG8_SA(1, 1), a1 + hstep, voffA);
            PG8_WAIT_V(8); PG8_WAIT_L(0); PG8_BAR; PG8_MMA(0, 0, At, B0); PG8_MMA(0, 1, At, B1); PG8_BAR; PG8_SCHED;
            PG8_LDA(At, 0, 1); PG8_STAGE(PG8_SB(0, 0), b2, voffB); PG8_STAGE(PG8_SB(0, 1), b2 + hstep, voffB); PG8_STAGE(PG8_SA(0, 0), a2, voffA);
            PG8_WAIT_V(8); PG8_WAIT_L(0); PG8_BAR; PG8_MMA(1, 0, At, B0); PG8_MMA(1, 1, At, B1); PG8_BAR; PG8_SCHED;
            PG8_LDB(B0, 1, 0); PG8_LDB(B1, 1, 1); PG8_SCHED; PG8_LDA(At, 1, 0); PG8_STAGE(PG8_SA(0, 1), a2 + hstep, voffA);
            PG8_WAIT_V(8); PG8_WAIT_L(0); PG8_BAR; PG8_MMA(0, 0, At, B0); PG8_MMA(0, 1, At, B1); PG8_BAR; PG8_SCHED;
            PG8_LDA(At, 1, 1); PG8_STAGE(PG8_SB(1, 0), b3, voffB); PG8_STAGE(PG8_SB(1, 1), b3 + hstep, voffB); PG8_STAGE(PG8_SA(1, 0), a3, voffA);
            PG8_WAIT_V(8); PG8_WAIT_L(0); PG8_BAR; PG8_MMA(1, 0, At, B0); PG8_MMA(1, 1, At, B1); PG8_BAR; PG8_SCHED;
            } else {
            PG8_LDB(B0, 0, 0); PG8_SCHED; PG8_LDA(At, 0, 0); PG8_STAGE(PG8_SA(1, 1), a1 + hstep, voffA);
            PG8_WAIT_L(8); PG8_BAR; PG8_WAIT_L(0); PG8_MMA(0, 0, At, B0); PG8_BAR; PG8_SCHED;
            PG8_LDB(B1, 0, 1); PG8_STAGE(PG8_SB(0, 0), b2, voffB);
            PG8_BAR; PG8_WAIT_L(0); PG8_MMA(0, 1, At, B1); PG8_BAR;
            PG8_LDA(At, 0, 1); PG8_STAGE(PG8_SA(0, 0), a2, voffA);
            PG8_BAR; PG8_WAIT_L(0); PG8_MMA(1, 0, At, B0); PG8_BAR; PG8_SCHED;
            PG8_STAGE(PG8_SB(0, 1), b2 + hstep, voffB);
            PG8_WAIT_V(6); PG8_BAR; PG8_MMA(1, 1, At, B1); PG8_BAR;
            PG8_LDB(B0, 1, 0); PG8_SCHED; PG8_LDA(At, 1, 0); PG8_STAGE(PG8_SA(0, 1), a2 + hstep, voffA);
            PG8_WAIT_L(8); PG8_BAR; PG8_WAIT_L(0); PG8_MMA(0, 0, At, B0); PG8_BAR; PG8_SCHED;
            PG8_LDB(B1, 1, 1); PG8_STAGE(PG8_SB(1, 0), b3, voffB);
            PG8_BAR; PG8_WAIT_L(0); PG8_MMA(0, 1, At, B1); PG8_BAR;
            PG8_LDA(At, 1, 1); PG8_STAGE(PG8_SA(1, 0), a3, voffA);
            PG8_BAR; PG8_WAIT_L(0); PG8_MMA(1, 0, At, B0); PG8_BAR; PG8_SCHED;
            PG8_STAGE(PG8_SB(1, 1), b3 + hstep, voffB);
            PG8_WAIT_V(6); PG8_BAR; PG8_MMA(1, 1, At, B1); PG8_BAR;
            }
        }
        if constexpr (ALIGN_EPI) { if (wr == 0) PG8_BAR; }
        if constexpr (!Epi::AFTER_DRAIN) { E(acc, cur, wr, wc, fr, fq); S.done(cur); }
        if (!has_next) break;
#pragma unroll
        for (int a = 0; a < 2; ++a)
#pragma unroll
            for (int b = 0; b < 2; ++b)
#pragma unroll
                for (int m = 0; m < 4; ++m)
#pragma unroll
                    for (int n = 0; n < 2; ++n) acc[a][b][m][n] = (f32x4){0.f, 0.f, 0.f, 0.f};
        cur = nxt; cA = nA; cB = nB; ++ui;
        if constexpr (ALIGN_EPI) { if (wr == 1) PG8_BAR; }
    }
    PG8_WAIT_V(0);
    if constexpr (!ALIGN_EPI) { if (wr == 0) PG8_BAR; }
    PG8_BAR;
    if constexpr (Epi::AFTER_DRAIN) { E.fused(acc, cur, wr, wc, fr, fq, lds, wid, lane); S.done(cur); }
#undef PG8_SA
#undef PG8_SB
#undef PG8_STAGE
#undef PG8_LDA
#undef PG8_LDB
#undef PG8_MMA
#undef PG8_WAIT_V
#undef PG8_WAIT_L
#undef PG8_BAR
#undef PG8_SCHED
}
}

typedef pg8::bf16_t bf16_t;
typedef pg8::bf16x8 bf16x8;
typedef pg8::f32x4 f32x4;
typedef pg8::u32x4 u32x4;
typedef short s16x4 __attribute__((ext_vector_type(4)));
typedef float f32x16 __attribute__((ext_vector_type(16)));
typedef unsigned u32x2 __attribute__((ext_vector_type(2)));
#define LAS __attribute__((address_space(3)))
typedef LAS unsigned char lds_u8;

constexpr int SEQ = 4096, NBATCH = 2, MTOK = 8192, DM = 4096, NIN = 13632, NINP = 13824, MIXW = 4608;
constexpr int C_ACQ = 0, C_ACKV = 768, C_KPE = 1280, C_BQ = 1344, C_BK = 2880, C_BV = 4416, C_CQ = 5952, C_CK = 6976, C_CV = 7232,
              C_DQ = 7488, C_DK = 8512, C_DV = 8768, C_GATE = 9024;
constexpr int MX_A = 0, MX_B = 1024, MX_C = 2560, MX_D = 3584;
constexpr float EPS = 1e-6f;
constexpr float LOG2E = 1.4426950408889634f, LN2 = 0.6931471805599453f;

constexpr size_t AL(size_t x) { return (x + 255) / 256 * 256; }
constexpr size_t WS_WIN   = 0;
constexpr size_t WS_WOUT  = WS_WIN   + AL((size_t)2 * NINP * DM * 2);
constexpr size_t WS_WUQ   = WS_WOUT  + AL((size_t)2 * DM * MIXW * 2);
constexpr size_t WS_WUKV  = WS_WUQ   + AL((size_t)2 * 1536 * 768 * 2);
constexpr size_t WS_H     = WS_WUKV  + AL((size_t)2 * 2048 * 512 * 2);
constexpr size_t WS_PROJ  = WS_H     + AL((size_t)MTOK * DM * 2);
constexpr size_t WS_X1    = WS_PROJ  + AL((size_t)MTOK * NINP * 2);
constexpr size_t WS_QAN   = WS_X1    + AL((size_t)MTOK * DM * 4);
constexpr size_t WS_KVAN  = WS_QAN   + AL((size_t)MTOK * 768 * 2);
constexpr size_t WS_KPE   = WS_KVAN  + AL((size_t)MTOK * 512 * 2);
constexpr size_t WS_QRAW  = WS_KPE   + AL((size_t)MTOK * 64 * 2);
constexpr size_t WS_KVRAW = WS_QRAW  + AL((size_t)MTOK * 1536 * 2);
constexpr size_t WS_QC    = WS_KVRAW + AL((size_t)MTOK * 2048 * 2);
constexpr size_t WS_KC    = WS_QC    + AL((size_t)MTOK * 1024 * 2);
constexpr size_t WS_MIXED = WS_KC    + AL((size_t)MTOK * 256 * 2);
constexpr size_t WS_LSE   = WS_MIXED + AL((size_t)MTOK * MIXW * 2);
constexpr size_t WS_CS    = WS_LSE   + AL((size_t)3 * MTOK * 4 * 4);
constexpr size_t WS_DELTA = WS_CS    + AL((size_t)SEQ * 32 * 8);
constexpr size_t WS_DKV   = WS_DELTA + AL((size_t)2 * MTOK * DM * 2);
constexpr size_t WS_BAR   = WS_DKV   + AL((size_t)MTOK * 512 * 2);
constexpr size_t WS_END   = WS_BAR   + AL((size_t)3456 * 4);

constexpr int LDS_BYTES = 141312;

#ifndef REP_GEMM
#define REP_GEMM 1
#endif
#ifndef REP_OUT
#define REP_OUT 1
#endif
#ifndef REP_UP
#define REP_UP 1
#endif
#ifndef REP_SYNC
#define REP_SYNC 0
#endif
#ifndef REP_BAND
#define REP_BAND 1
#endif
#ifndef REP_A
#define REP_A 1
#endif
#ifndef REP_C
#define REP_C 1
#endif
#ifndef HIDE_TAIL
#define HIDE_TAIL 0
#endif
#ifndef CVT_P0_LAYERS
#define CVT_P0_LAYERS 2
#endif
#ifndef GEMM_ALIGN
#define GEMM_ALIGN true
#endif
#ifndef GEMM_SP2
#define GEMM_SP2 true
#endif
#ifndef REP_D
#define REP_D 1
#endif
#ifndef REP_B
#define REP_B 1
#endif
#ifndef REP_ATTN
#define REP_ATTN 1
#endif
#ifndef REP_CVT
#define REP_CVT 1
#endif
#ifndef REP_MISC
#define REP_MISC 1
#endif
struct Params {
    const float *x, *g_attn, *w_in, *g_qa, *g_kva, *w_uq, *w_ukv, *g_qn, *g_kn, *sinks, *w_out, *rel_bias, *g_final;
    float* out; unsigned char* ws; int ph_lo, ph_hi;
};

__device__ __forceinline__ bf16_t f2bf(float f) { unsigned u = __float_as_uint(f); u += 0x7FFFu + ((u >> 16) & 1u); return (bf16_t)(u >> 16); }
__device__ __forceinline__ float bf2f(bf16_t b) { return __uint_as_float(((unsigned)b) << 16); }
__device__ __forceinline__ float bflo(unsigned w) { return __uint_as_float(w << 16); }
__device__ __forceinline__ float bfhi(unsigned w) { return __uint_as_float(w & 0xffff0000u); }
__device__ __forceinline__ unsigned cvtpk(float lo, float hi) { unsigned r; asm volatile("v_cvt_pk_bf16_f32 %0, %1, %2" : "=v"(r) : "v"(lo), "v"(hi)); return r; }
__device__ __forceinline__ float wave_sum(float v) {
#pragma unroll
    for (int o = 32; o >= 1; o >>= 1) v += __shfl_xor(v, o);
    return v;
}
__device__ __forceinline__ int rel_bucket(int rel) {
    const int n = rel < 0 ? -rel : rel; int b;
    if (n < 8) b = n;
    else b = 8 + (n >= 15) + (n >= 27) + (n >= 50) + (n >= 91) + (n >= 166) + (n >= 305) + (n >= 559);
    return b + (rel > 0 ? 16 : 0);
}

constexpr int CVT_NQ = 4;
__device__ __forceinline__ void cvt_transpose(const float* __restrict__ src, bf16_t* __restrict__ dst, int K, int N, int Npad, lds_u8* lds, int wg, int nwg) {
    LAS float* tile = (LAS float*)lds;
    const int tid = pg8::opaque_tid(), tn4 = Npad / (64 * CVT_NQ), tk = K / 64;
    __syncthreads();
    for (int t = wg; t < tn4 * tk; t += nwg) {
        const int nt4 = t % tn4, kt = t / tn4;
        f32x4 v[CVT_NQ][2];
#pragma unroll
        for (int q = 0; q < CVT_NQ; ++q)
#pragma unroll
            for (int i = 0; i < 2; ++i) {
                const int row = (tid >> 4) + 32 * i, c4 = (tid & 15) * 4, n = (nt4 * CVT_NQ + q) * 64 + c4;
                v[q][i] = (f32x4){0.f, 0.f, 0.f, 0.f};
                if (n < N) v[q][i] = __builtin_nontemporal_load((const f32x4*)(src + (size_t)(kt * 64 + row) * N + n));
            }
#pragma unroll
        for (int q = 0; q < CVT_NQ; ++q)
#pragma unroll
            for (int i = 0; i < 2; ++i) {
                const int row = (tid >> 4) + 32 * i, c4 = (tid & 15) * 4;
                LAS float* tp = tile + q * (64 * 65) + row * 65 + c4;
                tp[0] = v[q][i][0]; tp[1] = v[q][i][1]; tp[2] = v[q][i][2]; tp[3] = v[q][i][3];
            }
        __syncthreads();
#pragma unroll
        for (int q = 0; q < CVT_NQ; ++q) {
            const int nl = tid >> 3, kc = (tid & 7) * 8;
            float f[8];
#pragma unroll
            for (int j = 0; j < 8; ++j) f[j] = tile[q * (64 * 65) + (kc + j) * 65 + nl];
            u32x4 w; w.x = cvtpk(f[0], f[1]); w.y = cvtpk(f[2], f[3]); w.z = cvtpk(f[4], f[5]); w.w = cvtpk(f[6], f[7]);
            *(u32x4*)(dst + (size_t)((nt4 * CVT_NQ + q) * 64 + nl) * K + kt * 64 + kc) = w;
        }
        __syncthreads();
    }
}

__device__ __forceinline__ void build_cs(float2* cs, int wg, int nwg) {
    for (int idx = wg * 512 + pg8::opaque_tid(); idx < SEQ * 32; idx += nwg * 512) {
        const int pos = idx >> 5, i = idx & 31;
        const float inv = exp2f(-(float)i * (13.287712379549449f / 32.0f));
        const float ang = (float)pos * inv;
        const float k = rintf(ang * 0.15915494309189535f);
        float r = fmaf(-k, 6.2831854820251465f, ang); r = fmaf(-k, -1.7484555e-7f, r);
        cs[idx] = make_float2(__cosf(r), __sinf(r));
    }
}

template <int NDELTA, bool TO_BF16>
__device__ __forceinline__ void rmsnorm_rows(const float* __restrict__ x, const bf16_t* __restrict__ delta0, const bf16_t* __restrict__ delta1, const float* __restrict__ g,
                                             bf16_t* __restrict__ hout, float* __restrict__ fout, int wg, int nwg) {
    const int tid = pg8::opaque_tid(), wid = tid >> 6, lane = tid & 63;
    f32x4 gk[16];
#pragma unroll
    for (int k = 0; k < 16; ++k) gk[k] = *(const f32x4*)(g + k * 256 + lane * 4);
    for (int row = wg * 8 + wid; row < MTOK; row += nwg * 8) {
        const float* xr = x + (size_t)row * DM + lane * 4;
        f32x4 v[16];
#pragma unroll
        for (int k = 0; k < 16; ++k) v[k] = __builtin_nontemporal_load((const f32x4*)(xr + k * 256));
        if (NDELTA >= 1) {
            u32x2 d[16];
#pragma unroll
            for (int k = 0; k < 16; ++k) d[k] = __builtin_nontemporal_load((const u32x2*)(delta0 + (size_t)row * DM + k * 256 + lane * 4));
#pragma unroll
            for (int k = 0; k < 16; ++k) { v[k][0] += bflo(d[k].x); v[k][1] += bfhi(d[k].x); v[k][2] += bflo(d[k].y); v[k][3] += bfhi(d[k].y); }
        }
        if (NDELTA >= 2) {
            u32x2 d[16];
#pragma unroll
            for (int k = 0; k < 16; ++k) d[k] = __builtin_nontemporal_load((const u32x2*)(delta1 + (size_t)row * DM + k * 256 + lane * 4));
#pragma unroll
            for (int k = 0; k < 16; ++k) { v[k][0] += bflo(d[k].x); v[k][1] += bfhi(d[k].x); v[k][2] += bflo(d[k].y); v[k][3] += bfhi(d[k].y); }
        }
        float ss = 0.f;
#pragma unroll
        for (int k = 0; k < 16; ++k) ss += v[k][0] * v[k][0] + v[k][1] * v[k][1] + v[k][2] * v[k][2] + v[k][3] * v[k][3];
        ss = wave_sum(ss);
        const float rstd = rsqrtf(ss * (1.0f / DM) + EPS);
#pragma unroll
        for (int k = 0; k < 16; ++k) {
            const f32x4 y = v[k] * rstd * gk[k];
            if (TO_BF16) { u32x2 w; w.x = cvtpk(y[0], y[1]); w.y = cvtpk(y[2], y[3]); *(u32x2*)(hout + (size_t)row * DM + k * 256 + lane * 4) = w; }
            else __builtin_nontemporal_store(y, (f32x4*)(fout + (size_t)row * DM + k * 256 + lane * 4));
        }
    }
}

__device__ __forceinline__ void prep_tokens(const bf16_t* __restrict__ proj, const float* __restrict__ g_qa, const float* __restrict__ g_kva,
                                            const float* __restrict__ g_qn, const float* __restrict__ g_kn, const float2* __restrict__ cs,
                                            bf16_t* __restrict__ qan, bf16_t* __restrict__ kvan, bf16_t* __restrict__ kpe, bf16_t* __restrict__ qc, bf16_t* __restrict__ kc, bf16_t* __restrict__ dkv, int wg, int nwg) {
    const int tid = pg8::opaque_tid(), wid = tid >> 6, lane = tid & 63, hf = lane >> 5, i = lane & 31;
    for (int t = wg * 8 + wid; t < MTOK; t += nwg * 8) {
        const bf16_t* pr = proj + (size_t)t * NINP;
        const int pos = t & (SEQ - 1);
        u32x2 wq[3], wk[2];
#pragma unroll
        for (int k = 0; k < 3; ++k) wq[k] = *(const u32x2*)(pr + C_ACQ + k * 256 + lane * 4);
#pragma unroll
        for (int k = 0; k < 2; ++k) wk[k] = *(const u32x2*)(pr + C_ACKV + k * 256 + lane * 4);
        bf16_t hv[5][4];
#pragma unroll
        for (int s = 0; s < 5; ++s)
#pragma unroll
            for (int q = 0; q < 4; ++q) hv[s][q] = pr[C_CQ + (2 * s + hf) * 128 + q * 32 + i];
        const bf16_t kp1 = pr[C_KPE + i], kp2 = pr[C_KPE + 32 + i];
        const float2 ct = cs[pos * 32 + i], crow_ = cs[(pos >> 6) * 32 + i], ccol = cs[(pos & 63) * 32 + i];
        {
            float v[12]; float ss = 0.f;
#pragma unroll
            for (int k = 0; k < 3; ++k) { v[4 * k] = bflo(wq[k].x); v[4 * k + 1] = bfhi(wq[k].x); v[4 * k + 2] = bflo(wq[k].y); v[4 * k + 3] = bfhi(wq[k].y); }
#pragma unroll
            for (int j = 0; j < 12; ++j) ss += v[j] * v[j];
            ss = wave_sum(ss);
            const float rstd = rsqrtf(ss * (1.0f / 768.0f) + EPS);
#pragma unroll
            for (int k = 0; k < 3; ++k) { const f32x4 gg = *(const f32x4*)(g_qa + k * 256 + lane * 4);
                u32x2 w; w.x = cvtpk(v[4 * k] * rstd * gg[0], v[4 * k + 1] * rstd * gg[1]); w.y = cvtpk(v[4 * k + 2] * rstd * gg[2], v[4 * k + 3] * rstd * gg[3]);
                *(u32x2*)(qan + (size_t)t * 768 + k * 256 + lane * 4) = w; }
        }
        {
            float v[8]; float ss = 0.f;
#pragma unroll
            for (int k = 0; k < 2; ++k) { v[4 * k] = bflo(wk[k].x); v[4 * k + 1] = bfhi(wk[k].x); v[4 * k + 2] = bflo(wk[k].y); v[4 * k + 3] = bfhi(wk[k].y); }
#pragma unroll
            for (int j = 0; j < 8; ++j) ss += v[j] * v[j];
            ss = wave_sum(ss);
            const float rstd = rsqrtf(ss * (1.0f / 512.0f) + EPS);
#pragma unroll
            for (int k = 0; k < 2; ++k) { const f32x4 gg = *(const f32x4*)(g_kva + k * 256 + lane * 4);
                u32x2 w; w.x = cvtpk(v[4 * k] * rstd * gg[0], v[4 * k + 1] * rstd * gg[1]); w.y = cvtpk(v[4 * k + 2] * rstd * gg[2], v[4 * k + 3] * rstd * gg[3]);
                *(u32x2*)(kvan + (size_t)t * 512 + k * 256 + lane * 4) = w; }
        }
        if (hf == 0) {
            const float x1 = bf2f(kp1), x2 = bf2f(kp2);
            kpe[(size_t)t * 64 + i] = f2bf(x1 * ct.x - x2 * ct.y);
            kpe[(size_t)t * 64 + 32 + i] = f2bf(x2 * ct.x + x1 * ct.y);
        }
#pragma unroll
        for (int s = 0; s < 5; ++s) {
            const int head = 2 * s + hf;
            const float* gg = (head < 8) ? g_qn : g_kn;
            float a0 = bf2f(hv[s][0]), a1 = bf2f(hv[s][1]), a2 = bf2f(hv[s][2]), a3 = bf2f(hv[s][3]);
            float ss = a0 * a0 + a1 * a1 + a2 * a2 + a3 * a3;
#pragma unroll
            for (int o = 16; o >= 1; o >>= 1) ss += __shfl_xor(ss, o);
            const float rstd = rsqrtf(ss * (1.0f / 128.0f) + EPS);
            a0 *= rstd * gg[i]; a1 *= rstd * gg[32 + i]; a2 *= rstd * gg[64 + i]; a3 *= rstd * gg[96 + i];
            bf16_t* dst = (head < 8) ? (qc + (size_t)t * 1024 + head * 128) : (kc + (size_t)t * 256 + (head - 8) * 128);
            dst[i] = f2bf(a0 * crow_.x - a1 * crow_.y); dst[32 + i] = f2bf(a1 * crow_.x + a0 * crow_.y);
            dst[64 + i] = f2bf(a2 * ccol.x - a3 * ccol.y); dst[96 + i] = f2bf(a3 * ccol.x + a2 * ccol.y);
        }
    }
}

__device__ __forceinline__ void fixup_b(bf16_t* mixed, const float* __restrict__ lse, int wg, int nwg) {
    const int tid = pg8::opaque_tid(), wid = tid >> 6, lane = tid & 63, hh = lane >> 4;
    for (int t = wg * 8 + wid; t < MTOK; t += nwg * 8) {
        const float l0 = lse[((size_t)0 * MTOK + t) * 4 + hh], l1 = lse[((size_t)1 * MTOK + t) * 4 + hh], l2 = lse[((size_t)2 * MTOK + t) * 4 + hh];
        const float mx = fmaxf(l0, fmaxf(l1, l2));
        const float e0 = __expf(l0 - mx), e1 = __expf(l1 - mx), e2 = __expf(l2 - mx), inv = 1.0f / (e0 + e1 + e2);
        const float al[3] = {e0 * inv, e1 * inv, e2 * inv};
        u32x4 wv[3];
#pragma unroll
        for (int k = 0; k < 3; ++k) wv[k] = *(const u32x4*)(mixed + (size_t)t * MIXW + MX_B + k * 512 + lane * 8);
#pragma unroll
        for (int k = 0; k < 3; ++k) {
            u32x4 w = wv[k];
            const float a = al[k];
            w.x = cvtpk(bflo(w.x) * a, bfhi(w.x) * a); w.y = cvtpk(bflo(w.y) * a, bfhi(w.y) * a);
            w.z = cvtpk(bflo(w.z) * a, bfhi(w.z) * a); w.w = cvtpk(bflo(w.w) * a, bfhi(w.w) * a);
            *(u32x4*)(mixed + (size_t)t * MIXW + MX_B + k * 512 + lane * 8) = w;
        }
    }
}

__device__ __forceinline__ int crow(int r, int hi) { return (r & 3) + 8 * (r >> 2) + 4 * hi; }
#define KSWZ(row, colB) ((row) * 256 + ((colB) ^ (((row) & 7) << 4)))
#define PSWZ(row, colB) ((row) * 128 + ((colB) ^ (((row) & 7) << 4)))
__device__ __forceinline__ int v_st(int k, int c) { const int kk = (k & ~0xC) | ((k & 4) << 1) | ((k & 8) >> 1); return ((kk >> 3) * 4 + (c >> 5)) * 512 + ((kk & 7) * 32 + (c & 31)) * 2; }
__device__ __forceinline__ int v_rd_base(int lane) { return ((lane & 3) << 3) | (((lane >> 2) & 3) << 6) | (((lane >> 4) & 1) << 5) | (((lane >> 5) & 1) << 8); }
constexpr int v_rd_off(int d0, int ks, int half) { return d0 * 512 + ks * 4096 + half * 2048; }
template <int OFF> __device__ __forceinline__ s16x4 tr_read(int vb) {
    s16x4 r; asm volatile("ds_read_b64_tr_b16 %0, %1 offset:%2" : "=&v"(r) : "v"(vb), "i"(OFF) : "memory"); return r;
}
template <int D0> __device__ __forceinline__ void pv_one(f32x16& od, int vb, bf16x8 pa0, bf16x8 pa1, bf16x8 pa2, bf16x8 pa3) {
    const s16x4 l0 = tr_read<v_rd_off(D0, 0, 0)>(vb), h0 = tr_read<v_rd_off(D0, 0, 1)>(vb), l1 = tr_read<v_rd_off(D0, 1, 0)>(vb), h1 = tr_read<v_rd_off(D0, 1, 1)>(vb);
    const s16x4 l2 = tr_read<v_rd_off(D0, 2, 0)>(vb), h2 = tr_read<v_rd_off(D0, 2, 1)>(vb), l3 = tr_read<v_rd_off(D0, 3, 0)>(vb), h3 = tr_read<v_rd_off(D0, 3, 1)>(vb);
    asm volatile("s_waitcnt lgkmcnt(0)" ::: "memory"); __builtin_amdgcn_sched_barrier(0);
#define PK(L, H) (bf16x8){L[0], L[1], L[2], L[3], H[0], H[1], H[2], H[3]}
    od = __builtin_amdgcn_mfma_f32_32x32x16_bf16(pa0, PK(l0, h0), od, 0, 0, 0);
    od = __builtin_amdgcn_mfma_f32_32x32x16_bf16(pa1, PK(l1, h1), od, 0, 0, 0);
    od = __builtin_amdgcn_mfma_f32_32x32x16_bf16(pa2, PK(l2, h2), od, 0, 0, 0);
    od = __builtin_amdgcn_mfma_f32_32x32x16_bf16(pa3, PK(l3, h3), od, 0, 0, 0);
#undef PK
}

constexpr int AL_V = 0, AL_K = 16384, AL_KP = 32768, AL_WS = 40960, AL_LUT = 43008;

struct AttnArgs {
    const bf16_t* Q; long ldq;
    const bf16_t* K; long ldk;
    const bf16_t* K2; long ldk2;
    const bf16_t* V; long ldv;
    const bf16_t* G; long ldg;
    bf16_t* O; long ldo;
    float* lse; long ldl;
    const float2* cs;
    int i0, L, side, dil;
    const float* bias; int bcol;
    float C;
    float sink2;
};

template <int DQK, bool BAND, bool SINK, bool WLSE, bool ROPEQ>
__device__ __forceinline__ void attn_unit(lds_u8* lds, const AttnArgs& a) {
    constexpr int ND0 = DQK / 16;
    const int tid = pg8::opaque_tid(), wid = tid >> 6, lane = tid & 63, r32 = lane & 31, hi = lane >> 5;
    lds_u8* Vl = lds + AL_V; lds_u8* Kl = lds + AL_K; lds_u8* Kp = lds + AL_KP;
    LAS float* wsf = (LAS float*)(lds + AL_WS) + wid * 64; LAS float* li_l = wsf; LAS float* al_l = wsf + 32;
    LAS float* lut = (LAS float*)(lds + AL_LUT);
    __syncthreads();
    if (BAND) {
        if (tid <= 2 * a.side) { const int rel = tid - a.side; lut[tid] = a.bias[rel_bucket(rel * a.dil) * 20 + a.bcol] * LOG2E; }
    }
    const int qi = a.i0 + wid * 32 + r32;
    bf16x8 qr[ND0];
    {
        const bf16_t* Qw = a.Q + (long)qi * a.ldq + hi * 8;
#pragma unroll
        for (int d0 = 0; d0 < ND0; ++d0) qr[d0] = *(const bf16x8*)(Qw + d0 * 16);
    }
    if constexpr (ROPEQ) {
#pragma unroll
        for (int dd = 0; dd < 2; ++dd) {
            bf16x8 x1 = qr[8 + dd], x2 = qr[10 + dd];
#pragma unroll
            for (int j = 0; j < 8; ++j) {
                const float2 c = a.cs[qi * 32 + dd * 16 + hi * 8 + j];
                const float f1 = bf2f((bf16_t)x1[j]), f2 = bf2f((bf16_t)x2[j]);
                x1[j] = (short)f2bf(f1 * c.x - f2 * c.y); x2[j] = (short)f2bf(f2 * c.x + f1 * c.y);
            }
            qr[8 + dd] = x1; qr[10 + dd] = x2;
        }
    }
    int t_lo = 0, t_hi = a.L / 64, lo_w = 0, hi_w = 1 << 30;
    if (BAND) {
        t_lo = (a.i0 - a.side) / 64; if (t_lo < 0) t_lo = 0;
        int th = (a.i0 + 256 + a.side) / 64; if (th < t_hi) t_hi = th;
        const int w0 = a.i0 + wid * 32;
        lo_w = (w0 - a.side) >> 6; hi_w = (w0 + 31 + a.side) >> 6;
    }
    const int sr = tid >> 4, sc = (tid & 15) * 8;
    const int vst0 = v_st(sr, sc), vst1 = v_st(32 + sr, sc), kst0 = KSWZ(sr, sc * 2), kst1 = KSWZ(32 + sr, sc * 2);
    const int pr_ = tid >> 3, pc = (tid & 7) * 8, pst = PSWZ(pr_, pc * 2);
    const int vb0 = (int)(unsigned)(size_t)Vl + v_rd_base(lane);
    bf16x8 kA, kB, vA, vB, kP;
#define ALOAD(T) do { const long j0 = (long)(T) * 64; \
        kA = *(const bf16x8*)(a.K + (j0 + sr) * a.ldk + sc); kB = *(const bf16x8*)(a.K + (j0 + 32 + sr) * a.ldk + sc); \
        vA = *(const bf16x8*)(a.V + (j0 + sr) * a.ldv + sc); vB = *(const bf16x8*)(a.V + (j0 + 32 + sr) * a.ldv + sc); \
        if constexpr (DQK == 192) kP = *(const bf16x8*)(a.K2 + (j0 + pr_) * a.ldk2 + pc); } while (0)
    float m_reg = -1e29f, l_reg = 0.f;
    f32x16 o[4];
#pragma unroll
    for (int d = 0; d < 4; ++d)
#pragma unroll
        for (int r = 0; r < 16; ++r) o[d][r] = 0.f;
    ALOAD(t_lo);
    for (int T = t_lo; T < t_hi; ++T) {
        __syncthreads();
        *(LAS bf16x8*)(Kl + kst0) = kA; *(LAS bf16x8*)(Kl + kst1) = kB;
        *(LAS bf16x8*)(Vl + vst0) = vA; *(LAS bf16x8*)(Vl + vst1) = vB;
        if constexpr (DQK == 192) *(LAS bf16x8*)(Kp + pst) = kP;
        if (T + 1 < t_hi) ALOAD(T + 1);
        __syncthreads();
        if (T >= lo_w && T <= hi_w) {
            f32x16 p0, p1;
#pragma unroll
            for (int r = 0; r < 16; ++r) { p0[r] = 0.f; p1[r] = 0.f; }
#pragma unroll
            for (int d0 = 0; d0 < 8; ++d0) { const int cb = (d0 * 16 + hi * 8) * 2;
                const bf16x8 b0 = *(const LAS bf16x8*)(Kl + KSWZ(r32, cb)), b1 = *(const LAS bf16x8*)(Kl + KSWZ(32 + r32, cb));
                p0 = __builtin_amdgcn_mfma_f32_32x32x16_bf16(b0, qr[d0], p0, 0, 0, 0);
                p1 = __builtin_amdgcn_mfma_f32_32x32x16_bf16(b1, qr[d0], p1, 0, 0, 0); }
            if constexpr (DQK == 192) {
#pragma unroll
                for (int d0 = 0; d0 < 4; ++d0) { const int cb = (d0 * 16 + hi * 8) * 2;
                    const bf16x8 b0 = *(const LAS bf16x8*)(Kp + PSWZ(r32, cb)), b1 = *(const LAS bf16x8*)(Kp + PSWZ(32 + r32, cb));
                    p0 = __builtin_amdgcn_mfma_f32_32x32x16_bf16(b0, qr[8 + d0], p0, 0, 0, 0);
                    p1 = __builtin_amdgcn_mfma_f32_32x32x16_bf16(b1, qr[8 + d0], p1, 0, 0, 0); }
            }
            if (BAND) {
                const int base = T * 64 - qi + a.side;
#pragma unroll
                for (int r = 0; r < 16; ++r) {
                    const int i0_ = base + crow(r, hi), i1_ = i0_ + 32;
                    const bool ok0 = (unsigned)i0_ <= (unsigned)(2 * a.side), ok1 = (unsigned)i1_ <= (unsigned)(2 * a.side);
                    const float b0 = lut[ok0 ? i0_ : 0], b1 = lut[ok1 ? i1_ : 0];
                    p0[r] = ok0 ? fmaf(p0[r], a.C, b0) : -1e30f; p1[r] = ok1 ? fmaf(p1[r], a.C, b1) : -1e30f;
                }
            } else {
#pragma unroll
                for (int r = 0; r < 16; ++r) { p0[r] *= a.C; p1[r] *= a.C; }
            }
            float pmax = p0[0];
#pragma unroll
            for (int r = 1; r < 16; ++r) pmax = fmaxf(pmax, p0[r]);
#pragma unroll
            for (int r = 0; r < 16; ++r) pmax = fmaxf(pmax, p1[r]);
            { auto rr = __builtin_amdgcn_permlane32_swap(__float_as_uint(pmax), __float_as_uint(pmax), false, false);
              pmax = fmaxf(__uint_as_float(rr[0]), __uint_as_float(rr[1])); }
            const float mn = fmaxf(m_reg, pmax);
            const float alpha = __builtin_amdgcn_exp2f(m_reg - mn);
            m_reg = mn;
            float ps = 0.f;
#pragma unroll
            for (int r = 0; r < 16; ++r) { p0[r] = __builtin_amdgcn_exp2f(p0[r] - mn); p1[r] = __builtin_amdgcn_exp2f(p1[r] - mn); ps += p0[r] + p1[r]; }
            { auto rr = __builtin_amdgcn_permlane32_swap(__float_as_uint(ps), __float_as_uint(ps), false, false);
              ps = __uint_as_float(rr[0]) + __uint_as_float(rr[1]); }
            l_reg = l_reg * alpha + ps;
            if (__any(alpha < 1.f)) {
                if (hi == 0) al_l[r32] = alpha;
                asm volatile("s_waitcnt lgkmcnt(0)" ::: "memory");
#pragma unroll
                for (int r = 0; r < 16; ++r) { const float al = al_l[crow(r, hi)];
#pragma unroll
                    for (int d = 0; d < 4; ++d) o[d][r] *= al; }
            }
            bf16x8 pa0, pa1, pa2, pa3;
#define PK4(P, BASE, OUT) do { unsigned a0 = cvtpk(P[BASE + 0], P[BASE + 1]), a1 = cvtpk(P[BASE + 2], P[BASE + 3]);   \
    unsigned b0 = cvtpk(P[BASE + 4], P[BASE + 5]), b1 = cvtpk(P[BASE + 6], P[BASE + 7]);                              \
    auto r0 = __builtin_amdgcn_permlane32_swap(a0, b0, false, false); auto r1 = __builtin_amdgcn_permlane32_swap(a1, b1, false, false); \
    u32x4 w = {r0[0], r1[0], r0[1], r1[1]}; OUT = *reinterpret_cast<bf16x8*>(&w); } while (0)
            PK4(p0, 0, pa0); PK4(p0, 8, pa1); PK4(p1, 0, pa2); PK4(p1, 8, pa3);
#undef PK4
            pv_one<0>(o[0], vb0, pa0, pa1, pa2, pa3); pv_one<1>(o[1], vb0, pa0, pa1, pa2, pa3);
            pv_one<2>(o[2], vb0, pa0, pa1, pa2, pa3); pv_one<3>(o[3], vb0, pa0, pa1, pa2, pa3);
        }
    }
#undef ALOAD
    if (SINK) l_reg += __builtin_amdgcn_exp2f(a.sink2 - m_reg);
    if (hi == 0) li_l[r32] = l_reg;
    if (WLSE) { if (hi == 0) a.lse[(long)qi * a.ldl] = (m_reg + __builtin_amdgcn_logf(l_reg)) * LN2; }
    asm volatile("s_waitcnt lgkmcnt(0)" ::: "memory");
    bf16_t gv[16][4];
#pragma unroll
    for (int r = 0; r < 16; ++r) {
        const bf16_t* gp = a.G + (long)(a.i0 + wid * 32 + crow(r, hi)) * a.ldg + r32;
#pragma unroll
        for (int d0 = 0; d0 < 4; ++d0) gv[r][d0] = gp[d0 * 32];
    }
#pragma unroll
    for (int r = 0; r < 16; ++r) {
        const int row = crow(r, hi);
        const float rl = __builtin_amdgcn_rcpf(li_l[row]);
        const long i = a.i0 + wid * 32 + row;
        bf16_t* op = a.O + i * a.ldo + r32;
#pragma unroll
        for (int d0 = 0; d0 < 4; ++d0) {
            const float g = bf2f(gv[r][d0]);
            const float sg = g * __builtin_amdgcn_rcpf(1.0f + __builtin_amdgcn_exp2f(-LOG2E * g));
            op[d0 * 32] = (bf16_t)cvtpk(o[d0][r] * rl * sg, 0.f);
        }
    }
}


constexpr int DL_V = 0, DL_K = 32768, DL_P = 65536, DL_WS = 81920;
template <int DQK>
__device__ __forceinline__ void d_qkt(f32x16& p0, f32x16& p1, const lds_u8* Ks, const lds_u8* Ps, const bf16x8* qr, int r32, int hi) {
#pragma unroll
    for (int r = 0; r < 16; ++r) { p0[r] = 0.f; p1[r] = 0.f; }
#pragma unroll
    for (int d0 = 0; d0 < 8; ++d0) { const int cb = (d0 * 16 + hi * 8) * 2;
        const bf16x8 b0 = *(const LAS bf16x8*)(Ks + KSWZ(r32, cb)), b1 = *(const LAS bf16x8*)(Ks + KSWZ(32 + r32, cb));
        p0 = __builtin_amdgcn_mfma_f32_32x32x16_bf16(b0, qr[d0], p0, 0, 0, 0);
        p1 = __builtin_amdgcn_mfma_f32_32x32x16_bf16(b1, qr[d0], p1, 0, 0, 0); }
    if constexpr (DQK == 192) {
#pragma unroll
        for (int d0 = 0; d0 < 4; ++d0) { const int cb = (d0 * 16 + hi * 8) * 2;
            const bf16x8 b0 = *(const LAS bf16x8*)(Ps + PSWZ(r32, cb)), b1 = *(const LAS bf16x8*)(Ps + PSWZ(32 + r32, cb));
            p0 = __builtin_amdgcn_mfma_f32_32x32x16_bf16(b0, qr[8 + d0], p0, 0, 0, 0);
            p1 = __builtin_amdgcn_mfma_f32_32x32x16_bf16(b1, qr[8 + d0], p1, 0, 0, 0); }
    }
}
__device__ __forceinline__ void d_partialSM(f32x16& p0, f32x16& p1, float& m_reg, float& mn, float& alpha, const float C) {
    float pmax = p0[0];
#pragma unroll
    for (int r = 1; r < 16; ++r) pmax = fmaxf(pmax, p0[r]);
#pragma unroll
    for (int r = 0; r < 16; ++r) pmax = fmaxf(pmax, p1[r]);
    { auto rr = __builtin_amdgcn_permlane32_swap(__float_as_uint(pmax), __float_as_uint(pmax), false, false);
      pmax = fmaxf(__uint_as_float(rr[0]), __uint_as_float(rr[1])); }
    if (__builtin_expect(__all((pmax - m_reg) * C <= 8.0f * LOG2E), 1)) { mn = m_reg; alpha = 1.f; }
    else { mn = fmaxf(m_reg, pmax); alpha = __builtin_amdgcn_exp2f((m_reg - mn) * C); m_reg = mn; }
    const float mnC = -mn * C;
#pragma unroll
    for (int r = 0; r < 16; ++r) p0[r] = fmaf(p0[r], C, mnC);
#pragma unroll
    for (int r = 0; r < 16; ++r) p1[r] = fmaf(p1[r], C, mnC);
#pragma unroll
    for (int r = 0; r < 16; ++r) p0[r] = __builtin_amdgcn_exp2f(p0[r]);
}
__device__ __forceinline__ void d_finishSM(f32x16& p0, f32x16& p1, float alpha, float& l_reg, bf16x8& pa0, bf16x8& pa1, bf16x8& pa2, bf16x8& pa3) {
#pragma unroll
    for (int r = 0; r < 16; ++r) p1[r] = __builtin_amdgcn_exp2f(p1[r]);
    float ps = 0;
#pragma unroll
    for (int r = 0; r < 16; ++r) ps += p0[r];
#pragma unroll
    for (int r = 0; r < 16; ++r) ps += p1[r];
    { auto rr = __builtin_amdgcn_permlane32_swap(__float_as_uint(ps), __float_as_uint(ps), false, false);
      ps = __uint_as_float(rr[0]) + __uint_as_float(rr[1]); }
    l_reg = l_reg * alpha + ps;
#define PK4(P, BASE, OUT) do { unsigned a0 = cvtpk(P[BASE + 0], P[BASE + 1]), a1 = cvtpk(P[BASE + 2], P[BASE + 3]);   \
    unsigned b0 = cvtpk(P[BASE + 4], P[BASE + 5]), b1 = cvtpk(P[BASE + 6], P[BASE + 7]);                              \
    auto r0 = __builtin_amdgcn_permlane32_swap(a0, b0, false, false); auto r1 = __builtin_amdgcn_permlane32_swap(a1, b1, false, false); \
    u32x4 w = {r0[0], r1[0], r0[1], r1[1]}; OUT = *reinterpret_cast<bf16x8*>(&w); } while (0)
    PK4(p0, 0, pa0); PK4(p0, 8, pa1); PK4(p1, 0, pa2); PK4(p1, 8, pa3);
#undef PK4
}
__device__ __forceinline__ void d_pv(f32x16* o, int vb, bf16x8 pa0, bf16x8 pa1, bf16x8 pa2, bf16x8 pa3) {
    pv_one<0>(o[0], vb, pa0, pa1, pa2, pa3); pv_one<1>(o[1], vb, pa0, pa1, pa2, pa3); pv_one<2>(o[2], vb, pa0, pa1, pa2, pa3); pv_one<3>(o[3], vb, pa0, pa1, pa2, pa3);
}
#define SBAR() __builtin_amdgcn_sched_barrier(0)

template <int DQK, bool ROPEQ, int SDEPTH>
__device__ __forceinline__ void attn_dense_unit(lds_u8* lds, const AttnArgs& a) {
    constexpr int ND0 = DQK / 16;
    const int tid = pg8::opaque_tid(), wid = tid >> 6, lane = tid & 63, r32 = lane & 31, hi = lane >> 5;
    lds_u8* V_lds = lds + DL_V; lds_u8* K_lds = lds + DL_K; lds_u8* P_lds = lds + DL_P;
    LAS float* wsf = (LAS float*)(lds + DL_WS) + wid * 64; LAS float* li_l = wsf; LAS float* al_l = wsf + 32;
    const float C = a.C;
    __syncthreads();
    const int qi = a.i0 + wid * 32 + r32;
    float m_reg = -1e30f, l_reg = 0.f;
    f32x16 o[4];
#pragma unroll
    for (int d = 0; d < 4; ++d)
#pragma unroll
        for (int r = 0; r < 16; ++r) o[d][r] = 0.f;
    bf16x8 qr[ND0];
    {
        const bf16_t* Qw = a.Q + (long)qi * a.ldq + hi * 8;
#pragma unroll
        for (int d0 = 0; d0 < ND0; ++d0) qr[d0] = *(const bf16x8*)(Qw + d0 * 16);
    }
    if constexpr (ROPEQ) {
#pragma unroll
        for (int dd = 0; dd < 2; ++dd) {
            bf16x8 x1 = qr[8 + dd], x2 = qr[10 + dd];
#pragma unroll
            for (int j = 0; j < 8; ++j) {
                const float2 c = a.cs[qi * 32 + dd * 16 + hi * 8 + j];
                const float f1 = bf2f((bf16_t)x1[j]), f2 = bf2f((bf16_t)x2[j]);
                x1[j] = (short)f2bf(f1 * c.x - f2 * c.y); x2[j] = (short)f2bf(f2 * c.x + f1 * c.y);
            }
            qr[8 + dd] = x1; qr[10 + dd] = x2;
        }
    }
    const int sr = tid >> 4, sc = (tid & 15) * 8, vst0 = v_st(sr, sc), vst1 = v_st(32 + sr, sc), kst0 = KSWZ(sr, sc * 2), kst1 = KSWZ(32 + sr, sc * 2);
    const int pr_ = tid >> 3, pc = (tid & 7) * 8, pst = PSWZ(pr_, pc * 2);
    const int vb0 = (int)(unsigned)(size_t)V_lds + v_rd_base(lane);
    struct { bf16x8 vs0, vs1, ks0, ks1, kp; } sr_[SDEPTH];
#define SLOAD(i, k0) do { sr_[i].vs0 = *(const bf16x8*)(a.V + (long)((k0) + sr) * a.ldv + sc); sr_[i].vs1 = *(const bf16x8*)(a.V + (long)((k0) + 32 + sr) * a.ldv + sc); \
    sr_[i].ks0 = *(const bf16x8*)(a.K + (long)((k0) + sr) * a.ldk + sc); sr_[i].ks1 = *(const bf16x8*)(a.K + (long)((k0) + 32 + sr) * a.ldk + sc); \
    if constexpr (DQK == 192) sr_[i].kp = *(const bf16x8*)(a.K2 + (long)((k0) + pr_) * a.ldk2 + pc); } while (0)
#define SWRITE(b, i) do { *(LAS bf16x8*)(V_lds + (b) * 16384 + vst0) = sr_[i].vs0; *(LAS bf16x8*)(V_lds + (b) * 16384 + vst1) = sr_[i].vs1; \
    *(LAS bf16x8*)(K_lds + (b) * 16384 + kst0) = sr_[i].ks0; *(LAS bf16x8*)(K_lds + (b) * 16384 + kst1) = sr_[i].ks1; \
    if constexpr (DQK == 192) *(LAS bf16x8*)(P_lds + (b) * 8192 + pst) = sr_[i].kp; } while (0)
#define SWAIT() do { if constexpr (SDEPTH == 2) { if constexpr (DQK == 192) asm volatile("s_waitcnt vmcnt(5)" ::: "memory"); else asm volatile("s_waitcnt vmcnt(4)" ::: "memory"); } \
    else asm volatile("s_waitcnt vmcnt(0)" ::: "memory"); } while (0)
#define RESC(al) do { if (__any((al) < 1.f)) { if (hi == 0) al_l[r32] = (al); asm volatile("s_waitcnt lgkmcnt(0)" ::: "memory"); \
    _Pragma("unroll") for (int r = 0; r < 16; ++r) { const float s_ = al_l[crow(r, hi)]; _Pragma("unroll") for (int d = 0; d < 4; ++d) o[d][r] *= s_; } } } while (0)
    f32x16 pA0, pA1, pB0, pB1; float mnA, mnB, alA, alB; bf16x8 pa0, pa1, pa2, pa3; const int NT = a.L / 64;
    constexpr int SE = 0, SO = SDEPTH - 1;
    SLOAD(SE, 0); asm volatile("s_waitcnt vmcnt(0)" ::: "memory"); SWRITE(0, SE); __syncthreads();
    d_qkt<DQK>(pA0, pA1, K_lds, P_lds, qr, r32, hi); d_partialSM(pA0, pA1, m_reg, mnA, alA, C);
    SLOAD(SO, 64); if constexpr (SDEPTH == 2) { if (2 < NT) SLOAD(SE, 128); }
    SWAIT(); SWRITE(1, SO); __syncthreads();
    for (int j = 1; j + 1 < NT; j += 2) {
        SBAR(); d_qkt<DQK>(pB0, pB1, K_lds + 16384, P_lds + 8192, qr, r32, hi);
        d_finishSM(pA0, pA1, alA, l_reg, pa0, pa1, pa2, pa3); SBAR();
        SLOAD(SO, (j + SDEPTH) * 64); SBAR();
        d_pv(o, vb0, pa0, pa1, pa2, pa3); d_partialSM(pB0, pB1, m_reg, mnB, alB, C);
        __syncthreads(); SWAIT(); SWRITE(0, SE);
        RESC(alB); __syncthreads();
        SBAR(); d_qkt<DQK>(pA0, pA1, K_lds, P_lds, qr, r32, hi);
        d_finishSM(pB0, pB1, alB, l_reg, pa0, pa1, pa2, pa3); SBAR();
        if (SDEPTH == 1 || j + 3 < NT) SLOAD(SE, (j + 1 + SDEPTH) * 64); SBAR();
        d_pv(o, vb0 + 16384, pa0, pa1, pa2, pa3); d_partialSM(pA0, pA1, m_reg, mnA, alA, C);
        __syncthreads(); SWAIT(); SWRITE(1, SO);
        RESC(alA); __syncthreads();
    }
    SBAR(); d_qkt<DQK>(pB0, pB1, K_lds + 16384, P_lds + 8192, qr, r32, hi);
    d_finishSM(pA0, pA1, alA, l_reg, pa0, pa1, pa2, pa3); SBAR();
    d_pv(o, vb0, pa0, pa1, pa2, pa3); d_partialSM(pB0, pB1, m_reg, mnB, alB, C);
    __syncthreads(); RESC(alB);
    d_finishSM(pB0, pB1, alB, l_reg, pa0, pa1, pa2, pa3); SBAR();
    d_pv(o, vb0 + 16384, pa0, pa1, pa2, pa3);
#undef SLOAD
#undef SWRITE
#undef SWAIT
#undef RESC
    if (hi == 0) li_l[r32] = l_reg;
    asm volatile("s_waitcnt lgkmcnt(0)" ::: "memory");
    bf16_t gv[16][4];
#pragma unroll
    for (int r = 0; r < 16; ++r) {
        const bf16_t* gp = a.G + (long)(a.i0 + wid * 32 + crow(r, hi)) * a.ldg + r32;
#pragma unroll
        for (int d0 = 0; d0 < 4; ++d0) gv[r][d0] = gp[d0 * 32];
    }
#pragma unroll
    for (int r = 0; r < 16; ++r) {
        const int row = crow(r, hi);
        const float rl = __builtin_amdgcn_rcpf(li_l[row]);
        const long i = a.i0 + wid * 32 + row;
        bf16_t* op = a.O + i * a.ldo + r32;
#pragma unroll
        for (int d0 = 0; d0 < 4; ++d0) {
            const float g = bf2f(gv[r][d0]);
            const float sg = g * __builtin_amdgcn_rcpf(1.0f + __builtin_amdgcn_exp2f(-LOG2E * g));
            op[d0 * 32] = (bf16_t)cvtpk(o[d0][r] * rl * sg, 0.f);
        }
    }
}


constexpr int D3_V = 0, D3_K = 49152, D3_P = 98304, D3_WS = 122880;
template <int DQK, bool ROPEQ>
__device__ __forceinline__ void attn_dense_unit3(lds_u8* lds, const AttnArgs& a) {
    constexpr int ND0 = DQK / 16;
    const int tid = pg8::opaque_tid(), wid = tid >> 6, lane = tid & 63, r32 = lane & 31, hi = lane >> 5;
    lds_u8* V_lds = lds + D3_V; lds_u8* K_lds = lds + D3_K; lds_u8* P_lds = lds + D3_P;
    LAS float* wsf = (LAS float*)(lds + D3_WS) + wid * 64; LAS float* li_l = wsf; LAS float* al_l = wsf + 32;
    const float C = a.C;
    __syncthreads();
    const int qi = a.i0 + wid * 32 + r32;
    float m_reg = -1e30f, l_reg = 0.f;
    f32x16 o[4];
#pragma unroll
    for (int d = 0; d < 4; ++d)
#pragma unroll
        for (int r = 0; r < 16; ++r) o[d][r] = 0.f;
    bf16x8 qr[ND0];
    {
        const bf16_t* Qw = a.Q + (long)qi * a.ldq + hi * 8;
#pragma unroll
        for (int d0 = 0; d0 < ND0; ++d0) qr[d0] = *(const bf16x8*)(Qw + d0 * 16);
    }
    if constexpr (ROPEQ) {
#pragma unroll
        for (int dd = 0; dd < 2; ++dd) {
            bf16x8 x1 = qr[8 + dd], x2 = qr[10 + dd];
#pragma unroll
            for (int j = 0; j < 8; ++j) {
                const float2 c = a.cs[qi * 32 + dd * 16 + hi * 8 + j];
                const float f1 = bf2f((bf16_t)x1[j]), f2 = bf2f((bf16_t)x2[j]);
                x1[j] = (short)f2bf(f1 * c.x - f2 * c.y); x2[j] = (short)f2bf(f2 * c.x + f1 * c.y);
            }
            qr[8 + dd] = x1; qr[10 + dd] = x2;
        }
    }
    const int sr = tid >> 4, sc = (tid & 15) * 8, vst0 = v_st(sr, sc), vst1 = v_st(32 + sr, sc), kst0 = KSWZ(sr, sc * 2), kst1 = KSWZ(32 + sr, sc * 2);
    const int pr_ = tid >> 3, pc = (tid & 7) * 8, pst = PSWZ(pr_, pc * 2);
    const int vb0 = (int)(unsigned)(size_t)V_lds + v_rd_base(lane);
    bf16x8 s_vs0, s_vs1, s_ks0, s_ks1, s_kp;
#define SLOAD(k0) do { s_vs0 = *(const bf16x8*)(a.V + (long)((k0) + sr) * a.ldv + sc); s_vs1 = *(const bf16x8*)(a.V + (long)((k0) + 32 + sr) * a.ldv + sc); \
    s_ks0 = *(const bf16x8*)(a.K + (long)((k0) + sr) * a.ldk + sc); s_ks1 = *(const bf16x8*)(a.K + (long)((k0) + 32 + sr) * a.ldk + sc); \
    if constexpr (DQK == 192) s_kp = *(const bf16x8*)(a.K2 + (long)((k0) + pr_) * a.ldk2 + pc); } while (0)
#define SWRITE(b) do { *(LAS bf16x8*)(V_lds + (b) * 16384 + vst0) = s_vs0; *(LAS bf16x8*)(V_lds + (b) * 16384 + vst1) = s_vs1; \
    *(LAS bf16x8*)(K_lds + (b) * 16384 + kst0) = s_ks0; *(LAS bf16x8*)(K_lds + (b) * 16384 + kst1) = s_ks1; \
    if constexpr (DQK == 192) *(LAS bf16x8*)(P_lds + (b) * 8192 + pst) = s_kp; } while (0)
#define RESC(al) do { if (__any((al) < 1.f)) { if (hi == 0) al_l[r32] = (al); asm volatile("s_waitcnt lgkmcnt(0)" ::: "memory"); \
    _Pragma("unroll") for (int r = 0; r < 16; ++r) { const float s_ = al_l[crow(r, hi)]; _Pragma("unroll") for (int d = 0; d < 4; ++d) o[d][r] *= s_; } } } while (0)
#define ROT() do { bv = bq; bq = bw; bw = (bw == 2) ? 0 : bw + 1; } while (0)
    f32x16 pA0, pA1, pB0, pB1; float mnA, mnB, alA, alB; bf16x8 pa0, pa1, pa2, pa3; const int NT = a.L / 64;
    SLOAD(0); SWRITE(0); SLOAD(64); SWRITE(1); SLOAD(128); __syncthreads();
    d_qkt<DQK>(pA0, pA1, K_lds, P_lds, qr, r32, hi); d_partialSM(pA0, pA1, m_reg, mnA, alA, C);
    int bq = 1, bv = 0, bw = 2;
    for (int j = 1; j + 1 < NT; j += 2) {
        SBAR(); d_qkt<DQK>(pB0, pB1, K_lds + bq * 16384, P_lds + bq * 8192, qr, r32, hi);
        d_finishSM(pA0, pA1, alA, l_reg, pa0, pa1, pa2, pa3); SBAR();
        d_pv(o, vb0 + bv * 16384, pa0, pa1, pa2, pa3); d_partialSM(pB0, pB1, m_reg, mnB, alB, C);
        SWRITE(bw);
        if (j + 2 < NT) SLOAD((j + 2) * 64);
        RESC(alB); __syncthreads(); ROT();
        SBAR(); d_qkt<DQK>(pA0, pA1, K_lds + bq * 16384, P_lds + bq * 8192, qr, r32, hi);
        d_finishSM(pB0, pB1, alB, l_reg, pa0, pa1, pa2, pa3); SBAR();
        d_pv(o, vb0 + bv * 16384, pa0, pa1, pa2, pa3); d_partialSM(pA0, pA1, m_reg, mnA, alA, C);
        if (j + 2 < NT) SWRITE(bw);
        if (j + 3 < NT) SLOAD((j + 3) * 64);
        RESC(alA); __syncthreads(); ROT();
    }
    SBAR(); d_qkt<DQK>(pB0, pB1, K_lds + bq * 16384, P_lds + bq * 8192, qr, r32, hi);
    d_finishSM(pA0, pA1, alA, l_reg, pa0, pa1, pa2, pa3); SBAR();
    d_pv(o, vb0 + bv * 16384, pa0, pa1, pa2, pa3); d_partialSM(pB0, pB1, m_reg, mnB, alB, C);
    RESC(alB);
    d_finishSM(pB0, pB1, alB, l_reg, pa0, pa1, pa2, pa3); SBAR();
    d_pv(o, vb0 + bq * 16384, pa0, pa1, pa2, pa3);
#undef SLOAD
#undef SWRITE
#undef RESC
#undef ROT
    if (hi == 0) li_l[r32] = l_reg;
    asm volatile("s_waitcnt lgkmcnt(0)" ::: "memory");
    bf16_t gv[16][4];
#pragma unroll
    for (int r = 0; r < 16; ++r) {
        const bf16_t* gp = a.G + (long)(a.i0 + wid * 32 + crow(r, hi)) * a.ldg + r32;
#pragma unroll
        for (int d0 = 0; d0 < 4; ++d0) gv[r][d0] = gp[d0 * 32];
    }
#pragma unroll
    for (int r = 0; r < 16; ++r) {
        const int row = crow(r, hi);
        const float rl = __builtin_amdgcn_rcpf(li_l[row]);
        const long i = a.i0 + wid * 32 + row;
        bf16_t* op = a.O + i * a.ldo + r32;
#pragma unroll
        for (int d0 = 0; d0 < 4; ++d0) {
            const float g = bf2f(gv[r][d0]);
            const float sg = g * __builtin_amdgcn_rcpf(1.0f + __builtin_amdgcn_exp2f(-LOG2E * g));
            op[d0 * 32] = (bf16_t)cvtpk(o[d0][r] * rl * sg, 0.f);
        }
    }
}

constexpr int BL_WS = 131072, BL_LUT = 133120, BL_LUTSTRIDE = 260;
constexpr int BL_LUT2 = 65536, BL_LUT2MARGIN = 320, BL_LUT2STRIDE = 960;
struct BandArgs {
    const bf16_t* Q; long ldq;
    const bf16_t* K; const bf16_t* V; long ldk;
    const bf16_t* G; long ldg; bf16_t* O; long ldo;
    float* lse; long ldl;
    const float* bias; const float* sinks;
    int i0, L, side, dil, nt;
    float C;
};
template <int NH, bool SINK, bool WLSE, int PROBE = 0>
__device__ __forceinline__ void attn_band_unit(lds_u8* lds, const BandArgs& a) {
    constexpr int WPH = 8 / NH;
    const int tid = pg8::opaque_tid(), wid = tid >> 6, lane = tid & 63, r32 = lane & 31, hi = lane >> 5;
    const int hw = wid / WPH, rb = wid % WPH;
    LAS float* wsf = (LAS float*)(lds + BL_WS) + wid * 64; LAS float* li_l = wsf; LAS float* al_l = wsf + 32;
    LAS float* lut = (LAS float*)(lds + BL_LUT2) + hw * BL_LUT2STRIDE + BL_LUT2MARGIN;
    const int side = a.side, nlut = 2 * side + 1;
    __syncthreads();
    const int qi = a.i0 + rb * 32 + r32;
    bf16x8 qr[8];
    {
        const bf16_t* Qw = a.Q + hw * 128 + (long)qi * a.ldq + hi * 8;
#pragma unroll
        for (int d0 = 0; d0 < 8; ++d0) qr[d0] = *(const bf16x8*)(Qw + d0 * 16);
    }
    const int t_lo = (a.i0 >= side) ? 0 : (side - a.i0) / 64;
    int t_hi = (a.L - a.i0 + side) / 64; if (t_hi > a.nt) t_hi = a.nt;
    const int lo_w = rb >> 1, hi_w = (rb * 32 + 31 + 2 * side) >> 6;
    const int sr = tid >> 4, sc = (tid & 15) * 8;
    const int vst0 = v_st(sr, sc), vst1 = v_st(32 + sr, sc), kst0 = KSWZ(sr, sc * 2), kst1 = KSWZ(32 + sr, sc * 2);
    const int vbase = (int)(unsigned)(size_t)(lds + 16384) + v_rd_base(lane);
    constexpr int GT = 2;
    bf16x8 st[GT][4];
#define BLOAD(G0) do { _Pragma("unroll") for (int tt = 0; tt < GT; ++tt) { int T_ = (G0) + tt; if (T_ < t_lo) T_ = t_lo; if (T_ > t_hi - 1) T_ = t_hi - 1; \
            const long kb_ = (long)(a.i0 - side + 64 * T_); \
            st[tt][0] = *(const bf16x8*)(a.K + (kb_ + sr) * a.ldk + sc); st[tt][1] = *(const bf16x8*)(a.K + (kb_ + 32 + sr) * a.ldk + sc); \
            st[tt][2] = *(const bf16x8*)(a.V + (kb_ + sr) * a.ldk + sc); st[tt][3] = *(const bf16x8*)(a.V + (kb_ + 32 + sr) * a.ldk + sc); } } while (0)
    float m_reg = -1e29f, l_reg = 0.f;
    f32x16 o[4];
#pragma unroll
    for (int d = 0; d < 4; ++d)
#pragma unroll
        for (int r = 0; r < 16; ++r) o[d][r] = 0.f;
    const int g_lo = (t_lo / GT) * GT;
    BLOAD(g_lo);
    for (int idx = tid; idx < NH * nlut; idx += 512) { const int h = idx / nlut, e = idx - h * nlut;
        ((LAS float*)(lds + BL_LUT2))[h * BL_LUT2STRIDE + BL_LUT2MARGIN + e] = a.bias[rel_bucket((e - side) * a.dil) * 20 + h] * LOG2E; }
    for (int G0 = g_lo; G0 < t_hi; G0 += GT) {
        __syncthreads();
#pragma unroll
        for (int tt = 0; tt < GT; ++tt) {
            *(LAS bf16x8*)(lds + tt * 32768 + kst0) = st[tt][0]; *(LAS bf16x8*)(lds + tt * 32768 + kst1) = st[tt][1];
            *(LAS bf16x8*)(lds + tt * 32768 + 16384 + vst0) = st[tt][2]; *(LAS bf16x8*)(lds + tt * 32768 + 16384 + vst1) = st[tt][3];
        }
        if (G0 + GT < t_hi) BLOAD(G0 + GT);
        __syncthreads();
#pragma unroll 1
        for (int tt = 0; tt < GT; ++tt) {
            const int T = G0 + tt;
            if (T < t_lo || T >= t_hi || T < lo_w || T > hi_w) continue;
            if (PROBE >= 2) { l_reg += ((const LAS float*)(lds + tt * 32768))[tid]; continue; }
            const lds_u8* Kl = lds + tt * 32768; const int vb0 = vbase + tt * 32768;
            f32x16 p0, p1;
#pragma unroll
            for (int r = 0; r < 16; ++r) { p0[r] = 0.f; p1[r] = 0.f; }
#pragma unroll
            for (int d0 = 0; d0 < 8; ++d0) { const int cb = (d0 * 16 + hi * 8) * 2;
                const bf16x8 b0 = *(const LAS bf16x8*)(Kl + KSWZ(r32, cb)), b1 = *(const LAS bf16x8*)(Kl + KSWZ(32 + r32, cb));
                p0 = __builtin_amdgcn_mfma_f32_32x32x16_bf16(b0, qr[d0], p0, 0, 0, 0);
                p1 = __builtin_amdgcn_mfma_f32_32x32x16_bf16(b1, qr[d0], p1, 0, 0, 0); }
            const int base = a.i0 + 64 * T - qi;
            const LAS float* lrow = lut + base + 4 * hi;
            const int wlo = 64 * T - rb * 32 - 31, whi = 64 * T - rb * 32 + 63;
            if (wlo >= 0 && whi <= 2 * side) {
#pragma unroll
                for (int r = 0; r < 16; ++r) { const int c_ = (r & 3) + 8 * (r >> 2);
                    p0[r] = fmaf(p0[r], a.C, lrow[c_]); p1[r] = fmaf(p1[r], a.C, lrow[c_ + 32]); }
            } else {
                const int b0i = base + 4 * hi;
#pragma unroll
                for (int r = 0; r < 16; ++r) { const int c_ = (r & 3) + 8 * (r >> 2);
                    const bool ok0 = (unsigned)(b0i + c_) <= (unsigned)(2 * side), ok1 = (unsigned)(b0i + c_ + 32) <= (unsigned)(2 * side);
                    const float v0 = fmaf(p0[r], a.C, lrow[c_]), v1 = fmaf(p1[r], a.C, lrow[c_ + 32]);
                    p0[r] = ok0 ? v0 : -1e30f; p1[r] = ok1 ? v1 : -1e30f; }
            }
            float pmax = p0[0];
#pragma unroll
            for (int r = 1; r < 16; ++r) pmax = fmaxf(pmax, p0[r]);
#pragma unroll
            for (int r = 0; r < 16; ++r) pmax = fmaxf(pmax, p1[r]);
            { auto rr = __builtin_amdgcn_permlane32_swap(__float_as_uint(pmax), __float_as_uint(pmax), false, false);
              pmax = fmaxf(__uint_as_float(rr[0]), __uint_as_float(rr[1])); }
            const float mn = fmaxf(m_reg, pmax);
            const float alpha = __builtin_amdgcn_exp2f(m_reg - mn);
            m_reg = mn;
            float ps = 0.f;
#pragma unroll
            for (int r = 0; r < 16; ++r) { p0[r] = __builtin_amdgcn_exp2f(p0[r] - mn); p1[r] = __builtin_amdgcn_exp2f(p1[r] - mn); ps += p0[r] + p1[r]; }
            { auto rr = __builtin_amdgcn_permlane32_swap(__float_as_uint(ps), __float_as_uint(ps), false, false);
              ps = __uint_as_float(rr[0]) + __uint_as_float(rr[1]); }
            l_reg = l_reg * alpha + ps;
            if (__any(alpha < 1.f)) {
                if (hi == 0) al_l[r32] = alpha;
                asm volatile("s_waitcnt lgkmcnt(0)" ::: "memory");
#pragma unroll
                for (int r = 0; r < 16; ++r) { const float al = al_l[crow(r, hi)];
#pragma unroll
                    for (int d = 0; d < 4; ++d) o[d][r] *= al; }
            }
            bf16x8 pa0, pa1, pa2, pa3;
#define PK4(P, BASE, OUT) do { unsigned a0 = cvtpk(P[BASE + 0], P[BASE + 1]), a1 = cvtpk(P[BASE + 2], P[BASE + 3]);   \
    unsigned b0 = cvtpk(P[BASE + 4], P[BASE + 5]), b1 = cvtpk(P[BASE + 6], P[BASE + 7]);                              \
    auto r0 = __builtin_amdgcn_permlane32_swap(a0, b0, false, false); auto r1 = __builtin_amdgcn_permlane32_swap(a1, b1, false, false); \
    u32x4 w = {r0[0], r1[0], r0[1], r1[1]}; OUT = *reinterpret_cast<bf16x8*>(&w); } while (0)
            PK4(p0, 0, pa0); PK4(p0, 8, pa1); PK4(p1, 0, pa2); PK4(p1, 8, pa3);
#undef PK4
            pv_one<0>(o[0], vb0, pa0, pa1, pa2, pa3); pv_one<1>(o[1], vb0, pa0, pa1, pa2, pa3);
            pv_one<2>(o[2], vb0, pa0, pa1, pa2, pa3); pv_one<3>(o[3], vb0, pa0, pa1, pa2, pa3);
        }
    }
#undef BLOAD
    if (PROBE >= 1) { float acc_ = l_reg + m_reg; for (int d = 0; d < 4; ++d) for (int r = 0; r < 16; ++r) acc_ += o[d][r]; if (acc_ == 12345.678f) a.O[tid] = 0; return; }
    if (SINK) l_reg += __builtin_amdgcn_exp2f(a.sinks[hw] * LOG2E - m_reg);
    if (hi == 0) li_l[r32] = l_reg;
    if (WLSE) { if (hi == 0) a.lse[hw + (long)qi * a.ldl] = (m_reg + __builtin_amdgcn_logf(l_reg)) * LN2; }
    asm volatile("s_waitcnt lgkmcnt(0)" ::: "memory");
    bf16_t gv[16][4];
#pragma unroll
    for (int r = 0; r < 16; ++r) {
        const bf16_t* gp = a.G + hw * 128 + (long)(a.i0 + rb * 32 + crow(r, hi)) * a.ldg + r32;
#pragma unroll
        for (int d0 = 0; d0 < 4; ++d0) gv[r][d0] = gp[d0 * 32];
    }
#pragma unroll
    for (int r = 0; r < 16; ++r) {
        const int row = crow(r, hi);
        const float rl = __builtin_amdgcn_rcpf(li_l[row]);
        const long i = a.i0 + rb * 32 + row;
        bf16_t* op = a.O + hw * 128 + i * a.ldo + r32;
#pragma unroll
        for (int d0 = 0; d0 < 4; ++d0) {
            const float g = bf2f(gv[r][d0]);
            const float sg = g * __builtin_amdgcn_rcpf(1.0f + __builtin_amdgcn_exp2f(-LOG2E * g));
            op[d0 * 32] = (bf16_t)cvtpk(o[d0][r] * rl * sg, 0.f);
        }
    }
}

__device__ __forceinline__ void attn_phase(lds_u8* lds, const Params& p, int layer, int wg, int nwg) {
    unsigned char* ws = p.ws;
    const bf16_t* proj = (const bf16_t*)(ws + WS_PROJ);
    bf16_t* mixed = (bf16_t*)(ws + WS_MIXED);
    const float2* cs = (const float2*)(ws + WS_CS);
    constexpr int NA = 256, NC = 256, ND = 256, NBU = 384;
    for (int rep = 0; rep < REP_BAND; ++rep)
    for (int it = (rep == 0 ? wg : NA + NC + wg); it < NA + NC + ND + NBU; it += nwg) {
        AttnArgs a; a.lse = nullptr; a.ldl = 0; a.cs = cs; a.side = 0; a.dil = 1; a.bias = p.rel_bias; a.bcol = 0; a.sink2 = 0.f; a.K2 = nullptr; a.ldk2 = 0; a.L = SEQ;
        if (it < NA) {
            #ifdef LINEAR_MAP
            const int c = it, bh = c >> 4, qb = c & 15, b = bh >> 3, h = bh & 7;
#else
            const int c = it, xcd = c & 7, slot = c >> 3, bh = xcd * 2 + (slot >> 4), qb = slot & 15, b = bh >> 3, h = bh & 7;
#endif
            const size_t t0 = (size_t)b * SEQ;
            const bf16_t* qraw = (const bf16_t*)(ws + WS_QRAW); const bf16_t* kvraw = (const bf16_t*)(ws + WS_KVRAW); const bf16_t* kpe = (const bf16_t*)(ws + WS_KPE);
            a.Q = qraw + t0 * 1536 + h * 192; a.ldq = 1536;
            a.K = kvraw + t0 * 2048 + h * 256; a.ldk = 2048; a.K2 = kpe + t0 * 64; a.ldk2 = 64;
            a.V = kvraw + t0 * 2048 + h * 256 + 128; a.ldv = 2048;
            a.G = proj + t0 * NINP + C_GATE + MX_A + h * 128; a.ldg = NINP;
            a.O = mixed + t0 * MIXW + MX_A + h * 128; a.ldo = MIXW;
            a.i0 = qb * 256; a.C = 0.07216878364870322f * LOG2E;
#ifdef SIMPLE_DENSE
            attn_unit<192, false, false, false, true>(lds, a);
#else
            #ifndef DENSE3BUF
            for (int rep = 0; rep < REP_A; ++rep) attn_dense_unit<192, true, 1>(lds, a);
#else
            for (int rep = 0; rep < REP_A; ++rep) attn_dense_unit3<192, true>(lds, a);
#endif
#endif
        } else if (it < NA + NC) {
            #ifdef LINEAR_MAP
            const int c = it - NA, pair = c >> 4, qb = c & 15, b = pair >> 3, hq = pair & 7, hk = hq >> 2;
#else
            const int c = it - NA, xcd = c & 7, slot = c >> 3, pair = xcd * 2 + (slot >> 4), qb = slot & 15, b = pair >> 3, hq = pair & 7, hk = hq >> 2;
#endif
            const size_t t0 = (size_t)b * SEQ;
            const bf16_t* qc = (const bf16_t*)(ws + WS_QC); const bf16_t* kc = (const bf16_t*)(ws + WS_KC);
            a.Q = qc + t0 * 1024 + hq * 128; a.ldq = 1024;
            a.K = kc + t0 * 256 + hk * 128; a.ldk = 256;
            a.V = proj + t0 * NINP + C_CV + hk * 128; a.ldv = NINP;
            a.G = proj + t0 * NINP + C_GATE + MX_C + hq * 128; a.ldg = NINP;
            a.O = mixed + t0 * MIXW + MX_C + hq * 128; a.ldo = MIXW;
            a.i0 = qb * 256; a.C = 0.08838834764831845f * LOG2E;
#ifdef SIMPLE_DENSE
            attn_unit<128, false, false, false, false>(lds, a);
#else
            #ifndef DENSE3BUF
            for (int rep = 0; rep < REP_C; ++rep) attn_dense_unit<128, false, 2>(lds, a);
#else
            for (int rep = 0; rep < REP_C; ++rep) attn_dense_unit3<128, false>(lds, a);
#endif
#endif
        } else if (it < NA + NC + ND) {
            const int c = it - NA - NC, blk = c & 63, hk = (c >> 6) & 1, b = c >> 7;
            const size_t t0 = (size_t)b * SEQ;
            BandArgs d;
            d.Q = proj + t0 * NINP + C_DQ + hk * 512; d.ldq = NINP;
            d.K = proj + t0 * NINP + C_DK + hk * 128; d.V = proj + t0 * NINP + C_DV + hk * 128; d.ldk = NINP;
            d.G = proj + t0 * NINP + C_GATE + MX_D + hk * 512; d.ldg = NINP;
            d.O = mixed + t0 * MIXW + MX_D + hk * 512; d.ldo = MIXW;
            d.lse = nullptr; d.ldl = 0; d.bias = p.rel_bias + 12 + hk * 4; d.sinks = p.sinks + layer * 8 + hk * 4;
            d.i0 = blk * 64; d.L = SEQ; d.side = 128; d.dil = 1; d.nt = 5; d.C = 0.08838834764831845f * LOG2E;
#if defined(PROBE_D)
            attn_band_unit<4, true, false, PROBE_D>(lds, d);
#endif
            for (int rep2 = 0; rep2 < REP_D; ++rep2) attn_band_unit<4, true, false>(lds, d);
        } else {
            const int c = it - NA - NC - ND, u = c & 15, hh = (c >> 4) & 3, j = (c >> 6) % 3, b = c / 192;
            const int dil = (j == 0) ? 1 : (j == 1 ? 4 : 16), L = SEQ / dil, nblk = L / 256, r = u / nblk, qb = u % nblk;
            const size_t t0 = (size_t)b * SEQ + r; const int head = j * 4 + hh;
            BandArgs d;
            d.Q = proj + t0 * NINP + C_BQ + head * 128; d.ldq = (long)dil * NINP;
            d.K = proj + t0 * NINP + C_BK + head * 128; d.V = proj + t0 * NINP + C_BV + head * 128; d.ldk = (long)dil * NINP;
            d.G = proj + t0 * NINP + C_GATE + MX_B + head * 128; d.ldg = (long)dil * NINP;
            d.O = mixed + t0 * MIXW + MX_B + head * 128; d.ldo = (long)dil * MIXW;
            d.lse = (float*)(ws + WS_LSE) + ((size_t)j * MTOK + t0) * 4 + hh; d.ldl = (long)dil * 4;
            d.bias = p.rel_bias + head; d.sinks = nullptr;
            d.i0 = qb * 256; d.L = L; d.side = 64; d.dil = dil; d.nt = 6; d.C = 0.08838834764831845f * LOG2E;
            for (int rep2 = 0; rep2 < REP_B; ++rep2) attn_band_unit<1, false, true>(lds, d);
        }
    }
}

#define XB_TMO      128
#define XB_XCNT(j)  (256  + 64 * (j))
#define XB_XSUB(j)  (1280 + 64 * (j))
#define XB_XGEN(j)  (2304 + 64 * (j))
#define XB_TOP      3328
#define XB_TOPGEN   3392
#define XCD_BAR_WORDS 3456
#define XB_SPIN_CAP (1u << 18)

__device__ __forceinline__ unsigned xb_ld(unsigned* p)              { return __hip_atomic_load(p, __ATOMIC_RELAXED, __HIP_MEMORY_SCOPE_AGENT); }
__device__ __forceinline__ unsigned xb_add(unsigned* p, unsigned v) { return __hip_atomic_fetch_add(p, v, __ATOMIC_RELAXED, __HIP_MEMORY_SCOPE_AGENT); }
__device__ __forceinline__ unsigned xb_xcc_id() { return (unsigned)__builtin_amdgcn_s_getreg((3 << 11) | 20) & 0xFu; }
#define XB_SPIN(cond, bar) do { unsigned _sp = 0; while (cond) { __builtin_amdgcn_s_sleep(1); \
    if ((++_sp & 255u) == 0u) { if (xb_ld(&(bar)[XB_TMO])) break; if (_sp > XB_SPIN_CAP) { atomicAdd(&(bar)[XB_TMO], 1u); break; } } } } while (0)

struct XcdBarrier {
    unsigned* bar; unsigned x;
    volatile LAS unsigned* st;
};

__device__ __forceinline__ XcdBarrier xcd_barrier_post(unsigned* bar, volatile LAS unsigned* st) {
    XcdBarrier b; b.bar = bar; b.x = xb_xcc_id(); b.st = st;
    if (threadIdx.x == 0) (void)xb_add(&bar[XB_XCNT(b.x)], 1u);
    return b;
}
__device__ __forceinline__ void xcd_barrier_complete(unsigned* bar, unsigned x, unsigned& nloc, unsigned& nx) {
    const unsigned G = gridDim.x * gridDim.y * gridDim.z;
    unsigned sum, cnt, mine, sp = 0u;
    for (;;) {
        sum = 0u; cnt = 0u; mine = 0u;
#pragma unroll
        for (unsigned j = 0; j < 16; ++j) { const unsigned c = xb_ld(&bar[XB_XCNT(j)]); sum += c; cnt += (c > 0u) ? 1u : 0u; mine = (j == x) ? c : mine; }
        if (sum == G) break;
        __builtin_amdgcn_s_sleep(1);
        if ((++sp & 255u) == 0u) { if (xb_ld(&bar[XB_TMO])) break; if (sp > XB_SPIN_CAP) { atomicAdd(&bar[XB_TMO], 1u); break; } }
    }
    nloc = mine > 0u ? mine : 1u; nx = cnt > 0u ? cnt : 1u;
}

__device__ __forceinline__ void xcd_barrier(const XcdBarrier& b) {
    asm volatile("s_waitcnt vmcnt(0)" ::: "memory");
    __syncthreads();
    if (threadIdx.x == 0) {
        unsigned* bar = b.bar;
        __builtin_amdgcn_s_waitcnt(0);
        unsigned nloc = b.st[0], nx = b.st[1];
        if (nloc == 0u) { xcd_barrier_complete(bar, b.x, nloc, nx); b.st[0] = nloc; b.st[1] = nx; }
        const unsigned old = xb_add(&bar[XB_XSUB(b.x)], 1u);
        const unsigned gen = old / nloc;
        if (old + 1u == (gen + 1u) * nloc) {
            __builtin_amdgcn_fence(__ATOMIC_RELEASE, "agent");
            asm volatile("s_waitcnt vmcnt(0)" ::: "memory");
            const unsigned og = xb_add(&bar[XB_TOP], 1u);
            const unsigned tg = og / nx;
            if (og + 1u == (tg + 1u) * nx) xb_add(&bar[XB_TOPGEN], 1u);
            else XB_SPIN(xb_ld(&bar[XB_TOPGEN]) == tg, bar);
            __builtin_amdgcn_fence(__ATOMIC_ACQUIRE, "agent");
            xb_add(&bar[XB_XGEN(b.x)], 1u);
            asm volatile("s_waitcnt vmcnt(0)" ::: "memory");
        } else {
            XB_SPIN(xb_ld(&bar[XB_XGEN(b.x)]) == gen, bar);
            __builtin_amdgcn_fence(__ATOMIC_ACQUIRE, "agent");
            asm volatile("s_waitcnt vmcnt(0)" ::: "memory");
        }
    }
    __syncthreads();
}

__global__ void __launch_bounds__(512) hymba_fwd(Params p0) {
    extern __shared__ __attribute__((aligned(16))) unsigned char shm[];
    lds_u8* lds = (lds_u8*)shm;
    cg::grid_group grid = cg::this_grid();
    const int wg0 = blockIdx.x, nwg0 = gridDim.x;
    const int lo = p0.ph_lo, hi = p0.ph_hi;
    if (lo < 0) grid.sync();
    volatile LAS unsigned* bst = (volatile LAS unsigned*)(lds + LDS_BYTES - 256);
    if (threadIdx.x == 0) { bst[0] = 0u; bst[1] = 0u; }
    __syncthreads();
    XcdBarrier xbar = xcd_barrier_post((unsigned*)(p0.ws + WS_BAR), bst);
    int ph = 0;
#define PH_BEGIN if (lo <= ph && ph < hi) { auto kp4 = (__attribute__((address_space(4))) const char*)__builtin_amdgcn_kernarg_segment_ptr(); asm volatile("" : "+s"(kp4)); \
    const Params& p = *(const Params*)kp4; unsigned char* ws = p.ws; int wg = wg0, nwg = nwg0; asm volatile("" : "+s"(wg), "+s"(nwg)); \
    bf16_t* WinT = (bf16_t*)(ws + WS_WIN); bf16_t* WoutT = (bf16_t*)(ws + WS_WOUT); bf16_t* WuqT = (bf16_t*)(ws + WS_WUQ); bf16_t* WukvT = (bf16_t*)(ws + WS_WUKV); \
    bf16_t* H = (bf16_t*)(ws + WS_H); bf16_t* PROJ = (bf16_t*)(ws + WS_PROJ); float* X1 = (float*)(ws + WS_X1); \
    bf16_t* QAN = (bf16_t*)(ws + WS_QAN); bf16_t* KVAN = (bf16_t*)(ws + WS_KVAN); bf16_t* KPE = (bf16_t*)(ws + WS_KPE); \
    bf16_t* QRAW = (bf16_t*)(ws + WS_QRAW); bf16_t* KVRAW = (bf16_t*)(ws + WS_KVRAW); bf16_t* QC = (bf16_t*)(ws + WS_QC); bf16_t* KC = (bf16_t*)(ws + WS_KC); \
    bf16_t* MIXED = (bf16_t*)(ws + WS_MIXED); bf16_t* DELTA = (bf16_t*)(ws + WS_DELTA); (void)DELTA; float* LSE = (float*)(ws + WS_LSE); float2* CS = (float2*)(ws + WS_CS); \
    (void)WinT; (void)WoutT; (void)WuqT; (void)WukvT; (void)H; (void)PROJ; (void)X1; (void)QAN; (void)KVAN; (void)KPE; (void)QRAW; (void)KVRAW; (void)QC; (void)KC; (void)MIXED; (void)LSE; (void)CS;
#define PH_END } if (lo <= ph && ph + 1 < hi) xcd_barrier(xbar); ++ph;

    PH_BEGIN
        for (int l = 1; l >= 0; --l) {
            cvt_transpose(p.w_ukv + (size_t)l * 512 * 2048, WukvT + (size_t)l * 2048 * 512, 512, 2048, 2048, lds, wg, nwg);
            cvt_transpose(p.w_uq + (size_t)l * 768 * 1536, WuqT + (size_t)l * 1536 * 768, 768, 1536, 1536, lds, wg, nwg);
            if (l == 0) cvt_transpose(p.w_in, WinT, DM, NIN, NINP, lds, wg, nwg);
        }
        build_cs(CS, wg, nwg);
        rmsnorm_rows<0, true>(p.x, nullptr, nullptr, p.g_attn, H, nullptr, wg, nwg);
    PH_END

#pragma unroll 1
    for (int l = 0; l < 2; ++l) {
        if (l > 0) {
            PH_BEGIN
                cvt_transpose(p.w_in + (size_t)l * DM * NIN, WinT + (size_t)l * NINP * DM, DM, NIN, NINP, lds, wg, nwg);
                rmsnorm_rows<1, true>(p.x, DELTA, nullptr, p.g_attn + (size_t)l * DM, H, nullptr, wg, nwg);
            PH_END
        }
        PH_BEGIN
#ifndef NO_GEMM
            pg8::Gemm g{H, WinT + (size_t)l * NINP * DM, MTOK, NINP, DM}; pg8::RevColOrder S; S.init(MTOK, NINP, nwg, wg);
            pg8::EpiBf16P E{PROJ, NINP};
            for (int rep = 0; rep < REP_GEMM; ++rep)
            pg8::gemm_phase<pg8::EpiBf16P, pg8::RevColOrder, GEMM_ALIGN, GEMM_SP2>(lds, g, S, E);
            if (CVT_P0_LAYERS == 1 && l == 0 && nwg == 256 && wg >= 192)
                cvt_transpose(p.w_in + (size_t)DM * NIN, WinT + (size_t)NINP * DM, DM, NIN, NINP, lds, wg - 192, 64);
#endif
        PH_END
        PH_BEGIN
            for (int rep = 0; rep < REP_MISC; ++rep) prep_tokens(PROJ, p.g_qa + l * 768, p.g_kva + l * 512, p.g_qn + l * 128, p.g_kn + l * 128, CS, QAN, KVAN, KPE, QC, KC, (bf16_t*)(ws + WS_DKV), wg, nwg);
        PH_END
        PH_BEGIN
#ifndef NO_GEMM
            for (int rep = 0; rep < REP_UP; ++rep) {
            { pg8::Gemm g{QAN, WuqT + (size_t)l * 1536 * 768, MTOK, 1536, 768}; pg8::StaticOrder S; S.init(MTOK, 1536, nwg, wg);
              pg8::EpiBf16P E{QRAW, 1536};
              pg8::gemm_phase<pg8::EpiBf16P, pg8::StaticOrder, GEMM_ALIGN, GEMM_SP2>(lds, g, S, E); }
            { pg8::Gemm g{KVAN, WukvT + (size_t)l * 2048 * 512, MTOK, 2048, 512}; pg8::StaticOrder S; S.init(MTOK, 2048, nwg, nwg - 1 - wg);
              pg8::EpiBf16P E{KVRAW, 2048};
              pg8::gemm_phase<pg8::EpiBf16P, pg8::StaticOrder, GEMM_ALIGN, GEMM_SP2>(lds, g, S, E); }
            }
#endif
        PH_END
        PH_BEGIN
#ifndef NO_ATTN
            for (int rep = 0; rep < REP_ATTN; ++rep) attn_phase(lds, p, l, wg, nwg);
            if ((CVT_P0_LAYERS == 1 || HIDE_TAIL) && l == 0 && nwg == 256 && wg >= 128) {
                cvt_transpose(p.w_out + (size_t)MIXW * DM, WoutT + (size_t)DM * MIXW, MIXW, DM, DM, lds, wg - 128, 128);
                cvt_transpose(p.w_uq + (size_t)768 * 1536, WuqT + (size_t)1536 * 768, 768, 1536, 1536, lds, wg - 128, 128);
                cvt_transpose(p.w_ukv + (size_t)512 * 2048, WukvT + (size_t)2048 * 512, 512, 2048, 2048, lds, wg - 128, 128);
            }
#endif
        PH_END
        PH_BEGIN
            cvt_transpose(p.w_out + (size_t)l * MIXW * DM, WoutT + (size_t)l * DM * MIXW, MIXW, DM, DM, lds, wg, nwg);
            fixup_b(MIXED, LSE, wg, nwg);
        PH_END
        PH_BEGIN
#ifndef NO_GEMM
            pg8::Gemm g{MIXED, WoutT + (size_t)l * DM * MIXW, MTOK, DM, MIXW}; pg8::StaticOrder S; S.init(MTOK, DM, nwg, wg);
            pg8::EpiBf16P E{DELTA + (size_t)l * MTOK * DM, DM};
            for (int rep = 0; rep < REP_OUT; ++rep)
            pg8::gemm_phase<pg8::EpiBf16P, pg8::StaticOrder, GEMM_ALIGN, GEMM_SP2>(lds, g, S, E);
#endif
        PH_END
    }
    for (int rep = 0; rep < REP_SYNC; ++rep) xcd_barrier(xbar);
    PH_BEGIN
        rmsnorm_rows<2, false>(p.x, DELTA, DELTA + (size_t)MTOK * DM, p.g_final, nullptr, p.out, wg, nwg);
    PH_END
#undef PH_BEGIN
#undef PH_END
}

constexpr int N_PHASES = 15;

extern "C" void kernel_launch(void* const* d_in, const int* in_sizes, int n_in, void* d_out, int out_size, void* d_ws, size_t ws_size, hipStream_t stream) {
    static int grid_blocks = 0;
    if (grid_blocks == 0) {
        if (n_in != 13 || ws_size < WS_END || out_size != MTOK * DM) { fprintf(stderr, "kernel_launch: unexpected shapes (n_in %d, out %d, ws %zu, need %zu)\n", n_in, out_size, ws_size, (size_t)WS_END); grid_blocks = -1; return; }
        int dev = 0, cus = 0, per_cu = 0;
        hipGetDevice(&dev);
        hipDeviceGetAttribute(&cus, hipDeviceAttributeMultiprocessorCount, dev);
        if (hipFuncSetAttribute((const void*)hymba_fwd, hipFuncAttributeMaxDynamicSharedMemorySize, LDS_BYTES) != hipSuccess) { fprintf(stderr, "kernel_launch: hipFuncSetAttribute failed\n"); grid_blocks = -1; return; }
        if (hipOccupancyMaxActiveBlocksPerMultiprocessor(&per_cu, (const void*)hymba_fwd, 512, LDS_BYTES) != hipSuccess || per_cu < 1) { fprintf(stderr, "kernel_launch: occupancy query gave %d\n", per_cu); per_cu = 1; }
        (void)hipGetLastError();
        grid_blocks = cus * 1;
        fprintf(stderr, "kernel_launch: cus %d per_cu %d grid %d\n", cus, per_cu, grid_blocks);
    }
    if (grid_blocks < 0) return;
    Params p{};
    p.x = (const float*)d_in[0]; p.g_attn = (const float*)d_in[1]; p.w_in = (const float*)d_in[2]; p.g_qa = (const float*)d_in[3]; p.g_kva = (const float*)d_in[4];
    p.w_uq = (const float*)d_in[5]; p.w_ukv = (const float*)d_in[6]; p.g_qn = (const float*)d_in[7]; p.g_kn = (const float*)d_in[8]; p.sinks = (const float*)d_in[9];
    p.w_out = (const float*)d_in[10]; p.rel_bias = (const float*)d_in[11]; p.g_final = (const float*)d_in[12];
    p.out = (float*)d_out; p.ws = (unsigned char*)d_ws;
#if defined(MULTI_LAUNCH)
    for (int k = 0; k < N_PHASES; ++k) { p.ph_lo = k; p.ph_hi = k + 1; hipLaunchKernelGGL(hymba_fwd, dim3(grid_blocks), dim3(512), LDS_BYTES, stream, p); }
#else
    p.ph_lo = 0; p.ph_hi = N_PHASES;
    if (hipMemsetAsync((char*)d_ws + WS_BAR, 0, 3456 * 4, stream) != hipSuccess) { fprintf(stderr, "kernel_launch: memset of the barrier words failed\n"); return; }
    void* args[] = {&p};
    hipError_t e = hipLaunchCooperativeKernel((const void*)hymba_fwd, dim3(grid_blocks), dim3(512), args, LDS_BYTES, stream);
    if (e != hipSuccess) fprintf(stderr, "cooperative launch failed: %s (grid %d)\n", hipGetErrorString(e), grid_blocks);
#endif
}
```
